# Optimizing an MI355X kernel written in HIP

```python
import math
import jax, jax.numpy as jnp
from jax import lax
import numpy as np

D_MODEL = 1024
BATCH = 8
SEQ = 2048
DEPTH = 2

CTX_LEN = 256
GRID_W = 64
F32 = jnp.float32
NORM_EPS = 1e-6
N_MOD = 6
N_EVEN = (DEPTH + 1) // 2
N_ODD = DEPTH // 2

A_HEAD_DIM = 64
A_HEADS = D_MODEL // (2 * A_HEAD_DIM)
A_WIDTH = A_HEADS * A_HEAD_DIM
A_DECAY_LORA = 64
A_ICLR_LORA = 64
A_GATE_LORA = 128
A_LN_EPS = 64e-5
A_SIZES = (A_WIDTH, A_WIDTH, A_WIDTH, 2 * A_DECAY_LORA, 2 * A_ICLR_LORA, A_GATE_LORA)
A_COLS = sum(A_SIZES)

B_HEAD_DIM = 128
B_HEADS = D_MODEL // (2 * B_HEAD_DIM)
B_WIDTH = B_HEADS * B_HEAD_DIM
B_CONV = 5
B_CHUNK = 64
B_SIZES = (B_WIDTH, B_WIDTH, B_WIDTH, 2 * B_HEADS, 2 * B_HEADS, B_WIDTH)
B_COLS = sum(B_SIZES)
EVEN_IN = A_COLS + B_COLS

C_HEAD_DIM = 64
C_Q_HEADS = D_MODEL // C_HEAD_DIM
C_KV_HEADS = C_Q_HEADS // 4
C_GROUP = C_Q_HEADS // C_KV_HEADS
C_WINDOW = 128
C_BLOCK = 128
ROPE_BASE = 10000.0
ODD_IN = (C_Q_HEADS + 2 * C_KV_HEADS) * C_HEAD_DIM

N_EXPERTS = 16
MOE_HIDDEN = 1024
EC_CAPACITY = 2

kernel_name = "hybrid_rwkv7_gdn_swa_ec_moe_dit"


def _split(t, sizes):
    return jnp.split(t, np.cumsum(sizes)[:-1].tolist(), axis=-1)


def _heads(t, n_heads):
    return t.reshape(t.shape[:-1] + (n_heads, -1))


def _rms_norm(t, gain, eps=NORM_EPS):
    tf = t.astype(F32)
    tf = tf * lax.rsqrt(jnp.mean(tf * tf, axis=-1, keepdims=True) + eps)
    return (tf * gain.astype(F32)).astype(t.dtype)


def _l2norm(t, eps=1e-6):
    tf = t.astype(F32)
    return (tf * lax.rsqrt(jnp.sum(tf * tf, axis=-1, keepdims=True) + eps)).astype(t.dtype)


def _modulate(t, shift, scale):
    return t * (1 + scale) + shift


def _centred_shift_delta(p):
    pad = jnp.pad(p, ((0, 0), (1, 1), (0, 0)))
    return 0.5 * (pad[:, :-2] + pad[:, 2:]) - p


def _centred_dwconv(p, w):
    n_tap = w.shape[0]
    half = n_tap // 2
    n_tok = p.shape[1]
    pad = jnp.pad(p, ((0, 0), (half, half), (0, 0)))
    out = pad[:, 0:n_tok] * w[0]
    for j in range(1, n_tap):
        out = out + pad[:, j:j + n_tok] * w[j]
    return out


def _two_stream_scan(scan_fn, state0, ctx_in, lat_in, reverse):
    if reverse:
        ctx_in = [jnp.flip(t, axis=1) for t in ctx_in]
        lat_in = [jnp.flip(t, axis=1) for t in lat_in]
    state_ctx, y_ctx = scan_fn(state0, *ctx_in)
    _, y_lat = scan_fn(state_ctx, *lat_in)
    if reverse:
        y_ctx, y_lat = jnp.flip(y_ctx, axis=1), jnp.flip(y_lat, axis=1)
    return y_ctx, y_lat


def _rwkv_inputs(pa, mu, w0, w2, a0, a2, g2, k_k, k_a):
    bsz, n_tok, _ = pa.shape
    pa = pa + mu * _centred_shift_delta(pa)
    r, k, v, wd, ad, gd = _split(pa, A_SIZES)
    wd = wd.reshape(bsz, n_tok, 2, A_DECAY_LORA)
    ad = ad.reshape(bsz, n_tok, 2, A_ICLR_LORA)
    w_log = -jax.nn.softplus(-(w0 + jnp.einsum('btdr,drc->btdc', jnp.tanh(wd), w2))) - 0.5
    decay = jnp.exp(-jnp.exp(w_log.astype(F32)))
    a = jax.nn.sigmoid(a0 + jnp.einsum('btdr,drc->btdc', ad, a2))
    g = jax.nn.sigmoid(gd) @ g2
    kk = _l2norm(_heads(k * k_k, A_HEADS)).reshape(k.shape)
    k_dir = k[:, :, None] * (1 + (a - 1) * k_a)
    b_dir = kk[:, :, None] * a
    return r, v, g, kk, decay, k_dir, b_dir


def _rwkv_dir(f, d):
    r, v, g, kk, decay, k_dir, b_dir = f
    return [_heads(t, A_HEADS) for t in (r, decay[:, :, d], k_dir[:, :, d], v, kk, b_dir[:, :, d])]


def _rwkv_scan(state0, r, decay, k, v, kk, b):
    xs = [jnp.moveaxis(t.astype(F32), 1, 0) for t in (r, decay, k, v, kk, b)]

    def step(state, inp):
        r_t, w_t, k_t, v_t, kk_t, b_t = inp
        sa = jnp.einsum('bhij,bhj->bhi', state, kk_t)
        state = (state * w_t[:, :, None, :] - sa[..., None] * b_t[:, :, None, :]
                 + v_t[..., None] * k_t[:, :, None, :])
        return state, jnp.einsum('bhij,bhj->bhi', state, r_t)

    state, y = lax.scan(step, state0, xs)
    return state, jnp.moveaxis(y, 0, 1)


def _rwkv_output(f, y, ln_w, ln_b, r_k):
    r, v, g, kk, decay, k_dir, b_dir = f
    rh, vh = _heads(r, A_HEADS), _heads(v, A_HEADS)
    kh = _heads(k_dir, A_HEADS)
    mean = jnp.mean(y, axis=-1, keepdims=True)
    var = jnp.mean(jnp.square(y - mean), axis=-1, keepdims=True)
    yn = ((y - mean) * lax.rsqrt(var + A_LN_EPS)).reshape(y.shape[:2] + (A_WIDTH,))
    yn = (yn * ln_w.astype(F32) + ln_b.astype(F32)).astype(r.dtype)
    bonus = jnp.sum(rh[:, :, None] * kh * r_k, axis=(2, 4))[..., None] * vh
    return (yn + bonus.reshape(yn.shape)) * g


def _gdn_inputs(pb, conv_w, a_log, dt_bias):
    bsz, n_tok, _ = pb.shape
    q, k, v, al, be, z = _split(pb, B_SIZES)
    q, k, v = jnp.split(jax.nn.silu(_centred_dwconv(jnp.concatenate([q, k, v], axis=-1), conv_w)), 3, axis=-1)
    q = _l2norm(_heads(q, B_HEADS)) * B_HEAD_DIM ** -0.5
    k = _l2norm(_heads(k, B_HEADS))
    v = _heads(v, B_HEADS)
    al = al.reshape(bsz, n_tok, 2, B_HEADS)
    be = be.reshape(bsz, n_tok, 2, B_HEADS)
    g = -jnp.exp(a_log.astype(F32)) * jax.nn.softplus((al + dt_bias).astype(F32))
    beta = jax.nn.sigmoid(be.astype(F32))
    return q, k, v, g, beta, z


def _gdn_dir(f, d):
    q, k, v, g, beta, z = f
    return [q, k, v, g[:, :, d], beta[:, :, d]]


def _gdn_chunked(state0, q, k, v, g, beta):
    bsz, n_tok, n_heads, _ = q.shape
    dv = v.shape[-1]
    n_chunk = n_tok // B_CHUNK

    def chunked(t):
        t = t.astype(F32).reshape((bsz, n_chunk, B_CHUNK) + t.shape[2:])
        return jnp.moveaxis(jnp.moveaxis(t, 1, 0), 2, 3)

    qc, kc, vc, gc, bc = [chunked(t) for t in (q, k, v, g, beta)]
    gcum = jnp.cumsum(gc, axis=-1)
    pos = jnp.arange(B_CHUNK)
    incl = pos[:, None] >= pos[None, :]
    strict = pos[:, None] > pos[None, :]
    decay = jnp.exp(jnp.where(incl, gcum[..., :, None] - gcum[..., None, :], -jnp.inf))
    k_beta = kc * bc[..., None]
    l_mat = jnp.where(strict, jnp.einsum('nbhid,nbhjd->nbhij', k_beta, kc) * decay, 0.0)
    rhs = jnp.concatenate([vc * bc[..., None], k_beta * jnp.exp(gcum)[..., None]], axis=-1)
    sol = lax.linalg.triangular_solve(l_mat, rhs, left_side=True, lower=True, unit_diagonal=True)
    u, w = sol[..., :dv], sol[..., dv:]
    a_intra = jnp.where(incl, jnp.einsum('nbhid,nbhjd->nbhij', qc, kc) * decay, 0.0)

    def step(state, inp):
        q_i, k_i, u_i, w_i, g_i, a_i = inp
        v_new = u_i - jnp.einsum('bhlk,bhkv->bhlv', w_i, state)
        o_i = (jnp.einsum('bhlk,bhkv->bhlv', q_i * jnp.exp(g_i)[..., None], state)
               + jnp.einsum('bhlm,bhmv->bhlv', a_i, v_new))
        g_last = g_i[..., -1:]
        state = (state * jnp.exp(g_last)[..., None]
                 + jnp.einsum('bhlk,bhlv->bhkv', k_i * jnp.exp(g_last - g_i)[..., None], v_new))
        return state, o_i

    state, o = lax.scan(step, state0, (qc, kc, u, w, gcum, a_intra))
    o = jnp.moveaxis(jnp.moveaxis(o, 3, 2), 0, 1).reshape(bsz, n_tok, n_heads, dv)
    return state, o


def _gdn_output(f, o, norm_w):
    z = f[-1]
    on = o * lax.rsqrt(jnp.mean(o * o, axis=-1, keepdims=True) + NORM_EPS) * norm_w.astype(F32)
    return (on.astype(z.dtype) * jax.nn.silu(_heads(z, B_HEADS))).reshape(z.shape)


def _even_mixer(h_ctx, h_lat, w_in, w_out, a_mu, a_w0, a_w2, a_a0, a_a2, a_g2, a_k_k, a_k_a, a_r_k,
                a_ln_w, a_ln_b, b_conv, b_a_log, b_dt_bias, b_norm):
    bsz = h_lat.shape[0]
    pa_c, pb_c = _split(h_ctx @ w_in, (A_COLS, B_COLS))
    pa_l, pb_l = _split(h_lat @ w_in, (A_COLS, B_COLS))
    ra_c = _rwkv_inputs(pa_c, a_mu, a_w0, a_w2, a_a0, a_a2, a_g2, a_k_k, a_k_a)
    ra_l = _rwkv_inputs(pa_l, a_mu, a_w0, a_w2, a_a0, a_a2, a_g2, a_k_k, a_k_a)
    gb_c = _gdn_inputs(pb_c, b_conv, b_a_log, b_dt_bias)
    gb_l = _gdn_inputs(pb_l, b_conv, b_a_log, b_dt_bias)
    s0_a = jnp.zeros((bsz, A_HEADS, A_HEAD_DIM, A_HEAD_DIM), F32)
    s0_b = jnp.zeros((bsz, B_HEADS, B_HEAD_DIM, B_HEAD_DIM), F32)
    ya_cf, ya_lf = _two_stream_scan(_rwkv_scan, s0_a, _rwkv_dir(ra_c, 0), _rwkv_dir(ra_l, 0), False)
    ya_cb, ya_lb = _two_stream_scan(_rwkv_scan, s0_a, _rwkv_dir(ra_c, 1), _rwkv_dir(ra_l, 1), True)
    yb_cf, yb_lf = _two_stream_scan(_gdn_chunked, s0_b, _gdn_dir(gb_c, 0), _gdn_dir(gb_l, 0), False)
    yb_cb, yb_lb = _two_stream_scan(_gdn_chunked, s0_b, _gdn_dir(gb_c, 1), _gdn_dir(gb_l, 1), True)
    out_ctx = jnp.concatenate([_rwkv_output(ra_c, ya_cf + ya_cb, a_ln_w, a_ln_b, a_r_k),
                               _gdn_output(gb_c, yb_cf + yb_cb, b_norm)], axis=-1) @ w_out
    out_lat = jnp.concatenate([_rwkv_output(ra_l, ya_lf + ya_lb, a_ln_w, a_ln_b, a_r_k),
                               _gdn_output(gb_l, yb_lf + yb_lb, b_norm)], axis=-1) @ w_out
    return out_ctx, out_lat


def _axial_rope(t, row, col):
    quarter = C_HEAD_DIM // 4
    half = C_HEAD_DIM // 2
    inv = ROPE_BASE ** (-jnp.arange(quarter, dtype=F32) / quarter)

    def rot(part, pos):
        ang = pos[:, None] * inv[None, :]
        cos = jnp.cos(ang)[None, :, None, :].astype(t.dtype)
        sin = jnp.sin(ang)[None, :, None, :].astype(t.dtype)
        p1, p2 = part[..., :quarter], part[..., quarter:]
        return jnp.concatenate([p1 * cos - p2 * sin, p2 * cos + p1 * sin], axis=-1)

    return jnp.concatenate([rot(t[..., :half], row), rot(t[..., half:], col)], axis=-1)


def _odd_mixer(h_ctx, h_lat, w_in, w_out, sink):
    bsz, n_lat, _ = h_lat.shape
    q_cols = C_Q_HEADS * C_HEAD_DIM
    kv_cols = C_KV_HEADS * C_HEAD_DIM
    k_ctx, v_ctx = [_heads(t, C_KV_HEADS) for t in jnp.split(h_ctx @ w_in[:, q_cols:], 2, axis=-1)]
    q, k, v = _split(h_lat @ w_in, (q_cols, kv_cols, kv_cols))
    rows = n_lat // GRID_W
    row = jnp.repeat(jnp.arange(rows, dtype=F32), GRID_W)
    col = jnp.tile(jnp.arange(GRID_W, dtype=F32), rows)
    q = _axial_rope(_heads(q, C_Q_HEADS), row, col) * C_HEAD_DIM ** -0.5
    q = q.reshape(bsz, n_lat, C_KV_HEADS, C_GROUP, C_HEAD_DIM)
    k = _axial_rope(_heads(k, C_KV_HEADS), row, col)
    v = _heads(v, C_KV_HEADS)
    pad = ((0, 0), (C_BLOCK, C_BLOCK), (0, 0), (0, 0))
    k_pad, v_pad = jnp.pad(k, pad), jnp.pad(v, pad)
    span = 3 * C_BLOCK
    sink_logit = jnp.broadcast_to(sink.astype(F32).reshape(1, C_KV_HEADS, C_GROUP, 1, 1),
                                  (bsz, C_KV_HEADS, C_GROUP, C_BLOCK, 1))

    def block(n):
        start = n * C_BLOCK
        qb = lax.dynamic_slice_in_dim(q, start, C_BLOCK, axis=1)
        kb = lax.dynamic_slice_in_dim(k_pad, start, span, axis=1)
        vb = lax.dynamic_slice_in_dim(v_pad, start, span, axis=1)
        q_pos = start + jnp.arange(C_BLOCK)
        k_pos = start - C_BLOCK + jnp.arange(span)
        valid = ((jnp.abs(q_pos[:, None] - k_pos[None, :]) <= C_WINDOW)
                 & (k_pos >= 0)[None, :] & (k_pos < n_lat)[None, :])
        s_loc = jnp.where(valid, jnp.einsum('bqhgd,bshd->bhgqs', qb, kb).astype(F32), -jnp.inf)
        s_ctx = jnp.einsum('bqhgd,bshd->bhgqs', qb, k_ctx).astype(F32)
        p = jax.nn.softmax(jnp.concatenate([s_loc, s_ctx, sink_logit], axis=-1), axis=-1).astype(vb.dtype)
        return (jnp.einsum('bhgqs,bshd->bqhgd', p[..., :span], vb)
                + jnp.einsum('bhgqs,bshd->bqhgd', p[..., span:-1], v_ctx))

    out = lax.map(block, jnp.arange(n_lat // C_BLOCK))
    out = jnp.moveaxis(out, 0, 1).reshape(bsz, n_lat, q_cols)
    return out @ w_out


def _ec_moe(h, router, w1, w3, w2):
    bsz, n_tok, d = h.shape
    cap = EC_CAPACITY * n_tok // N_EXPERTS
    aff = jax.nn.softmax(jnp.einsum('btd,de->bte', h, router).astype(F32), axis=-1)
    gate, idx = lax.top_k(jnp.swapaxes(aff, 1, 2), cap)
    xe = jax.vmap(lambda hb, ib: hb[ib])(h, idx)
    hid = jax.nn.silu(jnp.einsum('becd,edf->becf', xe, w1)) * jnp.einsum('becd,edf->becf', xe, w3)
    ye = jnp.einsum('becf,efd->becd', hid, w2) * gate[..., None].astype(h.dtype)
    return jax.vmap(lambda ib, yb: jnp.zeros((n_tok, d), yb.dtype).at[ib.reshape(-1)].add(yb.reshape(-1, d)))(idx, ye)


def setup_inputs(seed: int = 0) -> dict:
    key = jax.random.key(seed)
    ks = iter(jax.random.split(key, 48))

    def nrm(shape, scale):
        return scale * jax.random.normal(next(ks), shape, F32)

    def unif(shape, lo, hi):
        return jax.random.uniform(next(ks), shape, F32, lo, hi)

    dt = jnp.exp(unif((N_EVEN, 2, B_HEADS), math.log(1e-3), math.log(1e-1)))
    return {
        "x": nrm((BATCH, SEQ, D_MODEL), 1.0),
        "c": nrm((BATCH, D_MODEL), 1.0),
        "ctx": nrm((BATCH, CTX_LEN, D_MODEL), 1.0),
        "c_ctx": nrm((D_MODEL,), 1.0),
        "ada_w": nrm((DEPTH, D_MODEL, N_MOD * D_MODEL), 0.5 * D_MODEL ** -0.5),
        "ada_b": nrm((DEPTH, N_MOD * D_MODEL), 0.01),
        "norm_mix": 1.0 + nrm((DEPTH, D_MODEL), 0.1),
        "norm_ffn": 1.0 + nrm((DEPTH, D_MODEL), 0.1),
        "e_w_in": nrm((N_EVEN, D_MODEL, EVEN_IN), D_MODEL ** -0.5),
        "e_w_out": nrm((N_EVEN, A_WIDTH + B_WIDTH, D_MODEL), (A_WIDTH + B_WIDTH) ** -0.5),
        "a_mu": unif((N_EVEN, A_COLS), 0.0, 1.0),
        "a_w0": unif((N_EVEN, 2, A_WIDTH), -6.0, -1.0),
        "a_w2": nrm((N_EVEN, 2, A_DECAY_LORA, A_WIDTH), 0.1 * A_DECAY_LORA ** -0.5),
        "a_a0": nrm((N_EVEN, 2, A_WIDTH), 0.1),
        "a_a2": nrm((N_EVEN, 2, A_ICLR_LORA, A_WIDTH), 0.1 * A_ICLR_LORA ** -0.5),
        "a_g2": nrm((N_EVEN, A_GATE_LORA, A_WIDTH), A_GATE_LORA ** -0.5),
        "a_k_k": 0.85 + nrm((N_EVEN, A_WIDTH), 0.05),
        "a_k_a": 1.0 + nrm((N_EVEN, A_WIDTH), 0.05),
        "a_r_k": nrm((N_EVEN, A_HEADS, A_HEAD_DIM), 0.1),
        "a_ln_w": 1.0 + nrm((N_EVEN, A_WIDTH), 0.1),
        "a_ln_b": nrm((N_EVEN, A_WIDTH), 0.01),
        "b_conv": nrm((N_EVEN, B_CONV, 3 * B_WIDTH), B_CONV ** -0.5),
        "b_a_log": jnp.log(unif((N_EVEN, 2, B_HEADS), 1.0, 16.0)),
        "b_dt_bias": dt + jnp.log(-jnp.expm1(-dt)),
        "b_norm": 1.0 + nrm((N_EVEN, B_HEAD_DIM), 0.1),
        "o_w_in": nrm((N_ODD, D_MODEL, ODD_IN), D_MODEL ** -0.5),
        "o_w_out": nrm((N_ODD, C_Q_HEADS * C_HEAD_DIM, D_MODEL), (C_Q_HEADS * C_HEAD_DIM) ** -0.5),
        "o_sink": nrm((N_ODD, C_Q_HEADS), 0.5),
        "moe_router": nrm((DEPTH, D_MODEL, N_EXPERTS), D_MODEL ** -0.5),
        "moe_w1": nrm((DEPTH, N_EXPERTS, D_MODEL, MOE_HIDDEN), D_MODEL ** -0.5),
        "moe_w3": nrm((DEPTH, N_EXPERTS, D_MODEL, MOE_HIDDEN), D_MODEL ** -0.5),
        "moe_w2": nrm((DEPTH, N_EXPERTS, MOE_HIDDEN, D_MODEL), MOE_HIDDEN ** -0.5),
        "final_norm": 1.0 + nrm((D_MODEL,), 0.1),
    }


def reference(x, c, ctx, c_ctx, ada_w, ada_b, norm_mix, norm_ffn, e_w_in, e_w_out, a_mu, a_w0, a_w2, a_a0,
              a_a2, a_g2, a_k_k, a_k_a, a_r_k, a_ln_w, a_ln_b, b_conv, b_a_log, b_dt_bias, b_norm, o_w_in,
              o_w_out, o_sink, moe_router, moe_w1, moe_w3, moe_w2, final_norm):
    x_lat, x_ctx = x, ctx
    silu_c, silu_cc = jax.nn.silu(c), jax.nn.silu(c_ctx)
    for i in range(DEPTH):
        j = i // 2
        mod_l = jnp.split((silu_c @ ada_w[i] + ada_b[i])[:, None, :], N_MOD, axis=-1)
        mod_c = jnp.split(silu_cc @ ada_w[i] + ada_b[i], N_MOD, axis=-1)
        h_lat = _modulate(_rms_norm(x_lat, norm_mix[i]), mod_l[0], mod_l[1])
        h_ctx = _modulate(_rms_norm(x_ctx, norm_mix[i]), mod_c[0], mod_c[1])
        if i % 2 == 0:
            o_ctx, o_lat = _even_mixer(h_ctx, h_lat, e_w_in[j], e_w_out[j], a_mu[j], a_w0[j], a_w2[j], a_a0[j],
                                       a_a2[j], a_g2[j], a_k_k[j], a_k_a[j], a_r_k[j], a_ln_w[j], a_ln_b[j],
                                       b_conv[j], b_a_log[j], b_dt_bias[j], b_norm[j])
            x_ctx = x_ctx + mod_c[2] * o_ctx
        else:
            o_lat = _odd_mixer(h_ctx, h_lat, o_w_in[j], o_w_out[j], o_sink[j])
        x_lat = x_lat + mod_l[2] * o_lat
        x_lat = x_lat + mod_l[5] * _ec_moe(_modulate(_rms_norm(x_lat, norm_ffn[i]), mod_l[3], mod_l[4]),
                                           moe_router[i], moe_w1[i], moe_w3[i], moe_w2[i])
        if i < DEPTH - 1:
            x_ctx = x_ctx + mod_c[5] * _ec_moe(_modulate(_rms_norm(x_ctx, norm_ffn[i]), mod_c[3], mod_c[4]),
                                               moe_router[i], moe_w1[i], moe_w3[i], moe_w2[i])
    return _rms_norm(x_lat, final_norm)
```

```cpp
#include <hip/hip_runtime.h>
#include <hip/hip_cooperative_groups.h>
#include <cstdio>
#include <cstdint>
namespace cg = cooperative_groups;

typedef unsigned short bf16_t;
typedef short bf16x8 __attribute__((ext_vector_type(8)));
typedef float f32x4 __attribute__((ext_vector_type(4)));
typedef unsigned u32x4 __attribute__((ext_vector_type(4)));

constexpr int NB = 8, SEQ = 2048, LC = 256, TT = 2304, DM = 1024, NTOK = NB * TT;
constexpr int EIN = 3984;
constexpr int NTHR = 512;
constexpr int LDS_MAIN = 155648;
constexpr int LDS_BYTES = LDS_MAIN + 16;

constexpr size_t SZ_MOD = 2ull * 9 * 6144 * 4;
constexpr size_t OFF_BAR = 0;
constexpr size_t SZ_BAR = 16384;
constexpr size_t OFF_MOD = OFF_BAR + SZ_BAR;
constexpr size_t OFF_ROPE = OFF_MOD + SZ_MOD;
constexpr size_t OFF_WIN0 = OFF_ROPE + 8192;
constexpr size_t OFF_WOUT0 = OFF_WIN0 + 4096ull * 1024 * 2;
constexpr size_t OFF_WIN1 = OFF_WOUT0 + 1024ull * 1024 * 2;
constexpr size_t OFF_WOUT1 = OFF_WIN1 + 1536ull * 1024 * 2;
constexpr size_t OFF_LORA = OFF_WOUT1 + 1024ull * 1024 * 2;
constexpr size_t OFF_XCTX = OFF_LORA + 196608ull * 2;
constexpr size_t OFF_H = OFF_XCTX + (size_t)NB * LC * DM * 4;
constexpr size_t OFF_BIG = OFF_H + (size_t)NTOK * DM * 2;
constexpr size_t SZ_T512 = (size_t)NTOK * 512 * 2;
constexpr size_t B_EW = OFF_BIG;
constexpr size_t B_KD = B_EW + 2 * SZ_T512;
constexpr size_t B_BD = B_KD + 2 * SZ_T512;
constexpr size_t B_RR = B_BD + 2 * SZ_T512;
constexpr size_t B_KK = B_RR + SZ_T512;
constexpr size_t B_GQ = B_KK + SZ_T512;
constexpr size_t B_GK = B_GQ + SZ_T512;
constexpr size_t B_GV = B_GK + SZ_T512;
constexpr size_t B_VV = B_GV + SZ_T512;
constexpr size_t B_GG = B_VV + SZ_T512;
constexpr size_t B_BC = B_GG + SZ_T512;
constexpr size_t B_GDG = B_BC + (size_t)NTOK * 8 * 4;
constexpr size_t B_GDB = B_GDG + (size_t)NTOK * 8 * 4;
constexpr size_t B_P = B_GDB + (size_t)NTOK * 8 * 4;
constexpr size_t B_YF = B_P + (size_t)NTOK * EIN * 2;
constexpr size_t B_YB = B_YF + SZ_T512;
constexpr size_t B_OF = B_YB + SZ_T512;
constexpr size_t B_OB = B_OF + SZ_T512;
constexpr size_t B_ZZ = B_OB + SZ_T512;
constexpr size_t B_END = B_ZZ + SZ_T512;
constexpr size_t C_GMW = B_P;
constexpr size_t C_GMU = C_GMW + 2304ull * 4096 * 2;
constexpr size_t C_RM = C_GMU + 2304ull * 4096 * 2;
static_assert(C_RM + 4608ull * 4096 * 2 <= B_YF, "chunk inverses must fit inside P");
constexpr size_t M_W = OFF_BIG;
constexpr size_t M_AFF = M_W + 3ull * 16 * 1024 * 1024 * 2;
constexpr size_t M_SEL = M_AFF + (size_t)NTOK * 16 * 4;
constexpr size_t M_IDX = M_SEL + (size_t)NTOK * 16 * 4;
constexpr size_t M_GATE = M_IDX + 16ull * 2304 * 4;
constexpr size_t M_HID = M_GATE + 16ull * 2304 * 4;
constexpr size_t M_YE = M_HID + 16ull * 2304 * 1024 * 2;
constexpr size_t M_END = M_YE + 16ull * 2304 * 1024 * 4;
constexpr size_t L_QB = M_HID;
constexpr size_t L_KB = L_QB + (size_t)NTOK * 1024 * 2;
constexpr size_t L_VT = L_KB + (size_t)NTOK * 256 * 2;
constexpr size_t L_AO = L_VT + (size_t)NTOK * 256 * 2;
constexpr size_t L_END = L_AO + (size_t)NB * SEQ * DM * 2;
constexpr size_t WS_NEED = B_END > M_END ? B_END : M_END;
static_assert(L_END <= M_END, "layer-1 buffers must fit below the MoE buffers' end");
static_assert(M_AFF <= B_VV, "MoE weights must only alias buffers dead after the scans");
static_assert(WS_NEED <= 560000000ull, "workspace too large");

struct Params {
    const float* in[33];
    float* out;
    char* ws;
    int ph_lo, ph_hi;
};

__device__ __forceinline__ float bf2f(bf16_t v) { return __uint_as_float(((unsigned)v) << 16); }
typedef __bf16 bf16x2_t __attribute__((ext_vector_type(2)));
typedef float f32x2 __attribute__((ext_vector_type(2)));
__device__ __forceinline__ bf16_t f2bf(float f) { return __builtin_bit_cast(bf16_t, (__bf16)f); }
__device__ __forceinline__ unsigned pack2(float a, float b) { const bf16x2_t v = __builtin_convertvector((f32x2){a, b}, bf16x2_t); return __builtin_bit_cast(unsigned, v); }
__device__ __forceinline__ uint2 pk4(f32x4 v) { uint2 o; o.x = pack2(v[0], v[1]); o.y = pack2(v[2], v[3]); return o; }
__device__ __forceinline__ float sigm(float x) { return __builtin_amdgcn_rcpf(1.f + __expf(-x)); }
__device__ __forceinline__ float siluf(float x) { return x * __builtin_amdgcn_rcpf(1.f + __expf(-x)); }
__device__ __forceinline__ float softplusf(float x) { return x > 20.f ? x : log1pf(expf(x)); }
__device__ __forceinline__ float red16(float x);
__device__ __forceinline__ float wave_sum(float v) {
    v = red16(v);
    v += __builtin_bit_cast(float, __builtin_amdgcn_update_dpp(0, __builtin_bit_cast(int, v), 0x142, 0xa, 0xf, false));
    v += __builtin_bit_cast(float, __builtin_amdgcn_update_dpp(0, __builtin_bit_cast(int, v), 0x143, 0xc, 0xf, false));
    return __builtin_bit_cast(float, __builtin_amdgcn_readlane(__builtin_bit_cast(int, v), 63));
}
__device__ __forceinline__ float red16(float x) {
    x += __builtin_bit_cast(float, __builtin_amdgcn_update_dpp(0, __builtin_bit_cast(int, x), 0xB1, 0xf, 0xf, false));
    x += __builtin_bit_cast(float, __builtin_amdgcn_update_dpp(0, __builtin_bit_cast(int, x), 0x4E, 0xf, 0xf, false));
    x += __builtin_bit_cast(float, __builtin_amdgcn_update_dpp(0, __builtin_bit_cast(int, x), 0x124, 0xf, 0xf, false));
    x += __builtin_bit_cast(float, __builtin_amdgcn_update_dpp(0, __builtin_bit_cast(int, x), 0x128, 0xf, 0xf, false));
    return x;
}
__device__ __forceinline__ const float* xin_row(const Params& p, int R) {
    int b = R / TT, s = R - b * TT;
    return s < LC ? p.in[2] + (size_t)(b * LC + s) * DM : p.in[0] + (size_t)(b * SEQ + s - LC) * DM;
}
__device__ __forceinline__ float* xs_row(const Params& p, int R) {
    int b = R / TT, s = R - b * TT;
    return s < LC ? (float*)(p.ws + OFF_XCTX) + (size_t)(b * LC + s) * DM : p.out + (size_t)(b * SEQ + s - LC) * DM;
}
__device__ __forceinline__ int mod_row(int R) {
    int b = R / TT, s = R - b * TT;
    return s < LC ? 8 : b;
}
__device__ __forceinline__ const float* mod_ptr(const Params& p, int layer, int mrow, int j) {
    return (const float*)(p.ws + OFF_MOD) + ((size_t)(layer * 9 + mrow) * 6 + j) * 1024;
}


#define XB_TMO      128
#define XB_XCNT(j)  (256  + 64 * (j))
#define XB_XSUB(j)  (1280 + 64 * (j))
#define XB_XGEN(j)  (2304 + 64 * (j))
#define XB_TOP      3328
#define XB_TOPGEN   3392
#define XCD_BAR_WORDS 3456
#define XB_SPIN_CAP (1u << 22)
#define LAS __attribute__((address_space(3)))
__device__ __forceinline__ unsigned xb_ld(unsigned* p)              { return __hip_atomic_load(p, __ATOMIC_RELAXED, __HIP_MEMORY_SCOPE_AGENT); }
__device__ __forceinline__ unsigned xb_add(unsigned* p, unsigned v) { return __hip_atomic_fetch_add(p, v, __ATOMIC_RELAXED, __HIP_MEMORY_SCOPE_AGENT); }
__device__ __forceinline__ unsigned xb_xcc_id() { return (unsigned)__builtin_amdgcn_s_getreg((3 << 11) | 20) & 0xFu; }
#define XB_SPIN(cond, bar) do { unsigned _sp = 0; while (cond) { __builtin_amdgcn_s_sleep(1); \
    if ((++_sp & 255u) == 0u) { if (xb_ld(&(bar)[XB_TMO])) break; if (_sp > XB_SPIN_CAP) { atomicAdd(&(bar)[XB_TMO], 1u); break; } } } } while (0)
struct XcdBarrier { unsigned* bar; unsigned x; volatile LAS unsigned* st; };
__device__ __forceinline__ XcdBarrier xcd_barrier_post(unsigned* bar, volatile LAS unsigned* st) {
    XcdBarrier b; b.bar = bar; b.x = xb_xcc_id(); b.st = st;
    if (threadIdx.x == 0) (void)xb_add(&bar[XB_XCNT(b.x)], 1u);
    return b;
}
__device__ __forceinline__ void xcd_barrier_complete(unsigned* bar, unsigned x, unsigned& nloc, unsigned& nx) {
    const unsigned G = gridDim.x * gridDim.y * gridDim.z;
    unsigned sum, cnt, mine, sp = 0u;
    for (;;) {
        sum = 0u; cnt = 0u; mine = 0u;
#pragma unroll
        for (unsigned j = 0; j < 16; ++j) { const unsigned c = xb_ld(&bar[XB_XCNT(j)]); sum += c; cnt += (c > 0u) ? 1u : 0u; mine = (j == x) ? c : mine; }
        if (sum == G) break;
        __builtin_amdgcn_s_sleep(1);
        if ((++sp & 255u) == 0u) { if (xb_ld(&bar[XB_TMO])) break; if (sp > XB_SPIN_CAP) { atomicAdd(&bar[XB_TMO], 1u); break; } }
    }
    nloc = mine > 0u ? mine : 1u; nx = cnt > 0u ? cnt : 1u;
}
__device__ __forceinline__ void xcd_barrier(const XcdBarrier& b) {
    asm volatile("s_waitcnt vmcnt(0)" ::: "memory");
    __syncthreads();
    if (threadIdx.x == 0) {
        unsigned* bar = b.bar;
        __builtin_amdgcn_s_waitcnt(0);
        unsigned nloc = b.st[0], nx = b.st[1];
        if (nloc == 0u) { xcd_barrier_complete(bar, b.x, nloc, nx); b.st[0] = nloc; b.st[1] = nx; }
        const unsigned old = xb_add(&bar[XB_XSUB(b.x)], 1u);
        const unsigned gen = old / nloc;
        if (old + 1u == (gen + 1u) * nloc) {
            __builtin_amdgcn_fence(__ATOMIC_RELEASE, "agent");
            asm volatile("s_waitcnt vmcnt(0)" ::: "memory");
            const unsigned og = xb_add(&bar[XB_TOP], 1u);
            const unsigned tg = og / nx;
            if (og + 1u == (tg + 1u) * nx) xb_add(&bar[XB_TOPGEN], 1u);
            else XB_SPIN(xb_ld(&bar[XB_TOPGEN]) == tg, bar);
            __builtin_amdgcn_fence(__ATOMIC_ACQUIRE, "agent");
            xb_add(&bar[XB_XGEN(b.x)], 1u);
            asm volatile("s_waitcnt vmcnt(0)" ::: "memory");
        } else {
            XB_SPIN(xb_ld(&bar[XB_XGEN(b.x)]) == gen, bar);
            __builtin_amdgcn_fence(__ATOMIC_ACQUIRE, "agent");
            asm volatile("s_waitcnt vmcnt(0)" ::: "memory");
        }
    }
    __syncthreads();
}

__device__ __forceinline__ int swz(int row, int chunk) { return row * 128 + ((chunk ^ ((row >> 1) & 7)) << 4); }

namespace g8 {
constexpr int BM = 256, BK = 64, HALF = 128, HTB = HALF * BK * 2, STAGE_BYTES = 8 * HTB, NXCD = 8, WGM = 8;
__device__ __forceinline__ int lds_byte(int r, int c) { const int st = (r >> 4) * 2 + (c >> 5), rr = r & 15, cc = c & 31, ob = rr * 64 + cc * 2; return st * 1024 + (ob ^ (((ob >> 9) & 1) << 5)); }
__device__ __forceinline__ void stage_rc(int b, int& R, int& C) { const int st = b / 1024, sb = b % 1024, swz = sb ^ (((sb >> 9) & 1) << 5); R = (st >> 1) * 16 + swz / 64; C = (st & 1) * 32 + (swz % 64) / 2; }
__device__ __forceinline__ int perm32(int rho) { const int n = rho >> 4, i = rho & 15; return 8 * (i >> 2) + 4 * n + (i & 3); }
struct Unit { const char* a0; const char* a1; const char* b0; const char* b1; int pm, pn, e, half, mh, nh; };
__device__ __forceinline__ bool tail_split(int i, int U, int maxp, int& L, int& sub, int& pieces) {
    const int G = (int)gridDim.x, c = (int)blockIdx.x, R = U / G, T = U - R * G;
    pieces = 1; sub = 0;
    if (i < R) { L = i * G + c; return true; }
    if (i > R || T == 0) return false;
    pieces = (maxp >= 4 && 4 * T <= G) ? 4 : (maxp >= 2 && 2 * T <= G) ? 2 : 1;
    if (c >= pieces * T) return false;
    L = R * G + c / pieces; sub = c % pieces; return true;
}
__device__ __forceinline__ void grid_order_L(int L, int nM, int nN, int& pm, int& pn) {
    const int nwg = nM * nN;
    int wgid = L; { const int q = nwg / NXCD, r = nwg % NXCD, xcd = wgid % NXCD, off = wgid / NXCD; wgid = (xcd < r ? xcd * (q + 1) : r * (q + 1) + (xcd - r) * q) + off; }
    const int nig = WGM * nN, gid = wgid / nig, fm = gid * WGM, gsz = (nM - fm) < WGM ? (nM - fm) : WGM;
    pm = fm + ((wgid % nig) % gsz); pn = (wgid % nig) / gsz;
}
__device__ __forceinline__ bool grid_order(int i, int nM, int nN, int& pm, int& pn) {
    const long L = (long)i * gridDim.x + blockIdx.x; if (L >= nM * nN) return false;
    grid_order_L((int)L, nM, nN, pm, pn); return true;
}

template <bool GATHER, class Epi, class Sched>
__device__ __forceinline__ void gemm_phase(LAS unsigned char* lds, const int K, const Sched& S, const Epi& E) {
    const int tid = threadIdx.x, wid = __builtin_amdgcn_readfirstlane(tid >> 6), lane = tid & 63, wr = wid >> 2, wc = wid & 3, fr = lane & 15, fq = lane >> 4;
    const int nt = K / BK;
    int sR[2], sC[2];
    unsigned voffB[2], voffA0[2], voffA1[2], nvoffA0[2], nvoffA1[2];
#pragma unroll
    for (int i = 0; i < 2; ++i) {
        stage_rc(tid * 16 + i * 8192, sR[i], sC[i]);
        const unsigned va = (unsigned)(sR[i] * K + sC[i]) * 2u;
        const int Rb = Epi::PERM ? ((sR[i] & ~31) + perm32(sR[i] & 31)) : sR[i];
        voffB[i] = (unsigned)(Rb * K + sC[i]) * 2u; voffA0[i] = va; voffA1[i] = va; nvoffA0[i] = va; nvoffA1[i] = va;
    }
    const size_t kstep = (size_t)(BK * 2);
    const unsigned ldsw = (unsigned)wid * 1024u;
    const int aoff = lds_byte(wr * 64 + fr, fq * 8), boff = lds_byte(wc * 32 + fr, fq * 8);
#define G8_SA(b, h) (((b) * 2 + (h)) * HTB)
#define G8_SB(b, h) ((4 + (b) * 2 + (h)) * HTB)
#define G8_STAGE(bufoff, gbase, voff) do { _Pragma("unroll") for (int _i = 0; _i < 2; ++_i) \
        __builtin_amdgcn_global_load_lds((const unsigned*)((const char*)(gbase) + (voff)[_i]), (LAS unsigned*)(lds + (bufoff) + ldsw + _i * 8192), 16, 0, 0); } while (0)
#define G8_LDA(dst, b, h) do { _Pragma("unroll") for (int m = 0; m < 4; ++m) _Pragma("unroll") for (int k = 0; k < 2; ++k) dst[m][k] = *(const LAS bf16x8*)(lds + G8_SA(b, h) + aoff + m * 2048 + k * 1024); } while (0)
#define G8_LDB(dst, b, h) do { _Pragma("unroll") for (int n = 0; n < 2; ++n) _Pragma("unroll") for (int k = 0; k < 2; ++k) dst[n][k] = *(const LAS bf16x8*)(lds + G8_SB(b, h) + boff + n * 2048 + k * 1024); } while (0)
#define G8_MMA(ai, bj, At, Bt) do { __builtin_amdgcn_s_setprio(1); _Pragma("unroll") for (int m = 0; m < 4; ++m) _Pragma("unroll") for (int n = 0; n < 2; ++n) _Pragma("unroll") for (int k = 0; k < 2; ++k) \
        acc[ai][bj][m][n] = __builtin_amdgcn_mfma_f32_16x16x32_bf16(Bt[n][k], At[m][k], acc[ai][bj][m][n], 0, 0, 0); __builtin_amdgcn_s_setprio(0); } while (0)
#define G8_WAIT_V(n) asm volatile("s_waitcnt vmcnt(" #n ")" ::: "memory")
#define G8_WAIT_L(n) asm volatile("s_waitcnt lgkmcnt(" #n ")" ::: "memory")
#define G8_BAR __builtin_amdgcn_s_barrier()
#define G8_SCHED __builtin_amdgcn_sched_barrier(0)
    Unit cur, nxt; int ui = 0;
    if (!S.next(0, cur)) return;
    if (GATHER) {
#pragma unroll
        for (int i = 0; i < 2; ++i) { voffA0[i] = S.aoff(cur, 0, sR[i], sC[i]); voffA1[i] = (cur.half & 2) ? 0u : S.aoff(cur, 1, sR[i], sC[i]); }
    } else {
#pragma unroll
        for (int i = 0; i < 2; ++i) voffA1[i] = (cur.half & 2) ? 0u : voffA0[i];
    }
    unsigned cB1[2], nB1[2];
#pragma unroll
    for (int i = 0; i < 2; ++i) { cB1[i] = (cur.half & 1) ? 0u : voffB[i]; nB1[i] = cB1[i]; }
    int raw0[2] = {0, 0}, raw1[2] = {0, 0};
    if (GATHER) {
        Unit u1;
        if (S.next(1, u1)) {
#pragma unroll
            for (int i = 0; i < 2; ++i) { raw0[i] = S.araw(u1, 0, sR[i]); raw1[i] = (u1.half & 2) ? 0 : S.araw(u1, 1, sR[i]); }
        }
    }
    f32x4 acc[2][2][4][2];
#pragma unroll
    for (int a = 0; a < 2; ++a)
#pragma unroll
        for (int b = 0; b < 2; ++b)
#pragma unroll
            for (int m = 0; m < 4; ++m)
#pragma unroll
                for (int n = 0; n < 2; ++n) acc[a][b][m][n] = (f32x4){0.f, 0.f, 0.f, 0.f};
    bf16x8 At[4][2], B0[2][2], B1[2][2];
    G8_STAGE(G8_SB(0, 0), cur.b0, voffB); G8_STAGE(G8_SA(0, 0), cur.a0, voffA0); G8_STAGE(G8_SB(0, 1), cur.b1, cB1); G8_STAGE(G8_SA(0, 1), cur.a1, voffA1);
    if (wr == 1) G8_BAR;
    G8_WAIT_V(4); G8_BAR;
    G8_STAGE(G8_SB(1, 0), cur.b0 + kstep, voffB); G8_STAGE(G8_SA(1, 0), cur.a0 + kstep, voffA0); G8_STAGE(G8_SB(1, 1), cur.b1 + kstep, cB1);
    G8_WAIT_V(6); G8_BAR;
    for (;;) {
        const bool has_next = S.next(ui + 1, nxt);
        if (!has_next) nxt = cur;
        if (GATHER) {
#pragma unroll
            for (int i = 0; i < 2; ++i) { nvoffA0[i] = has_next ? S.afrom(raw0[i], sC[i]) : voffA0[i]; nvoffA1[i] = has_next ? ((nxt.half & 2) ? 0u : S.afrom(raw1[i], sC[i])) : voffA1[i]; }
            Unit u2;
            if (S.next(ui + 2, u2)) {
#pragma unroll
                for (int i = 0; i < 2; ++i) { raw0[i] = S.araw(u2, 0, sR[i]); raw1[i] = (u2.half & 2) ? 0 : S.araw(u2, 1, sR[i]); }
            }
        } else {
#pragma unroll
            for (int i = 0; i < 2; ++i) nvoffA1[i] = (nxt.half & 2) ? 0u : voffA0[i];
        }
#pragma unroll
        for (int i = 0; i < 2; ++i) nB1[i] = (nxt.half & 1) ? 0u : voffB[i];
        const bool liveB = !(cur.half & 1), liveA = !(cur.half & 2), liveAB = cur.half == 0;
        for (int t = 0; t < nt; t += 2) {
            const bool last = (t == nt - 2);
            const char* a1h1 = cur.a1 + (size_t)(t + 1) * kstep;
            const char* a2h0 = last ? nxt.a0 : cur.a0 + (size_t)(t + 2) * kstep; const char* a2h1 = last ? nxt.a1 : cur.a1 + (size_t)(t + 2) * kstep;
            const char* b2h0 = last ? nxt.b0 : cur.b0 + (size_t)(t + 2) * kstep; const char* b2h1 = last ? nxt.b1 : cur.b1 + (size_t)(t + 2) * kstep;
            const char* a3h0 = a2h0 + kstep; const char* b3h0 = b2h0 + kstep; const char* b3h1 = b2h1 + kstep;
            unsigned v2a0[2], v2a1[2], v2b1[2];
#pragma unroll
            for (int i = 0; i < 2; ++i) { v2a0[i] = (GATHER && last) ? nvoffA0[i] : voffA0[i]; v2a1[i] = last ? nvoffA1[i] : voffA1[i]; v2b1[i] = last ? nB1[i] : cB1[i]; }
            G8_LDB(B0, 0, 0); G8_SCHED; G8_LDA(At, 0, 0); G8_STAGE(G8_SA(1, 1), a1h1, voffA1);
            G8_WAIT_L(8); G8_BAR; G8_WAIT_L(0); G8_MMA(0, 0, At, B0); G8_BAR; G8_SCHED;
            G8_LDB(B1, 0, 1); G8_STAGE(G8_SB(0, 0), b2h0, voffB);
            G8_BAR; G8_WAIT_L(0); if (liveB) G8_MMA(0, 1, At, B1); G8_BAR;
            G8_LDA(At, 0, 1); G8_STAGE(G8_SA(0, 0), a2h0, v2a0);
            G8_BAR; G8_WAIT_L(0); if (liveA) G8_MMA(1, 0, At, B0); G8_BAR; G8_SCHED;
            G8_STAGE(G8_SB(0, 1), b2h1, v2b1);
            G8_WAIT_V(6); G8_BAR; if (liveAB) G8_MMA(1, 1, At, B1); G8_BAR;
            G8_LDB(B0, 1, 0); G8_SCHED; G8_LDA(At, 1, 0); G8_STAGE(G8_SA(0, 1), a2h1, v2a1);
            G8_WAIT_L(8); G8_BAR; G8_WAIT_L(0); G8_MMA(0, 0, At, B0); G8_BAR; G8_SCHED;
            G8_LDB(B1, 1, 1); G8_STAGE(G8_SB(1, 0), b3h0, voffB);
            G8_BAR; G8_WAIT_L(0); if (liveB) G8_MMA(0, 1, At, B1); G8_BAR;
            G8_LDA(At, 1, 1); G8_STAGE(G8_SA(1, 0), a3h0, v2a0);
            G8_BAR; G8_WAIT_L(0); if (liveA) G8_MMA(1, 0, At, B0); G8_BAR; G8_SCHED;
            G8_STAGE(G8_SB(1, 1), b3h1, v2b1);
            G8_WAIT_V(6); G8_BAR; if (liveAB) G8_MMA(1, 1, At, B1); G8_BAR;
        }
        E(acc, cur, wr, wc, fr, fq);
        if (!has_next) break;
#pragma unroll
        for (int a = 0; a < 2; ++a)
#pragma unroll
            for (int b = 0; b < 2; ++b)
#pragma unroll
                for (int m = 0; m < 4; ++m)
#pragma unroll
                    for (int n = 0; n < 2; ++n) acc[a][b][m][n] = (f32x4){0.f, 0.f, 0.f, 0.f};
        cur = nxt; ++ui;
#pragma unroll
        for (int i = 0; i < 2; ++i) { if (GATHER) voffA0[i] = nvoffA0[i]; voffA1[i] = nvoffA1[i]; cB1[i] = nB1[i]; }
    }
    G8_WAIT_V(0);
    if (wr == 0) G8_BAR;
    G8_BAR;
#undef G8_SA
#undef G8_SB
#undef G8_STAGE
#undef G8_LDA
#undef G8_LDB
#undef G8_MMA
#undef G8_WAIT_V
#undef G8_WAIT_L
#undef G8_BAR
#undef G8_SCHED
}
}

__device__ __forceinline__ void transpose_tile(const float* __restrict__ src, bf16_t* __restrict__ dst, int K, int N, int kt, int nt, float* tile) {
    const int t = threadIdx.x;
    {
        const int k = t >> 3, n4 = (t & 7) * 4;
        const int n = nt * 64 + n4;
        f32x4 v0 = (f32x4){0.f, 0.f, 0.f, 0.f}, v1 = v0;
        const float* sp = src + (size_t)(kt * 64 + k) * N + n;
        if (n < N) v0 = *(const f32x4*)sp;
        if (n + 32 < N) v1 = *(const f32x4*)(sp + 32);
        float* tp = tile + k * 65 + n4;
        tp[0] = v0[0]; tp[1] = v0[1]; tp[2] = v0[2]; tp[3] = v0[3];
        tp[32] = v1[0]; tp[33] = v1[1]; tp[34] = v1[2]; tp[35] = v1[3];
    }
    __syncthreads();
    {
        const int n = t >> 3, k8 = (t & 7) * 8;
        if (nt * 64 + n < N) {
            uint4 o;
            o.x = pack2(tile[(k8 + 0) * 65 + n], tile[(k8 + 1) * 65 + n]);
            o.y = pack2(tile[(k8 + 2) * 65 + n], tile[(k8 + 3) * 65 + n]);
            o.z = pack2(tile[(k8 + 4) * 65 + n], tile[(k8 + 5) * 65 + n]);
            o.w = pack2(tile[(k8 + 6) * 65 + n], tile[(k8 + 7) * 65 + n]);
            *(uint4*)(dst + (size_t)(nt * 64 + n) * K + kt * 64 + k8) = o;
        }
    }
    __syncthreads();
}

__device__ __forceinline__ void adaln_unit(const Params& p, int u, float* lds) {
    float* sc = lds;
    float* red = lds + 9216;
    const int t = threadIdx.x;
    for (int i = t; i < 9216; i += NTHR) {
        const int r = i >> 10, k = i & 1023;
        const float v = (r < 8) ? p.in[1][r * 1024 + k] : p.in[3][k];
        sc[i] = siluf(v);
    }
    __syncthreads();
    const int w = t >> 6, lane = t & 63;
    const int l = u / 96, nc = u % 96;
    const float* W = p.in[4] + (size_t)l * 1024 * 6144 + nc * 64 + lane;
    float acc[9];
#pragma unroll
    for (int r = 0; r < 9; ++r) acc[r] = 0.f;
#pragma unroll 8
    for (int k = w * 128; k < w * 128 + 128; ++k) {
        const float wv = W[(size_t)k * 6144];
#pragma unroll
        for (int r = 0; r < 9; ++r) acc[r] += sc[r * 1024 + k] * wv;
    }
#pragma unroll
    for (int r = 0; r < 9; ++r) red[(w * 9 + r) * 64 + lane] = acc[r];
    __syncthreads();
    float* mod = (float*)(p.ws + OFF_MOD);
    for (int i = t; i < 576; i += NTHR) {
        const int r = i >> 6, ln = i & 63;
        float s = 0.f;
#pragma unroll
        for (int w2 = 0; w2 < 8; ++w2) s += red[(w2 * 9 + r) * 64 + ln];
        const int n = nc * 64 + ln;
        mod[(size_t)(l * 9 + r) * 6144 + n] = s + p.in[5][l * 6144 + n];
    }
    __syncthreads();
}

__device__ __forceinline__ void phase0(const Params& p, char* lds) {
    constexpr int T_WIN0 = 16 * 63, T_WOUT = 16 * 16, T_WIN1 = 16 * 24;
    constexpr int U0 = 193, U1 = U0 + T_WIN0, U2 = U1 + T_WOUT, U3 = U2 + T_WIN1, U4 = U3 + T_WOUT;
    for (int u = blockIdx.x; u < U4 + 49; u += gridDim.x) {
        if (u < 192) {
            adaln_unit(p, u, (float*)lds);
        } else if (u == 192) {
            float* rope = (float*)(p.ws + OFF_ROPE);
            for (int idx = threadIdx.x; idx < 1024; idx += NTHR) {
                const int pos = idx >> 4, i = idx & 15;
                const double inv = pow(10000.0, -(double)i / 16.0);
                const double ang = (double)pos * inv;
                rope[idx] = (float)cos(ang);
                rope[1024 + idx] = (float)sin(ang);
            }
        } else if (u < U1) {
            const int v = u - U0;
            transpose_tile(p.in[8], (bf16_t*)(p.ws + OFF_WIN0), 1024, EIN, v / 63, v % 63, (float*)lds);
        } else if (u < U2) {
            const int v = u - U1;
            transpose_tile(p.in[9], (bf16_t*)(p.ws + OFF_WOUT0), 1024, 1024, v / 16, v % 16, (float*)lds);
        } else if (u < U3) {
            const int v = u - U2;
            transpose_tile(p.in[25], (bf16_t*)(p.ws + OFF_WIN1), 1024, 1536, v / 24, v % 24, (float*)lds);
        } else if (u < U4) {
            const int v = u - U3;
            transpose_tile(p.in[26], (bf16_t*)(p.ws + OFF_WOUT1), 1024, 1024, v / 16, v % 16, (float*)lds);
        } else if (u == U4 + 48) {
            uint4* z = (uint4*)(p.ws + OFF_WIN0 + (size_t)EIN * 1024 * 2);
            for (int i = threadIdx.x; i < (4096 - EIN) * 1024 * 2 / 16; i += NTHR) z[i] = make_uint4(0u, 0u, 0u, 0u);
        } else {
            const int v = u - U4;
            bf16_t* LW = (bf16_t*)(p.ws + OFF_LORA);
            if (v < 16) transpose_tile(p.in[12] + (v >> 3) * 64 * 512, LW + (v >> 3) * 32768, 64, 512, 0, v & 7, (float*)lds);
            else if (v < 32) transpose_tile(p.in[14] + ((v - 16) >> 3) * 64 * 512, LW + 65536 + ((v - 16) >> 3) * 32768, 64, 512, 0, v & 7, (float*)lds);
            else transpose_tile(p.in[15], LW + 131072, 128, 512, (v - 32) >> 3, v & 7, (float*)lds);
        }
    }
}

__device__ __forceinline__ void convert_moe(const Params& p, int layer, char* lds, int first, int count) {
    const int me = (int)blockIdx.x - first;
    if (me < 0 || me >= count) return;
    bf16_t* dstb = (bf16_t*)(p.ws + M_W);
    float* tile = (float*)lds;
    const int t = threadIdx.x;
    const int k = t >> 3, n4 = (t & 7) * 4;
    constexpr int NT = 48 * 256;
    const int stride = count * 4;
    f32x4 a0[4], a1[4], b0[4], b1[4], c0[4], c1[4];
    auto fetch = [&](int u0, f32x4 (&v0)[4], f32x4 (&v1)[4]) {
#pragma unroll
        for (int q = 0; q < 4; ++q) {
            const int u = u0 + q, mat = u >> 8, tl = u & 255;
            const float* src = p.in[29 + (mat >> 4)] + (size_t)(layer * 16 + (mat & 15)) * 1024 * 1024;
            const float* sp = src + (size_t)((tl >> 4) * 64 + k) * 1024 + (tl & 15) * 64 + n4;
            v0[q] = *(const f32x4*)sp; v1[q] = *(const f32x4*)(sp + 32);
        }
    };
    auto to_lds = [&](const f32x4 (&v0)[4], const f32x4 (&v1)[4]) {
#pragma unroll
        for (int q = 0; q < 4; ++q) {
            float* tp = tile + q * 4160 + k * 65 + n4;
            tp[0] = v0[q][0]; tp[1] = v0[q][1]; tp[2] = v0[q][2]; tp[3] = v0[q][3];
            tp[32] = v1[q][0]; tp[33] = v1[q][1]; tp[34] = v1[q][2]; tp[35] = v1[q][3];
        }
    };
    auto store = [&](int u0) {
        const int n = t >> 3, k8 = (t & 7) * 8;
#pragma unroll
        for (int q = 0; q < 4; ++q) {
            const int u = u0 + q, mat = u >> 8, tl = u & 255;
            const float* tq = tile + q * 4160;
            uint4 o;
            o.x = pack2(tq[(k8 + 0) * 65 + n], tq[(k8 + 1) * 65 + n]);
            o.y = pack2(tq[(k8 + 2) * 65 + n], tq[(k8 + 3) * 65 + n]);
            o.z = pack2(tq[(k8 + 4) * 65 + n], tq[(k8 + 5) * 65 + n]);
            o.w = pack2(tq[(k8 + 6) * 65 + n], tq[(k8 + 7) * 65 + n]);
            *(uint4*)(dstb + (size_t)mat * 1024 * 1024 + (size_t)((tl & 15) * 64 + n) * 1024 + (tl >> 4) * 64 + k8) = o;
        }
    };
    int u0 = me * 4;
    if (u0 < NT) fetch(u0, a0, a1);
    if (u0 + stride < NT) fetch(u0 + stride, b0, b1);
    if (u0 + 2 * stride < NT) fetch(u0 + 2 * stride, c0, c1);
    for (; u0 < NT; u0 += 3 * stride) {
        to_lds(a0, a1);
        if (u0 + 3 * stride < NT) fetch(u0 + 3 * stride, a0, a1);
        __syncthreads();
        store(u0);
        __syncthreads();
        if (u0 + stride >= NT) break;
        to_lds(b0, b1);
        if (u0 + 4 * stride < NT) fetch(u0 + 4 * stride, b0, b1);
        __syncthreads();
        store(u0 + stride);
        __syncthreads();
        if (u0 + 2 * stride >= NT) break;
        to_lds(c0, c1);
        if (u0 + 5 * stride < NT) fetch(u0 + 5 * stride, c0, c1);
        __syncthreads();
        store(u0 + 2 * stride);
        __syncthreads();
    }
}

__device__ __forceinline__ void load_row(const float* src, int lane, f32x4 (&x)[4]) {
#pragma unroll
    for (int i = 0; i < 4; ++i) x[i] = *(const f32x4*)(src + 4 * lane + 256 * i);
}
__device__ __forceinline__ float row_rs(const f32x4 (&x)[4]) {
    float ss = 0.f;
#pragma unroll
    for (int i = 0; i < 4; ++i) ss += x[i][0] * x[i][0] + x[i][1] * x[i][1] + x[i][2] * x[i][2] + x[i][3] * x[i][3];
    ss = wave_sum(ss);
    return rsqrtf(ss * (1.f / 1024.f) + 1e-6f);
}
__device__ __forceinline__ void norm_mod(const f32x4 (&x)[4], const float* gain, const float* shift, const float* scale, int lane, f32x4 (&h)[4]) {
    const float rs = row_rs(x);
#pragma unroll
    for (int i = 0; i < 4; ++i) {
        const int c = 4 * lane + 256 * i;
        const f32x4 g = *(const f32x4*)(gain + c), sh = *(const f32x4*)(shift + c), sc = *(const f32x4*)(scale + c);
        h[i] = x[i] * rs * g * (1.f + sc) + sh;
    }
}
__device__ __forceinline__ void store_h(bf16_t* dst, int lane, const f32x4 (&h)[4]) {
#pragma unroll
    for (int i = 0; i < 4; ++i) {
        uint2 o;
        o.x = pack2(h[i][0], h[i][1]);
        o.y = pack2(h[i][2], h[i][3]);
        *(uint2*)(dst + 4 * lane + 256 * i) = o;
    }
}
__device__ __forceinline__ void router_row(const f32x4 (&h)[4], const float* rt, int lane, float* aff) {
    float mylog = 0.f;
#pragma unroll 2
    for (int e = 0; e < 16; ++e) {
        f32x4 a = (f32x4){0.f, 0.f, 0.f, 0.f};
#pragma unroll
        for (int i = 0; i < 4; ++i) a += h[i] * *(const f32x4*)(rt + e * 1024 + 4 * lane + 256 * i);
        const float v = wave_sum((a[0] + a[1]) + (a[2] + a[3]));
        mylog = ((lane & 15) == e) ? v : mylog;
    }
    float mx = mylog;
    mx = fmaxf(mx, __shfl_xor(mx, 1)); mx = fmaxf(mx, __shfl_xor(mx, 2)); mx = fmaxf(mx, __shfl_xor(mx, 4)); mx = fmaxf(mx, __shfl_xor(mx, 8));
    const float ex = expf(mylog - mx);
    float sum = ex;
    sum += __shfl_xor(sum, 1); sum += __shfl_xor(sum, 2); sum += __shfl_xor(sum, 4); sum += __shfl_xor(sum, 8);
    if (lane < 16) aff[lane] = ex / sum;
}

__device__ __forceinline__ void phase1(const Params& p) {
    const int lane = threadIdx.x & 63, wg = blockIdx.x * 8 + (threadIdx.x >> 6), nw = gridDim.x * 8;
    bf16_t* H = (bf16_t*)(p.ws + OFF_H);
    f32x4 xn[4];
    if (wg < NTOK) load_row(xin_row(p, wg), lane, xn);
    for (int R = wg; R < NTOK; R += nw) {
        f32x4 x[4], h[4];
#pragma unroll
        for (int i = 0; i < 4; ++i) x[i] = xn[i];
        if (R + nw < NTOK) load_row(xin_row(p, R + nw), lane, xn);
        const int mr = mod_row(R);
        norm_mod(x, p.in[6], mod_ptr(p, 0, mr, 0), mod_ptr(p, 0, mr, 1), lane, h);
        store_h(H + (size_t)R * DM, lane, h);
    }
}

__device__ __forceinline__ f32x4 ld_bf4(const bf16_t* q) {
    const uint2 v = *(const uint2*)q;
    return (f32x4){bf2f((bf16_t)(v.x & 0xffff)), bf2f((bf16_t)(v.x >> 16)), bf2f((bf16_t)(v.y & 0xffff)), bf2f((bf16_t)(v.y >> 16))};
}
__device__ __forceinline__ void st_bf4(bf16_t* q, f32x4 v) {
    uint2 o; o.x = pack2(v[0], v[1]); o.y = pack2(v[2], v[3]);
    *(uint2*)q = o;
}
struct Sched2 {
    const char* H; const char* W;
    __device__ __forceinline__ bool next(int i, g8::Unit& u) const {
        int L, sub, pieces; if (!g8::tail_split(i, 72 * 16, 2, L, sub, pieces)) return false;
        int pm, pn; g8::grid_order_L(L, 72, 16, pm, pn);
        u.pm = pm; u.pn = pn; u.e = 0; u.mh = 0; u.nh = sub; u.half = pieces == 2 ? 1 : 0;
        u.a0 = H + (size_t)pm * 256 * DM * 2; u.a1 = u.a0 + (size_t)128 * DM * 2;
        u.b0 = W + (size_t)(pn * 256 + sub * 128) * DM * 2; u.b1 = u.half ? u.b0 : u.b0 + (size_t)128 * DM * 2;
        return true;
    }
    __device__ __forceinline__ unsigned aoff(const g8::Unit&, int, int, int) const { return 0u; }
    __device__ __forceinline__ int araw(const g8::Unit&, int, int) const { return 0; }
    __device__ __forceinline__ unsigned afrom(int, int) const { return 0u; }
};
struct Epi2 {
    static constexpr bool PERM = true;
    bf16_t* P;
    __device__ __forceinline__ void operator()(const f32x4 (&acc)[2][2][4][2], const g8::Unit& u, int wr, int wc, int fr, int fq) const {
#pragma unroll
        for (int ai = 0; ai < 2; ++ai)
#pragma unroll
            for (int m = 0; m < 4; ++m) {
                const int row = u.pm * 256 + ai * 128 + wr * 64 + m * 16 + fr;
#pragma unroll
                for (int bj = 0; bj < 2; ++bj) {
                    const int col = u.pn * 256 + (bj + u.nh) * 128 + wc * 32 + 8 * fq;
                    if (col < EIN && !(bj == 1 && (u.half & 1))) {
                        const uint2 t0 = pk4(acc[ai][bj][m][0]), t1 = pk4(acc[ai][bj][m][1]);
                        *(uint4*)(P + (size_t)row * EIN + col) = make_uint4(t0.x, t0.y, t1.x, t1.y);
                    }
                }
            }
    }
};
__device__ __forceinline__ void phase2(const Params& p, char* lds) {
    Sched2 S{p.ws + OFF_H, p.ws + OFF_WIN0};
    Epi2 E{(bf16_t*)(p.ws + B_P)};
    g8::gemm_phase<false>((LAS unsigned char*)lds, DM, S, E);
}

__device__ __forceinline__ f32x4 sigm4(f32x4 x) { return (f32x4){sigm(x[0]), sigm(x[1]), sigm(x[2]), sigm(x[3])}; }
__device__ __forceinline__ f32x4 shifted4(const bf16_t* P, int R, int s, int lo, int hi, int c, const float* mu) {
    const f32x4 pc = ld_bf4(P + (size_t)R * EIN + c);
    f32x4 pm = (f32x4){0.f, 0.f, 0.f, 0.f}, pp = pm;
    if (s - 1 >= lo) pm = ld_bf4(P + (size_t)(R - 1) * EIN + c);
    if (s + 1 < hi) pp = ld_bf4(P + (size_t)(R + 1) * EIN + c);
    return pc + *(const f32x4*)(mu + c) * (0.5f * (pm + pp) - pc);
}
__device__ __forceinline__ void unpack8(const uint4 v, float (&f)[8]) {
    f[0] = bf2f((bf16_t)(v.x & 0xffff)); f[1] = bf2f((bf16_t)(v.x >> 16)); f[2] = bf2f((bf16_t)(v.y & 0xffff)); f[3] = bf2f((bf16_t)(v.y >> 16));
    f[4] = bf2f((bf16_t)(v.z & 0xffff)); f[5] = bf2f((bf16_t)(v.z >> 16)); f[6] = bf2f((bf16_t)(v.w & 0xffff)); f[7] = bf2f((bf16_t)(v.w >> 16));
}

__device__ __forceinline__ void phase3a(const Params& p, char* lds) {
    const bf16_t* P = (const bf16_t*)(p.ws + B_P);
    bf16_t* EW = (bf16_t*)(p.ws + B_EW); bf16_t* KD = (bf16_t*)(p.ws + B_KD); bf16_t* BD = (bf16_t*)(p.ws + B_BD);
    bf16_t* RR = (bf16_t*)(p.ws + B_RR); bf16_t* KK = (bf16_t*)(p.ws + B_KK); bf16_t* VV = (bf16_t*)(p.ws + B_VV); bf16_t* GG = (bf16_t*)(p.ws + B_GG);
    bf16_t* GQ = (bf16_t*)(p.ws + B_GQ); bf16_t* GK = (bf16_t*)(p.ws + B_GK); bf16_t* GV = (bf16_t*)(p.ws + B_GV);
    float* BC = (float*)(p.ws + B_BC); float* GDG = (float*)(p.ws + B_GDG); float* GDB = (float*)(p.ws + B_GDB);
    bf16_t* LIN = (bf16_t*)(p.ws + OFF_H);
    constexpr int PT = 16, LROW = 784;
    const int t = threadIdx.x, lane = t & 63, w = t >> 6, fr = lane & 15, fq = lane >> 4;
    const float* mu = p.in[10];
    for (int u = blockIdx.x; u < NB * (TT / PT); u += gridDim.x) {
        const int b = u / (TT / PT), s0 = (u % (TT / PT)) * PT;
        const int lo = (s0 < LC) ? 0 : LC, hi = (s0 < LC) ? LC : TT;
        const int R0 = b * TT + s0;
        for (int gi = t; gi < PT * 48; gi += NTHR) {
            const int tok = gi / 48, c8 = (gi % 48) * 8;
            const int col = 1536 + c8, R = R0 + tok, s = s0 + tok;
            float pc[8], pm[8], pp[8];
            unpack8(*(const uint4*)(P + (size_t)R * EIN + col), pc);
#pragma unroll
            for (int j = 0; j < 8; ++j) { pm[j] = 0.f; pp[j] = 0.f; }
            if (s - 1 >= lo) unpack8(*(const uint4*)(P + (size_t)(R - 1) * EIN + col), pm);
            if (s + 1 < hi) unpack8(*(const uint4*)(P + (size_t)(R + 1) * EIN + col), pp);
            float v[8];
#pragma unroll
            for (int j = 0; j < 8; ++j) {
                float x = pc[j] + mu[col + j] * (0.5f * (pm[j] + pp[j]) - pc[j]);
                if (c8 < 128) x = tanhf(x);
                else if (c8 >= 256) x = sigm(x);
                v[j] = x;
            }
            uint4 o; o.x = pack2(v[0], v[1]); o.y = pack2(v[2], v[3]); o.z = pack2(v[4], v[5]); o.w = pack2(v[6], v[7]);
            *(uint4*)(LIN + (size_t)R * 384 + c8) = o;
        }
        if (t < 384) {
            const int cg = t % 192, seg = t / 192;
            const int ch = cg * 8;
            const float* cw = p.in[21];
            float wj[5][8];
#pragma unroll
            for (int j = 0; j < 5; ++j) {
                const f32x4 w0 = *(const f32x4*)(cw + j * 1536 + ch), w1 = *(const f32x4*)(cw + j * 1536 + ch + 4);
                wj[j][0] = w0[0]; wj[j][1] = w0[1]; wj[j][2] = w0[2]; wj[j][3] = w0[3]; wj[j][4] = w1[0]; wj[j][5] = w1[1]; wj[j][6] = w1[2]; wj[j][7] = w1[3];
            }
            const int typ = cg >> 6;
            const int sb = s0 + seg * 8 - 2;
            const bf16_t* Pc = P + (size_t)(b * TT) * EIN + 1920 + ch;
            uint4 r0 = make_uint4(0u, 0u, 0u, 0u), r1 = r0, r2 = r0, r3 = r0, r4 = r0;
            if (sb + 0 >= lo && sb + 0 < hi) r0 = *(const uint4*)(Pc + (size_t)(sb + 0) * EIN);
            if (sb + 1 >= lo && sb + 1 < hi) r1 = *(const uint4*)(Pc + (size_t)(sb + 1) * EIN);
            if (sb + 2 >= lo && sb + 2 < hi) r2 = *(const uint4*)(Pc + (size_t)(sb + 2) * EIN);
            if (sb + 3 >= lo && sb + 3 < hi) r3 = *(const uint4*)(Pc + (size_t)(sb + 3) * EIN);
            if (sb + 4 >= lo && sb + 4 < hi) r4 = *(const uint4*)(Pc + (size_t)(sb + 4) * EIN);
#pragma unroll 1
            for (int k = 0; k < 8; ++k) {
                const int sn = sb + k + 5;
                uint4 nxt = make_uint4(0u, 0u, 0u, 0u);
                if (sn >= lo && sn < hi) nxt = *(const uint4*)(Pc + (size_t)sn * EIN);
                float a[8], x[8];
                unpack8(r0, x);
#pragma unroll
                for (int i = 0; i < 8; ++i) a[i] = x[i] * wj[0][i];
                unpack8(r1, x);
#pragma unroll
                for (int i = 0; i < 8; ++i) a[i] += x[i] * wj[1][i];
                unpack8(r2, x);
#pragma unroll
                for (int i = 0; i < 8; ++i) a[i] += x[i] * wj[2][i];
                unpack8(r3, x);
#pragma unroll
                for (int i = 0; i < 8; ++i) a[i] += x[i] * wj[3][i];
                unpack8(r4, x);
#pragma unroll
                for (int i = 0; i < 8; ++i) a[i] += x[i] * wj[4][i];
                float ssq = 0.f;
#pragma unroll
                for (int i = 0; i < 8; ++i) { a[i] = siluf(a[i]); ssq += a[i] * a[i]; }
                ssq = red16(ssq);
                float sc = 1.f;
                if (typ == 0) sc = rsqrtf(ssq + 1e-6f) * 0.08838834764831845f;
                else if (typ == 1) sc = rsqrtf(ssq + 1e-6f);
                uint4 o; o.x = pack2(a[0] * sc, a[1] * sc); o.y = pack2(a[2] * sc, a[3] * sc); o.z = pack2(a[4] * sc, a[5] * sc); o.w = pack2(a[6] * sc, a[7] * sc);
                bf16_t* dst = (typ == 0 ? GQ : (typ == 1 ? GK : GV)) + (size_t)(R0 + seg * 8 + k) * 512 + (ch & 511);
                *(uint4*)dst = o;
                r0 = r1; r1 = r2; r2 = r3; r3 = r4; r4 = nxt;
            }
        } else {
            const int tt = t - 384;
            {
                bf16_t* ZZ = (bf16_t*)(p.ws + B_ZZ);
#pragma unroll
                for (int q = 0; q < 8; ++q) {
                    const int pc = tt * 8 + q, k = pc >> 6, c8 = (pc & 63) * 8;
                    *(uint4*)(ZZ + (size_t)(R0 + k) * 512 + c8) = *(const uint4*)(P + (size_t)(R0 + k) * EIN + 3472 + c8);
                }
            }
#pragma unroll
            for (int q = 0; q < 2; ++q) {
                const int idx = tt * 2 + q, k = idx >> 4, j = idx & 15;
                const int R = R0 + k;
                if (j < 8) {
                    const float al = bf2f(P[(size_t)R * EIN + 3456 + j]);
                    GDG[(size_t)R * 8 + j] = -expf(p.in[22][j]) * softplusf(al + p.in[23][j]);
                } else {
                    const float be = bf2f(P[(size_t)R * EIN + 3464 + (j - 8)]);
                    GDB[(size_t)R * 8 + (j - 8)] = sigm(be);
                }
            }
        }
    }
}


__device__ __forceinline__ void phase3b(const Params& p, char* lds) {
    const bf16_t* P = (const bf16_t*)(p.ws + B_P);
    bf16_t* EW = (bf16_t*)(p.ws + B_EW); bf16_t* KD = (bf16_t*)(p.ws + B_KD); bf16_t* BD = (bf16_t*)(p.ws + B_BD);
    bf16_t* RR = (bf16_t*)(p.ws + B_RR); bf16_t* KK = (bf16_t*)(p.ws + B_KK); bf16_t* VV = (bf16_t*)(p.ws + B_VV); bf16_t* GG = (bf16_t*)(p.ws + B_GG);
    float* BC = (float*)(p.ws + B_BC);
    const bf16_t* LW = (const bf16_t*)(p.ws + OFF_LORA);
    const bf16_t* LIN = (const bf16_t*)(p.ws + OFF_H);
    const int t = threadIdx.x, lane = t & 63, w = t >> 6, fr = lane & 15, fq = lane >> 4;
    const float* mu = p.in[10];
    const int hd = blockIdx.x & 7, grp = blockIdx.x >> 3, ngrp = gridDim.x >> 3;
    for (int i = t; i < 4 * 64 * 8; i += NTHR) {
        const int mtx = i >> 9, row = (i >> 3) & 63, c16 = i & 7;
        *(uint4*)(lds + mtx * 64 * 144 + row * 144 + c16 * 16) = *(const uint4*)(LW + (size_t)mtx * 32768 + (size_t)(64 * hd + row) * 64 + c16 * 8);
    }
    for (int i = t; i < 64 * 16; i += NTHR) {
        const int row = i >> 4, c16 = i & 15;
        *(uint4*)(lds + 4 * 64 * 144 + row * 272 + c16 * 16) = *(const uint4*)(LW + 131072 + (size_t)(64 * hd + row) * 128 + c16 * 8);
    }
    __syncthreads();
    if (grp < ngrp) {
        for (int tile = grp * 8 + w; tile < NB * (TT / 16); tile += ngrp * 8) {
            const int b = tile / (TT / 16), s0 = (tile % (TT / 16)) * 16;
            const int lo = (s0 < LC) ? 0 : LC, hi = (s0 < LC) ? LC : TT;
            const int R0 = b * TT + s0;
        {
            const int cb = 64 * hd;
            const int R = R0 + fr, s = s0 + fr;
            const int c0 = cb + 16 * fq;
            const char* Wl = lds + (16 * (fr >> 2) + (fr & 3)) * 144 + fq * 16;
            const char* Wg = lds + 4 * 64 * 144 + (16 * (fr >> 2) + (fr & 3)) * 272 + fq * 16;
            const bf16_t* Lrow = LIN + (size_t)R * 384 + 8 * fq;
            f32x4 rq[4], kq[4], kkn[4];
            float ss = 0.f;
            {
                auto shift16 = [&](int which, f32x4 (&o)[4]) {
                    const bf16_t* pc = P + (size_t)R * EIN + which * 512 + c0;
#pragma unroll
                    for (int hh = 0; hh < 2; ++hh) {
                        float xc[8], xm[8], xp[8];
                        unpack8(*(const uint4*)(pc + 8 * hh), xc);
#pragma unroll
                        for (int j = 0; j < 8; ++j) { xm[j] = 0.f; xp[j] = 0.f; }
                        if (s - 1 >= lo) unpack8(*(const uint4*)(pc - EIN + 8 * hh), xm);
                        if (s + 1 < hi) unpack8(*(const uint4*)(pc + EIN + 8 * hh), xp);
                        const f32x4 m0 = *(const f32x4*)(mu + which * 512 + c0 + 8 * hh), m1 = *(const f32x4*)(mu + which * 512 + c0 + 8 * hh + 4);
#pragma unroll
                        for (int j = 0; j < 4; ++j) {
                            o[2 * hh][j] = xc[j] + m0[j] * (0.5f * (xm[j] + xp[j]) - xc[j]);
                            o[2 * hh + 1][j] = xc[4 + j] + m1[j] * (0.5f * (xm[4 + j] + xp[4 + j]) - xc[4 + j]);
                        }
                    }
                };
                auto store16 = [&](bf16_t* dst, const f32x4 (&o)[4]) {
                    const uint2 t0 = pk4(o[0]), t1 = pk4(o[1]), t2 = pk4(o[2]), t3 = pk4(o[3]);
                    *(uint4*)dst = make_uint4(t0.x, t0.y, t1.x, t1.y); *(uint4*)(dst + 8) = make_uint4(t2.x, t2.y, t3.x, t3.y);
                };
                { f32x4 vq[4]; shift16(2, vq); store16(VV + (size_t)R * 512 + c0, vq); }
                shift16(0, rq); store16(RR + (size_t)R * 512 + c0, rq);
                shift16(1, kq);
#pragma unroll
                for (int ni = 0; ni < 4; ++ni) {
                    kkn[ni] = kq[ni] * *(const f32x4*)(p.in[16] + c0 + 4 * ni);
                    ss += kkn[ni][0] * kkn[ni][0] + kkn[ni][1] * kkn[ni][1] + kkn[ni][2] * kkn[ni][2] + kkn[ni][3] * kkn[ni][3];
                }
            }
            ss += __shfl_xor(ss, 16); ss += __shfl_xor(ss, 32);
            const float rn = rsqrtf(ss + 1e-6f);
#pragma unroll
            for (int ni = 0; ni < 4; ++ni) kkn[ni] *= rn;
            { uint4 o0, o1; uint2 t0 = pk4(kkn[0]), t1 = pk4(kkn[1]), t2 = pk4(kkn[2]), t3 = pk4(kkn[3]);
              o0 = make_uint4(t0.x, t0.y, t1.x, t1.y); o1 = make_uint4(t2.x, t2.y, t3.x, t3.y);
              *(uint4*)(KK + (size_t)R * 512 + c0) = o0; *(uint4*)(KK + (size_t)R * 512 + c0 + 8) = o1; }
            float bon = 0.f;
#pragma unroll
            for (int d = 0; d < 2; ++d) {
                f32x4 acc[4];
#pragma unroll
                for (int ni = 0; ni < 4; ++ni) acc[ni] = (f32x4){0.f, 0.f, 0.f, 0.f};
#pragma unroll
                for (int kk = 0; kk < 2; ++kk) {
                    const bf16x8 af = *(const bf16x8*)(Lrow + 128 + 64 * d + 32 * kk);
#pragma unroll
                    for (int ni = 0; ni < 4; ++ni) {
                        const bf16x8 bfr = *(const bf16x8*)(Wl + (2 + d) * 64 * 144 + ni * 4 * 144 + kk * 64);
                        acc[ni] = __builtin_amdgcn_mfma_f32_16x16x32_bf16(bfr, af, acc[ni], 0, 0, 0);
                    }
                }
                f32x4 kdv[4], bdv[4];
#pragma unroll
                for (int ni = 0; ni < 4; ++ni) {
                    const int c = c0 + 4 * ni;
                    const f32x4 a = sigm4(acc[ni] + *(const f32x4*)(p.in[13] + d * 512 + c));
                    kdv[ni] = kq[ni] * (1.f + (a - 1.f) * *(const f32x4*)(p.in[17] + c));
                    bdv[ni] = kkn[ni] * a;
                    const f32x4 bt = rq[ni] * kdv[ni] * *(const f32x4*)(p.in[18] + c);
                    bon += (bt[0] + bt[1]) + (bt[2] + bt[3]);
                }
                { uint2 t0 = pk4(kdv[0]), t1 = pk4(kdv[1]), t2 = pk4(kdv[2]), t3 = pk4(kdv[3]);
                  bf16_t* dst = KD + (size_t)d * NTOK * 512 + (size_t)R * 512 + c0;
                  *(uint4*)dst = make_uint4(t0.x, t0.y, t1.x, t1.y); *(uint4*)(dst + 8) = make_uint4(t2.x, t2.y, t3.x, t3.y); }
                { uint2 t0 = pk4(bdv[0]), t1 = pk4(bdv[1]), t2 = pk4(bdv[2]), t3 = pk4(bdv[3]);
                  bf16_t* dst = BD + (size_t)d * NTOK * 512 + (size_t)R * 512 + c0;
                  *(uint4*)dst = make_uint4(t0.x, t0.y, t1.x, t1.y); *(uint4*)(dst + 8) = make_uint4(t2.x, t2.y, t3.x, t3.y); }
            }
            bon += __shfl_xor(bon, 16); bon += __shfl_xor(bon, 32);
            if (fq == 0) BC[(size_t)R * 8 + hd] = bon;
#pragma unroll
            for (int d = 0; d < 2; ++d) {
                f32x4 acc[4];
#pragma unroll
                for (int ni = 0; ni < 4; ++ni) acc[ni] = (f32x4){0.f, 0.f, 0.f, 0.f};
#pragma unroll
                for (int kk = 0; kk < 2; ++kk) {
                    const bf16x8 af = *(const bf16x8*)(Lrow + 64 * d + 32 * kk);
#pragma unroll
                    for (int ni = 0; ni < 4; ++ni) {
                        const bf16x8 bfr = *(const bf16x8*)(Wl + d * 64 * 144 + ni * 4 * 144 + kk * 64);
                        acc[ni] = __builtin_amdgcn_mfma_f32_16x16x32_bf16(bfr, af, acc[ni], 0, 0, 0);
                    }
                }
                uint2 tq[4];
#pragma unroll
                for (int ni = 0; ni < 4; ++ni) tq[ni] = pk4(0.60653066f * sigm4(acc[ni] + *(const f32x4*)(p.in[11] + d * 512 + c0 + 4 * ni)));
                bf16_t* dst = EW + (size_t)d * NTOK * 512 + (size_t)R * 512 + c0;
                *(uint4*)dst = make_uint4(tq[0].x, tq[0].y, tq[1].x, tq[1].y); *(uint4*)(dst + 8) = make_uint4(tq[2].x, tq[2].y, tq[3].x, tq[3].y);
            }
            {
                f32x4 acc[4];
#pragma unroll
                for (int ni = 0; ni < 4; ++ni) acc[ni] = (f32x4){0.f, 0.f, 0.f, 0.f};
#pragma unroll
                for (int kk = 0; kk < 4; ++kk) {
                    const bf16x8 af = *(const bf16x8*)(Lrow + 256 + 32 * kk);
#pragma unroll
                    for (int ni = 0; ni < 4; ++ni) {
                        const bf16x8 bfr = *(const bf16x8*)(Wg + ni * 4 * 272 + kk * 64);
                        acc[ni] = __builtin_amdgcn_mfma_f32_16x16x32_bf16(bfr, af, acc[ni], 0, 0, 0);
                    }
                }
                uint2 tq[4];
#pragma unroll
                for (int ni = 0; ni < 4; ++ni) tq[ni] = pk4(acc[ni]);
                bf16_t* dst = GG + (size_t)R * 512 + c0;
                *(uint4*)dst = make_uint4(tq[0].x, tq[0].y, tq[1].x, tq[1].y); *(uint4*)(dst + 8) = make_uint4(tq[2].x, tq[2].y, tq[3].x, tq[3].y);
            }
        }
        }
    }
}

__device__ __forceinline__ void phase3(const Params& p, char* lds, const XcdBarrier& xb) {
    phase3a(p, lds);
    xcd_barrier(xb);
    phase3b(p, lds);
}

__device__ __forceinline__ int scan_token(int dir, int j) { return dir == 0 ? j : (j < LC ? (LC - 1 - j) : (TT + LC - 1 - j)); }

__device__ __forceinline__ f32x4 bf4_lo(const uint4 v) { return (f32x4){bf2f((bf16_t)(v.x & 0xffff)), bf2f((bf16_t)(v.x >> 16)), bf2f((bf16_t)(v.y & 0xffff)), bf2f((bf16_t)(v.y >> 16))}; }
__device__ __forceinline__ f32x4 bf4_hi(const uint4 v) { return (f32x4){bf2f((bf16_t)(v.z & 0xffff)), bf2f((bf16_t)(v.z >> 16)), bf2f((bf16_t)(v.w & 0xffff)), bf2f((bf16_t)(v.w >> 16))}; }
__device__ __forceinline__ f32x4 exp4n(f32x4 x) { return (f32x4){expf(-x[0]), expf(-x[1]), expf(-x[2]), expf(-x[3])}; }

__device__ __forceinline__ void dot2r_4(float& d0, float& d1, float a0_0, float a0_1, float a0_2, float a0_3, float a1_0, float a1_1, float a1_2, float a1_3, float x0, float x1, float x2, float x3) {
    asm("v_mul_f32 %0, %2, %10\n\t"
        "v_mul_f32 %1, %6, %10\n\t"
        "v_fma_f32 %0, %3, %11, %0\n\t"
        "v_fma_f32 %1, %7, %11, %1\n\t"
        "v_fma_f32 %0, %4, %12, %0\n\t"
        "v_fma_f32 %1, %8, %12, %1\n\t"
        "v_fma_f32 %0, %5, %13, %0\n\t"
        "v_fma_f32 %1, %9, %13, %1\n\t"
        "s_nop 0\n\t"
        "v_add_f32_dpp %0, %0, %0 quad_perm:[1,0,3,2] row_mask:0xf bank_mask:0xf bound_ctrl:1\n\t"
        "v_add_f32_dpp %1, %1, %1 quad_perm:[1,0,3,2] row_mask:0xf bank_mask:0xf bound_ctrl:1\n\t"
        "s_nop 0\n\t"
        "v_add_f32_dpp %0, %0, %0 quad_perm:[2,3,0,1] row_mask:0xf bank_mask:0xf bound_ctrl:1\n\t"
        "v_add_f32_dpp %1, %1, %1 quad_perm:[2,3,0,1] row_mask:0xf bank_mask:0xf bound_ctrl:1\n\t"
        "s_nop 0\n\t"
        "v_add_f32_dpp %0, %0, %0 row_ror:4 row_mask:0xf bank_mask:0xf bound_ctrl:1\n\t"
        "v_add_f32_dpp %1, %1, %1 row_ror:4 row_mask:0xf bank_mask:0xf bound_ctrl:1\n\t"
        "s_nop 0\n\t"
        "v_add_f32_dpp %0, %0, %0 row_ror:8 row_mask:0xf bank_mask:0xf bound_ctrl:1\n\t"
        "v_add_f32_dpp %1, %1, %1 row_ror:8 row_mask:0xf bank_mask:0xf bound_ctrl:1\n\t"
        "s_nop 1\n\t"
        : "=&v"(d0), "=&v"(d1)
        : "v"(a0_0), "v"(a0_1), "v"(a0_2), "v"(a0_3), "v"(a1_0), "v"(a1_1), "v"(a1_2), "v"(a1_3), "v"(x0), "v"(x1), "v"(x2), "v"(x3));
}

__device__ __forceinline__ void dot2r_8(float& d0, float& d1, float a0_0, float a0_1, float a0_2, float a0_3, float a0_4, float a0_5, float a0_6, float a0_7, float a1_0, float a1_1, float a1_2, float a1_3, float a1_4, float a1_5, float a1_6, float a1_7, float x0, float x1, float x2, float x3, float x4, float x5, float x6, float x7) {
    asm("v_mul_f32 %0, %2, %18\n\t"
        "v_mul_f32 %1, %10, %18\n\t"
        "v_fma_f32 %0, %3, %19, %0\n\t"
        "v_fma_f32 %1, %11, %19, %1\n\t"
        "v_fma_f32 %0, %4, %20, %0\n\t"
        "v_fma_f32 %1, %12, %20, %1\n\t"
        "v_fma_f32 %0, %5, %21, %0\n\t"
        "v_fma_f32 %1, %13, %21, %1\n\t"
        "v_fma_f32 %0, %6, %22, %0\n\t"
        "v_fma_f32 %1, %14, %22, %1\n\t"
        "v_fma_f32 %0, %7, %23, %0\n\t"
        "v_fma_f32 %1, %15, %23, %1\n\t"
        "v_fma_f32 %0, %8, %24, %0\n\t"
        "v_fma_f32 %1, %16, %24, %1\n\t"
        "v_fma_f32 %0, %9, %25, %0\n\t"
        "v_fma_f32 %1, %17, %25, %1\n\t"
        "s_nop 0\n\t"
        "v_add_f32_dpp %0, %0, %0 quad_perm:[1,0,3,2] row_mask:0xf bank_mask:0xf bound_ctrl:1\n\t"
        "v_add_f32_dpp %1, %1, %1 quad_perm:[1,0,3,2] row_mask:0xf bank_mask:0xf bound_ctrl:1\n\t"
        "s_nop 0\n\t"
        "v_add_f32_dpp %0, %0, %0 quad_perm:[2,3,0,1] row_mask:0xf bank_mask:0xf bound_ctrl:1\n\t"
        "v_add_f32_dpp %1, %1, %1 quad_perm:[2,3,0,1] row_mask:0xf bank_mask:0xf bound_ctrl:1\n\t"
        "s_nop 0\n\t"
        "v_add_f32_dpp %0, %0, %0 row_ror:4 row_mask:0xf bank_mask:0xf bound_ctrl:1\n\t"
        "v_add_f32_dpp %1, %1, %1 row_ror:4 row_mask:0xf bank_mask:0xf bound_ctrl:1\n\t"
        "s_nop 0\n\t"
        "v_add_f32_dpp %0, %0, %0 row_ror:8 row_mask:0xf bank_mask:0xf bound_ctrl:1\n\t"
        "v_add_f32_dpp %1, %1, %1 row_ror:8 row_mask:0xf bank_mask:0xf bound_ctrl:1\n\t"
        "s_nop 1\n\t"
        : "=&v"(d0), "=&v"(d1)
        : "v"(a0_0), "v"(a0_1), "v"(a0_2), "v"(a0_3), "v"(a0_4), "v"(a0_5), "v"(a0_6), "v"(a0_7), "v"(a1_0), "v"(a1_1), "v"(a1_2), "v"(a1_3), "v"(a1_4), "v"(a1_5), "v"(a1_6), "v"(a1_7), "v"(x0), "v"(x1), "v"(x2), "v"(x3), "v"(x4), "v"(x5), "v"(x6), "v"(x7));
}

__device__ __forceinline__ void rwkv_upd2(float (&s0)[4], float (&s1)[4], f32x4 w, f32x4 kd, f32x4 bb, float v0, float v1, float sa0, float sa1) {
    float t0, t1;
    asm("v_mul_f32 %8, %22, %14\n\t"
        "v_mul_f32 %9, %23, %14\n\t"
        "v_fma_f32 %8, -%24, %18, %8\n\t"
        "v_fma_f32 %9, -%25, %18, %9\n\t"
        "v_fma_f32 %0, %0, %10, %8\n\t"
        "v_fma_f32 %4, %4, %10, %9\n\t"
        "v_mul_f32 %8, %22, %15\n\t"
        "v_mul_f32 %9, %23, %15\n\t"
        "v_fma_f32 %8, -%24, %19, %8\n\t"
        "v_fma_f32 %9, -%25, %19, %9\n\t"
        "v_fma_f32 %1, %1, %11, %8\n\t"
        "v_fma_f32 %5, %5, %11, %9\n\t"
        "v_mul_f32 %8, %22, %16\n\t"
        "v_mul_f32 %9, %23, %16\n\t"
        "v_fma_f32 %8, -%24, %20, %8\n\t"
        "v_fma_f32 %9, -%25, %20, %9\n\t"
        "v_fma_f32 %2, %2, %12, %8\n\t"
        "v_fma_f32 %6, %6, %12, %9\n\t"
        "v_mul_f32 %8, %22, %17\n\t"
        "v_mul_f32 %9, %23, %17\n\t"
        "v_fma_f32 %8, -%24, %21, %8\n\t"
        "v_fma_f32 %9, -%25, %21, %9\n\t"
        "v_fma_f32 %3, %3, %13, %8\n\t"
        "v_fma_f32 %7, %7, %13, %9\n\t"
        : "+v"(s0[0]), "+v"(s0[1]), "+v"(s0[2]), "+v"(s0[3]), "+v"(s1[0]), "+v"(s1[1]), "+v"(s1[2]), "+v"(s1[3]), "=&v"(t0), "=&v"(t1)
        : "v"(w[0]), "v"(w[1]), "v"(w[2]), "v"(w[3]), "v"(kd[0]), "v"(kd[1]), "v"(kd[2]), "v"(kd[3]), "v"(bb[0]), "v"(bb[1]), "v"(bb[2]), "v"(bb[3]), "v"(v0), "v"(v1), "v"(sa0), "v"(sa1));
}

__device__ __forceinline__ void gdn_upd2(float (&s0)[8], float (&s1)[8], f32x4 ka, f32x4 kb, float eg, float d0, float d1) {
    float t0, t1;
    asm("v_mul_f32 %16, %18, %27\n\t"
        "v_mul_f32 %17, %18, %28\n\t"
        "v_fma_f32 %0, %26, %0, %16\n\t"
        "v_fma_f32 %8, %26, %8, %17\n\t"
        "v_mul_f32 %16, %19, %27\n\t"
        "v_mul_f32 %17, %19, %28\n\t"
        "v_fma_f32 %1, %26, %1, %16\n\t"
        "v_fma_f32 %9, %26, %9, %17\n\t"
        "v_mul_f32 %16, %20, %27\n\t"
        "v_mul_f32 %17, %20, %28\n\t"
        "v_fma_f32 %2, %26, %2, %16\n\t"
        "v_fma_f32 %10, %26, %10, %17\n\t"
        "v_mul_f32 %16, %21, %27\n\t"
        "v_mul_f32 %17, %21, %28\n\t"
        "v_fma_f32 %3, %26, %3, %16\n\t"
        "v_fma_f32 %11, %26, %11, %17\n\t"
        "v_mul_f32 %16, %22, %27\n\t"
        "v_mul_f32 %17, %22, %28\n\t"
        "v_fma_f32 %4, %26, %4, %16\n\t"
        "v_fma_f32 %12, %26, %12, %17\n\t"
        "v_mul_f32 %16, %23, %27\n\t"
        "v_mul_f32 %17, %23, %28\n\t"
        "v_fma_f32 %5, %26, %5, %16\n\t"
        "v_fma_f32 %13, %26, %13, %17\n\t"
        "v_mul_f32 %16, %24, %27\n\t"
        "v_mul_f32 %17, %24, %28\n\t"
        "v_fma_f32 %6, %26, %6, %16\n\t"
        "v_fma_f32 %14, %26, %14, %17\n\t"
        "v_mul_f32 %16, %25, %27\n\t"
        "v_mul_f32 %17, %25, %28\n\t"
        "v_fma_f32 %7, %26, %7, %16\n\t"
        "v_fma_f32 %15, %26, %15, %17\n\t"
        : "+v"(s0[0]), "+v"(s0[1]), "+v"(s0[2]), "+v"(s0[3]), "+v"(s0[4]), "+v"(s0[5]), "+v"(s0[6]), "+v"(s0[7]), "+v"(s1[0]), "+v"(s1[1]), "+v"(s1[2]), "+v"(s1[3]), "+v"(s1[4]), "+v"(s1[5]), "+v"(s1[6]), "+v"(s1[7]), "=&v"(t0), "=&v"(t1)
        : "v"(ka[0]), "v"(ka[1]), "v"(ka[2]), "v"(ka[3]), "v"(kb[0]), "v"(kb[1]), "v"(kb[2]), "v"(kb[3]), "v"(eg), "v"(d0), "v"(d1));
}

template <bool DO_R, bool DO_G>
__device__ __forceinline__ void phase4_seq(const Params& p, char* lds) {
    float* Ws = (float*)lds;
    float* Ks = Ws + 2048;
    float* Bs = Ks + 2048;
    float* Ds = Bs + 2048;
    float* Rs = Ds + 2048;
    float* Vs = Rs + 2048;
    float* Yo = Vs + 1024;
    float* Kc = Yo + 1024;
    float* Qc = Kc + 4096;
    float* Vc = Qc + 4096;
    float* Oo = Vc + 1024;
    float* Gc = Oo + 1024;
    float* Bc = Gc + 32;
    const int t = threadIdx.x;
    const bool isR = t < 256;
    const bool act = isR ? DO_R : DO_G;
    const int tl = t & 255;
    const int grp = tl >> 4, sub = tl & 15;
    const int sstep = tl >> 3, sq = tl & 7;
    for (int u = blockIdx.x; u < 256; u += gridDim.x) {
        const int rscan = u >> 1, rhalf = u & 1;
        const int rb = rscan >> 4, rh = (rscan >> 1) & 7, rdir = rscan & 1;
        const int gscan = u >> 2, gquart = u & 3;
        const int gb = gscan >> 3, gh = (gscan >> 1) & 3, gdir = gscan & 1;
        const bf16_t* EW = (const bf16_t*)(p.ws + B_EW) + (size_t)rdir * NTOK * 512;
        const bf16_t* KD = (const bf16_t*)(p.ws + B_KD) + (size_t)rdir * NTOK * 512;
        const bf16_t* BD = (const bf16_t*)(p.ws + B_BD) + (size_t)rdir * NTOK * 512;
        const bf16_t* RR = (const bf16_t*)(p.ws + B_RR); const bf16_t* KK = (const bf16_t*)(p.ws + B_KK); const bf16_t* VV = (const bf16_t*)(p.ws + B_VV);
        bf16_t* Y = (bf16_t*)(p.ws + (rdir == 0 ? B_YF : B_YB));
        const bf16_t* GQ = (const bf16_t*)(p.ws + B_GQ); const bf16_t* GK = (const bf16_t*)(p.ws + B_GK); const bf16_t* GV = (const bf16_t*)(p.ws + B_GV);
        const float* GDG = (const float*)(p.ws + B_GDG); const float* GDB = (const float*)(p.ws + B_GDB);
        bf16_t* O = (bf16_t*)(p.ws + (gdir == 0 ? B_OF : B_OB));
        float SR[2][4], SG[2][8];
#pragma unroll
        for (int i = 0; i < 4; ++i) { SR[0][i] = 0.f; SR[1][i] = 0.f; }
#pragma unroll
        for (int i = 0; i < 8; ++i) { SG[0][i] = 0.f; SG[1][i] = 0.f; }
        for (int chunk = 0; chunk < TT / 32; ++chunk) {
            if (!act) {
            } else if (isR) {
                const int s = scan_token(rdir, chunk * 32 + sstep);
                const size_t o = (size_t)(rb * TT + s) * 512 + rh * 64 + sq * 8;
                const uint4 e = *(const uint4*)(EW + o), kk = *(const uint4*)(KK + o), bb = *(const uint4*)(BD + o), kd = *(const uint4*)(KD + o), rr = *(const uint4*)(RR + o);
                const int li = sstep * 64 + sq * 8;
                *(f32x4*)(Ws + li) = exp4n(bf4_lo(e)); *(f32x4*)(Ws + li + 4) = exp4n(bf4_hi(e));
                *(f32x4*)(Ks + li) = bf4_lo(kk); *(f32x4*)(Ks + li + 4) = bf4_hi(kk);
                *(f32x4*)(Bs + li) = bf4_lo(bb); *(f32x4*)(Bs + li + 4) = bf4_hi(bb);
                *(f32x4*)(Ds + li) = bf4_lo(kd); *(f32x4*)(Ds + li + 4) = bf4_hi(kd);
                *(f32x4*)(Rs + li) = bf4_lo(rr); *(f32x4*)(Rs + li + 4) = bf4_hi(rr);
                *(f32x4*)(Vs + sstep * 32 + sq * 4) = ld_bf4(VV + (size_t)(rb * TT + s) * 512 + rh * 64 + rhalf * 32 + sq * 4);
            } else {
                const int s = scan_token(gdir, chunk * 32 + sstep);
                const size_t R = (size_t)(gb * TT + s);
                const uint4 k0 = *(const uint4*)(GK + R * 512 + gh * 128 + sq * 16), k1 = *(const uint4*)(GK + R * 512 + gh * 128 + sq * 16 + 8);
                const uint4 q0 = *(const uint4*)(GQ + R * 512 + gh * 128 + sq * 16), q1 = *(const uint4*)(GQ + R * 512 + gh * 128 + sq * 16 + 8);
                float* kd = Kc + sstep * 128 + sq * 16; float* qd = Qc + sstep * 128 + sq * 16;
                *(f32x4*)(kd) = bf4_lo(k0); *(f32x4*)(kd + 4) = bf4_hi(k0); *(f32x4*)(kd + 8) = bf4_lo(k1); *(f32x4*)(kd + 12) = bf4_hi(k1);
                *(f32x4*)(qd) = bf4_lo(q0); *(f32x4*)(qd + 4) = bf4_hi(q0); *(f32x4*)(qd + 8) = bf4_lo(q1); *(f32x4*)(qd + 12) = bf4_hi(q1);
                *(f32x4*)(Vc + sstep * 32 + sq * 4) = ld_bf4(GV + R * 512 + gh * 128 + gquart * 32 + sq * 4);
                if (tl < 32) {
                    const int s2 = scan_token(gdir, chunk * 32 + tl);
                    const size_t R2 = (size_t)(gb * TT + s2);
                    Gc[tl] = expf(GDG[R2 * 8 + gdir * 4 + gh]);
                    Bc[tl] = GDB[R2 * 8 + gdir * 4 + gh];
                }
            }
            __syncthreads();
            if (!act) {
            } else if (isR) {
                const int c4 = sub * 4;
                f32x4 kk = *(const f32x4*)(Ks + c4), wv = *(const f32x4*)(Ws + c4), bb = *(const f32x4*)(Bs + c4), kd = *(const f32x4*)(Ds + c4), rv = *(const f32x4*)(Rs + c4);
                float v0 = Vs[grp], v1 = Vs[16 + grp];
#pragma unroll 2
                for (int step = 0; step < 32; ++step) {
                    const int nx = (step + 1 < 32 ? step + 1 : step) * 64 + c4;
                    const f32x4 kkn = *(const f32x4*)(Ks + nx), wvn = *(const f32x4*)(Ws + nx), bbn = *(const f32x4*)(Bs + nx), kdn = *(const f32x4*)(Ds + nx), rvn = *(const f32x4*)(Rs + nx);
                    const int nv = (step + 1 < 32 ? step + 1 : step) * 32;
                    const float v0n = Vs[nv + grp], v1n = Vs[nv + 16 + grp];
                    float sa0, sa1, y0, y1;
                    dot2r_4(sa0, sa1, SR[0][0], SR[0][1], SR[0][2], SR[0][3], SR[1][0], SR[1][1], SR[1][2], SR[1][3], kk[0], kk[1], kk[2], kk[3]);
                    rwkv_upd2(SR[0], SR[1], wv, kd, bb, v0, v1, sa0, sa1);
                    dot2r_4(y0, y1, SR[0][0], SR[0][1], SR[0][2], SR[0][3], SR[1][0], SR[1][1], SR[1][2], SR[1][3], rv[0], rv[1], rv[2], rv[3]);
                    if (sub == 0) { Yo[step * 32 + grp] = y0; Yo[step * 32 + 16 + grp] = y1; }
                    kk = kkn; wv = wvn; bb = bbn; kd = kdn; rv = rvn; v0 = v0n; v1 = v1n;
                }
            } else {
                const int k8 = sub * 8;
                f32x4 ka = *(const f32x4*)(Kc + k8), kb = *(const f32x4*)(Kc + k8 + 4), qa = *(const f32x4*)(Qc + k8), qb = *(const f32x4*)(Qc + k8 + 4);
                float v0 = Vc[grp], v1 = Vc[16 + grp], eg = Gc[0], be = Bc[0];
#pragma unroll 2
                for (int step = 0; step < 32; ++step) {
                    const int ns = (step + 1 < 32 ? step + 1 : step);
                    const f32x4 kan = *(const f32x4*)(Kc + ns * 128 + k8), kbn = *(const f32x4*)(Kc + ns * 128 + k8 + 4), qan = *(const f32x4*)(Qc + ns * 128 + k8), qbn = *(const f32x4*)(Qc + ns * 128 + k8 + 4);
                    const float v0n = Vc[ns * 32 + grp], v1n = Vc[ns * 32 + 16 + grp], egn = Gc[ns], ben = Bc[ns];
                    float ks0, ks1, o0, o1;
                    dot2r_8(ks0, ks1, SG[0][0], SG[0][1], SG[0][2], SG[0][3], SG[0][4], SG[0][5], SG[0][6], SG[0][7], SG[1][0], SG[1][1], SG[1][2], SG[1][3], SG[1][4], SG[1][5], SG[1][6], SG[1][7],
                            ka[0], ka[1], ka[2], ka[3], kb[0], kb[1], kb[2], kb[3]);
                    const float d0 = be * (v0 - eg * ks0), d1 = be * (v1 - eg * ks1);
                    gdn_upd2(SG[0], SG[1], ka, kb, eg, d0, d1);
                    dot2r_8(o0, o1, SG[0][0], SG[0][1], SG[0][2], SG[0][3], SG[0][4], SG[0][5], SG[0][6], SG[0][7], SG[1][0], SG[1][1], SG[1][2], SG[1][3], SG[1][4], SG[1][5], SG[1][6], SG[1][7],
                            qa[0], qa[1], qa[2], qa[3], qb[0], qb[1], qb[2], qb[3]);
                    if (sub == 0) { Oo[step * 32 + grp] = o0; Oo[step * 32 + 16 + grp] = o1; }
                    ka = kan; kb = kbn; qa = qan; qb = qbn; v0 = v0n; v1 = v1n; eg = egn; be = ben;
                }
            }
            __syncthreads();
            if (!act) {
            } else if (isR) {
                const int s = scan_token(rdir, chunk * 32 + sstep);
                st_bf4(Y + (size_t)(rb * TT + s) * 512 + rh * 64 + rhalf * 32 + sq * 4, *(const f32x4*)(Yo + sstep * 32 + sq * 4));
            } else {
                const int s = scan_token(gdir, chunk * 32 + sstep);
                st_bf4(O + (size_t)(gb * TT + s) * 512 + gh * 128 + gquart * 32 + sq * 4, *(const f32x4*)(Oo + sstep * 32 + sq * 4));
            }
        }
        __syncthreads();
    }
}


template <int I> __device__ __forceinline__ void fs_load_row(const LAS char* L, f32x4 (&l)[16]) {
#pragma unroll
    for (int j4 = 0; j4 < (I + 3) / 4; ++j4) l[j4] = *(const LAS f32x4*)(L + I * 256 + j4 * 16);
}
template <int I> __device__ __forceinline__ void fs_do_row(const f32x4 (&l)[16], float (&m)[64], int lane) {
    float a0 = (I == lane) ? 1.f : 0.f, a1 = 0.f, a2 = 0.f, a3 = 0.f;
#pragma unroll
    for (int j4 = 0; j4 < (I + 3) / 4; ++j4) {
        if (4 * j4 + 0 < I) a0 -= l[j4][0] * m[4 * j4 + 0];
        if (4 * j4 + 1 < I) a1 -= l[j4][1] * m[4 * j4 + 1];
        if (4 * j4 + 2 < I) a2 -= l[j4][2] * m[4 * j4 + 2];
        if (4 * j4 + 3 < I) a3 -= l[j4][3] * m[4 * j4 + 3];
    }
    m[I] = (a0 + a1) + (a2 + a3);
}
template <int I> struct FsRows {
    static __device__ __forceinline__ void run(const LAS char* L, float (&m)[64], int lane) {
        f32x4 ra[16];
        fs_load_row<I>(L, ra);
        fs_do_row<I>(ra, m, lane);
        __builtin_amdgcn_sched_barrier(0);
        if constexpr (I + 1 < 64) FsRows<I + 1>::run(L, m, lane);
    }
};
__device__ __forceinline__ void fs_solve(const LAS char* L, float (&m)[64], int lane) { FsRows<0>::run(L, m, lane); }

__device__ __forceinline__ float wave_incl_scan(float x, int lane) {
    (void)lane;
    x += __builtin_bit_cast(float, __builtin_amdgcn_update_dpp(0, __builtin_bit_cast(int, x), 0x111, 0xf, 0xf, true));
    x += __builtin_bit_cast(float, __builtin_amdgcn_update_dpp(0, __builtin_bit_cast(int, x), 0x112, 0xf, 0xf, true));
    x += __builtin_bit_cast(float, __builtin_amdgcn_update_dpp(0, __builtin_bit_cast(int, x), 0x114, 0xf, 0xf, true));
    x += __builtin_bit_cast(float, __builtin_amdgcn_update_dpp(0, __builtin_bit_cast(int, x), 0x118, 0xf, 0xf, true));
    x += __builtin_bit_cast(float, __builtin_amdgcn_update_dpp(0, __builtin_bit_cast(int, x), 0x142, 0xa, 0xf, false));
    x += __builtin_bit_cast(float, __builtin_amdgcn_update_dpp(0, __builtin_bit_cast(int, x), 0x143, 0xc, 0xf, false));
    return x;
}
__device__ __forceinline__ float lane63(float x) { return __builtin_bit_cast(float, __builtin_amdgcn_readlane(__builtin_bit_cast(int, x), 63)); }

__device__ __forceinline__ void phase4a(const Params& p, char* lds) {
    const int t = threadIdx.x, lane = t & 63, w = t >> 6, fr = lane & 15, fq = lane >> 4;
    unsigned lb = (unsigned)(w * 16384);
    asm volatile("" : "+v"(lb));
    LAS char* Lw = (LAS char*)lds + lb;
    LAS float* GCw = (LAS float*)((LAS char*)lds + 131072 + w * 512);
    const bf16_t* GK = (const bf16_t*)(p.ws + B_GK);
    const float* GDG = (const float*)(p.ws + B_GDG); const float* GDB = (const float*)(p.ws + B_GDB);
    const bf16_t* KK = (const bf16_t*)(p.ws + B_KK);
    bf16_t* GMW = (bf16_t*)(p.ws + C_GMW); bf16_t* GMU = (bf16_t*)(p.ws + C_GMU); bf16_t* RM = (bf16_t*)(p.ws + C_RM);
    const int nwave = gridDim.x * 8;
    for (int q = blockIdx.x * 8 + w; q < 6912; q += nwave) {
        float m[64];
        float gcl = 0.f, bel = 0.f;
        if (q >= 4608) {
            const int qq = q - 4608, sg = qq / 36, n = qq % 36;
            const int b = sg >> 3, h = (sg >> 1) & 3, dir = sg & 1;
            {
                const size_t R = (size_t)(b * TT + scan_token(dir, 64 * n + lane));
                gcl = wave_incl_scan(GDG[R * 8 + dir * 4 + h], lane);
                bel = GDB[R * 8 + dir * 4 + h];
                GCw[lane] = gcl; GCw[64 + lane] = bel;
            }
            bf16x8 kf[4][4];
#pragma unroll
            for (int tt = 0; tt < 4; ++tt) {
                const size_t R = (size_t)(b * TT + scan_token(dir, 64 * n + 16 * tt + fr));
#pragma unroll
                for (int kk = 0; kk < 4; ++kk) kf[tt][kk] = *(const bf16x8*)(GK + R * 512 + h * 128 + 32 * kk + 8 * fq);
            }
#pragma unroll
            for (int ti = 0; ti < 4; ++ti)
#pragma unroll
                for (int tj = 0; tj <= ti; ++tj) {
                    f32x4 acc = (f32x4){0.f, 0.f, 0.f, 0.f};
#pragma unroll
                    for (int kk = 0; kk < 4; ++kk) acc = __builtin_amdgcn_mfma_f32_16x16x32_bf16(kf[ti][kk], kf[tj][kk], acc, 0, 0, 0);
                    const int j = 16 * tj + fr;
                    const float gcj = GCw[j];
#pragma unroll
                    for (int r = 0; r < 4; ++r) {
                        const int i = 16 * ti + 4 * fq + r;
                        const float v = (i > j) ? GCw[64 + i] * acc[r] * expf(fminf(GCw[i] - gcj, 0.f)) : 0.f;
                        *(LAS float*)(Lw + i * 256 + j * 4) = v;
                    }
                }
        } else {
            const int sr = q / 36, n = q % 36;
            const int b = sr >> 4, h = (sr >> 1) & 7, dir = sr & 1;
            const bf16_t* EW = (const bf16_t*)(p.ws + B_EW) + (size_t)dir * NTOK * 512;
            const bf16_t* BD = (const bf16_t*)(p.ws + B_BD) + (size_t)dir * NTOK * 512;
            {
                const size_t o = (size_t)(b * TT + scan_token(dir, 64 * n + lane)) * 512 + h * 64;
                uint4 ewq[8], kkq[8], bdq[8];
#pragma unroll
                for (int part = 0; part < 8; ++part) { ewq[part] = *(const uint4*)(EW + o + part * 8); kkq[part] = *(const uint4*)(KK + o + part * 8); bdq[part] = *(const uint4*)(BD + o + part * 8); }
#pragma unroll
                for (int part = 0; part < 8; ++part) {
                    float ew[8], kkv[8], bv[8], okt[8], obh[8];
                    unpack8(ewq[part], ew); unpack8(kkq[part], kkv); unpack8(bdq[part], bv);
#pragma unroll
                    for (int e = 0; e < 8; ++e) {
                        const float lam = -wave_incl_scan(ew[e], lane);
                        const float el = __expf(lam);
                        okt[e] = kkv[e] * (el * __expf(ew[e]));
                        obh[e] = bv[e] * __builtin_amdgcn_rcpf(el);
                    }
                    const u32x4 q1 = (u32x4){pack2(okt[0], okt[1]), pack2(okt[2], okt[3]), pack2(okt[4], okt[5]), pack2(okt[6], okt[7])};
                    const u32x4 q2 = (u32x4){pack2(obh[0], obh[1]), pack2(obh[2], obh[3]), pack2(obh[4], obh[5]), pack2(obh[6], obh[7])};
                    *(LAS u32x4*)(Lw + lane * 128 + part * 16) = q1;
                    *(LAS u32x4*)(Lw + 8192 + lane * 128 + part * 16) = q2;
                }
            }
            f32x4 acc[10];
            {
                int tix = 0;
#pragma unroll
                for (int ti = 0; ti < 4; ++ti)
#pragma unroll
                    for (int tj = 0; tj <= ti; ++tj) {
                        f32x4 a = (f32x4){0.f, 0.f, 0.f, 0.f};
#pragma unroll
                        for (int kk = 0; kk < 2; ++kk) {
                            const bf16x8 xf = *(const LAS bf16x8*)(Lw + (16 * ti + fr) * 128 + (32 * kk + 8 * fq) * 2);
                            const bf16x8 yf = *(const LAS bf16x8*)(Lw + 8192 + (16 * tj + fr) * 128 + (32 * kk + 8 * fq) * 2);
                            a = __builtin_amdgcn_mfma_f32_16x16x32_bf16(xf, yf, a, 0, 0, 0);
                        }
                        acc[tix++] = a;
                    }
            }
            asm volatile("s_waitcnt lgkmcnt(0)" ::: "memory");
            {
                int tix = 0;
#pragma unroll
                for (int ti = 0; ti < 4; ++ti)
#pragma unroll
                    for (int tj = 0; tj <= ti; ++tj) {
                        const f32x4 a = acc[tix++];
                        const int j = 16 * tj + fr;
#pragma unroll
                        for (int r = 0; r < 4; ++r) {
                            const int i = 16 * ti + 4 * fq + r;
                            *(LAS float*)(Lw + i * 256 + j * 4) = (i > j) ? a[r] : 0.f;
                        }
                    }
            }
        }
        asm volatile("s_waitcnt lgkmcnt(0)" ::: "memory");
        fs_solve(Lw, m, lane);
        if (q >= 4608) {
            const float su = bel, sw = bel * expf(gcl);
            bf16_t* dw = GMW + (size_t)(q - 4608) * 4096 + lane; bf16_t* du = GMU + (size_t)(q - 4608) * 4096 + lane;
#pragma unroll
            for (int i = 0; i < 64; ++i) { dw[i * 64] = f2bf(m[i] * sw); du[i * 64] = f2bf(m[i] * su); }
        } else {
            bf16_t* dm = RM + (size_t)q * 4096 + lane;
#pragma unroll
            for (int i = 0; i < 64; ++i) dm[i * 64] = f2bf(m[i]);
        }
        asm volatile("s_waitcnt lgkmcnt(0)" ::: "memory");
    }
}

#define PIN4(q) asm volatile("" : "+v"((q).x), "+v"((q).y), "+v"((q).z), "+v"((q).w))
constexpr int S144 = 144, S272 = 272;
constexpr int G_KROW = 0;
constexpr int G_QROW = G_KROW + 64 * S272;
constexpr int G_W = G_QROW + 64 * S272;
constexpr int G_ST = G_W + 64 * S272;
constexpr int G_KT = G_ST + 64 * S272;
constexpr int G_VT = G_KT + 128 * S144;
constexpr int G_MW = G_VT + 64 * S144;
constexpr int G_MU = G_MW + 64 * S144;
constexpr int G_AQK = G_MU + 64 * S144;
constexpr int G_UT = G_AQK + 64 * S144;
constexpr int G_VNT = G_UT + 64 * S144;
constexpr int G_VST = G_VNT + 64 * S144;
constexpr int G_GC = G_VST + 64 * S144;
constexpr int G_END = G_GC + 256;
static_assert(G_END <= LDS_MAIN, "DeltaNet chunk LDS map too large");

template <int K>
__device__ __forceinline__ void mm_nt(f32x4& acc, const char* xrow, const char* yrow) {
#pragma unroll
    for (int kk = 0; kk < K / 32; ++kk) {
        const bf16x8 xf = *(const bf16x8*)(xrow + kk * 64), yf = *(const bf16x8*)(yrow + kk * 64);
        acc = __builtin_amdgcn_mfma_f32_16x16x32_bf16(xf, yf, acc, 0, 0, 0);
    }
}

__device__ __forceinline__ void gdn_chunk_unit(const Params& p, int u, char* lds) {
    const int scan = u >> 1, hf = u & 1;
    const int b = scan >> 3, h = (scan >> 1) & 3, dir = scan & 1;
    const bf16_t* GQ = (const bf16_t*)(p.ws + B_GQ); const bf16_t* GK = (const bf16_t*)(p.ws + B_GK); const bf16_t* GV = (const bf16_t*)(p.ws + B_GV);
    const float* GDG = (const float*)(p.ws + B_GDG);
    const bf16_t* GMW = (const bf16_t*)(p.ws + C_GMW) + (size_t)scan * 36 * 4096; const bf16_t* GMU = (const bf16_t*)(p.ws + C_GMU) + (size_t)scan * 36 * 4096;
    bf16_t* O = (bf16_t*)(p.ws + (dir == 0 ? B_OF : B_OB));
    float* GC = (float*)(lds + G_GC);
    const int t = threadIdx.x, lane = t & 63, w = t >> 6, fr = lane & 15, fq = lane >> 4;
    for (int i = t; i < 64 * S272 / 16; i += NTHR) ((uint4*)(lds + G_ST))[i] = make_uint4(0u, 0u, 0u, 0u);
    f32x4 Sreg[4];
#pragma unroll
    for (int tc = 0; tc < 4; ++tc) Sreg[tc] = (f32x4){0.f, 0.f, 0.f, 0.f};
    uint4 pk0, pk1, pq0, pq1, pv0, pmw, pmu; float pg;
    {
        const size_t R0 = (size_t)(b * TT + scan_token(dir, lane));
        pk0 = *(const uint4*)(GK + R0 * 512 + h * 128 + w * 16); pk1 = *(const uint4*)(GK + R0 * 512 + h * 128 + w * 16 + 8);
        pq0 = *(const uint4*)(GQ + R0 * 512 + h * 128 + w * 16); pq1 = *(const uint4*)(GQ + R0 * 512 + h * 128 + w * 16 + 8);
        pv0 = *(const uint4*)(GV + R0 * 512 + h * 128 + 64 * hf + w * 8);
        pmw = *(const uint4*)(GMW + t * 8); pmu = *(const uint4*)(GMU + t * 8);
        pg = GDG[R0 * 8 + dir * 4 + h];
    }
    __syncthreads();
    for (int n = 0; n < TT / 64; ++n) {
        {
            const int i = lane, part = w;
            PIN4(pk0); PIN4(pk1); PIN4(pq0); PIN4(pq1); PIN4(pv0); PIN4(pmw); PIN4(pmu); asm volatile("" : "+v"(pg));
            const uint4 k0 = pk0, k1 = pk1, q0 = pq0, q1 = pq1, v0 = pv0, mw = pmw, mu = pmu;
            const float gcur = pg;
            if (n + 1 < TT / 64) {
                const size_t Rn = (size_t)(b * TT + scan_token(dir, 64 * (n + 1) + i));
                pk0 = *(const uint4*)(GK + Rn * 512 + h * 128 + part * 16); pk1 = *(const uint4*)(GK + Rn * 512 + h * 128 + part * 16 + 8);
                pq0 = *(const uint4*)(GQ + Rn * 512 + h * 128 + part * 16); pq1 = *(const uint4*)(GQ + Rn * 512 + h * 128 + part * 16 + 8);
                pv0 = *(const uint4*)(GV + Rn * 512 + h * 128 + 64 * hf + part * 8);
                pmw = *(const uint4*)(GMW + (size_t)(n + 1) * 4096 + t * 8); pmu = *(const uint4*)(GMU + (size_t)(n + 1) * 4096 + t * 8);
                pg = GDG[Rn * 8 + dir * 4 + h];
            }
            *(uint4*)(lds + G_KROW + i * S272 + part * 32) = k0; *(uint4*)(lds + G_KROW + i * S272 + part * 32 + 16) = k1;
            *(uint4*)(lds + G_QROW + i * S272 + part * 32) = q0; *(uint4*)(lds + G_QROW + i * S272 + part * 32 + 16) = q1;
            *(uint4*)(lds + G_MW + (t >> 3) * S144 + (t & 7) * 16) = mw; *(uint4*)(lds + G_MU + (t >> 3) * S144 + (t & 7) * 16) = mu;
            const unsigned kw[8] = {k0.x, k0.y, k0.z, k0.w, k1.x, k1.y, k1.z, k1.w};
#pragma unroll
            for (int e = 0; e < 8; ++e) {
                *(bf16_t*)(lds + G_KT + (part * 16 + 2 * e) * S144 + i * 2) = (bf16_t)(kw[e] & 0xffff);
                *(bf16_t*)(lds + G_KT + (part * 16 + 2 * e + 1) * S144 + i * 2) = (bf16_t)(kw[e] >> 16);
            }
            const unsigned vw[4] = {v0.x, v0.y, v0.z, v0.w};
#pragma unroll
            for (int e = 0; e < 4; ++e) {
                *(bf16_t*)(lds + G_VT + (part * 8 + 2 * e) * S144 + i * 2) = (bf16_t)(vw[e] & 0xffff);
                *(bf16_t*)(lds + G_VT + (part * 8 + 2 * e + 1) * S144 + i * 2) = (bf16_t)(vw[e] >> 16);
            }
            if (w == 0) GC[lane] = wave_incl_scan(gcur, lane);
        }
        __syncthreads();
        {
            const int ti = w >> 1;
#pragma unroll
            for (int tjj = 0; tjj < 2; ++tjj) {
                const int tj = 2 * (w & 1) + tjj;
                f32x4 aqk = (f32x4){0.f, 0.f, 0.f, 0.f};
                if (tj <= ti) mm_nt<128>(aqk, lds + G_QROW + (16 * ti + fr) * S272 + fq * 16, lds + G_KROW + (16 * tj + fr) * S272 + fq * 16);
                const int j = 16 * tj + fr;
                const float gcj = GC[j];
#pragma unroll
                for (int r = 0; r < 4; ++r) {
                    const int i = 16 * ti + 4 * fq + r;
                    *(bf16_t*)(lds + G_AQK + i * S144 + j * 2) = f2bf((i >= j) ? aqk[r] * expf(fminf(GC[i] - gcj, 0.f)) : 0.f);
                }
            }
#pragma unroll
            for (int ti2 = 0; ti2 < 4; ++ti2) {
                f32x4 acc = (f32x4){0.f, 0.f, 0.f, 0.f};
                mm_nt<64>(acc, lds + G_KT + (16 * w + fr) * S144 + fq * 16, lds + G_MW + (16 * ti2 + fr) * S144 + fq * 16);
                *(uint2*)(lds + G_W + (16 * ti2 + fr) * S272 + (16 * w + 4 * fq) * 2) = pk4(acc);
            }
#pragma unroll
            for (int tcc = 0; tcc < 2; ++tcc) {
                const int tc = 2 * (w & 1) + tcc;
                f32x4 acc = (f32x4){0.f, 0.f, 0.f, 0.f};
                mm_nt<64>(acc, lds + G_MU + (16 * ti + fr) * S144 + fq * 16, lds + G_VT + (16 * tc + fr) * S144 + fq * 16);
                *(uint2*)(lds + G_UT + (16 * tc + fr) * S144 + (16 * ti + 4 * fq) * 2) = pk4(acc);
            }
        }
        __syncthreads();
        const float gL = GC[63];
        {
            const int ti = w >> 1;
#pragma unroll
            for (int tcc = 0; tcc < 2; ++tcc) {
                const int tc = 2 * (w & 1) + tcc;
                f32x4 acc = (f32x4){0.f, 0.f, 0.f, 0.f};
                mm_nt<128>(acc, lds + G_W + (16 * ti + fr) * S272 + fq * 16, lds + G_ST + (16 * tc + fr) * S272 + fq * 16);
                const int i0 = 16 * ti + 4 * fq, col = 16 * tc + fr;
                const f32x4 vn = ld_bf4((const bf16_t*)(lds + G_UT + col * S144 + i0 * 2)) - acc;
                *(uint2*)(lds + G_VNT + col * S144 + i0 * 2) = pk4(vn);
                const f32x4 sc = (f32x4){expf(gL - GC[i0]), expf(gL - GC[i0 + 1]), expf(gL - GC[i0 + 2]), expf(gL - GC[i0 + 3])};
                *(uint2*)(lds + G_VST + col * S144 + i0 * 2) = pk4(vn * sc);
            }
        }
        __syncthreads();
        {
            const int ti = w >> 1;
#pragma unroll
            for (int tcc = 0; tcc < 2; ++tcc) {
                const int tc = 2 * (w & 1) + tcc;
                f32x4 a1 = (f32x4){0.f, 0.f, 0.f, 0.f}, a2 = a1;
                mm_nt<128>(a1, lds + G_QROW + (16 * ti + fr) * S272 + fq * 16, lds + G_ST + (16 * tc + fr) * S272 + fq * 16);
                mm_nt<64>(a2, lds + G_AQK + (16 * ti + fr) * S144 + fq * 16, lds + G_VNT + (16 * tc + fr) * S144 + fq * 16);
                const int i0 = 16 * ti + 4 * fq, col = 16 * tc + fr;
#pragma unroll
                for (int r = 0; r < 4; ++r) *(bf16_t*)(lds + G_UT + (i0 + r) * S144 + col * 2) = f2bf(expf(GC[i0 + r]) * a1[r] + a2[r]);
            }
            const float egL = expf(gL);
#pragma unroll
            for (int tc = 0; tc < 4; ++tc) {
                f32x4 acc = (f32x4){0.f, 0.f, 0.f, 0.f};
                mm_nt<64>(acc, lds + G_KT + (16 * w + fr) * S144 + fq * 16, lds + G_VST + (16 * tc + fr) * S144 + fq * 16);
                Sreg[tc] = Sreg[tc] * egL + acc;
            }
        }
        __syncthreads();
#pragma unroll
        for (int tc = 0; tc < 4; ++tc) *(uint2*)(lds + G_ST + (16 * tc + fr) * S272 + (16 * w + 4 * fq) * 2) = pk4(Sreg[tc]);
        {
            const int i = t >> 3, part = t & 7;
            const size_t R = (size_t)(b * TT + scan_token(dir, 64 * n + i));
            *(uint4*)(O + R * 512 + h * 128 + 64 * hf + part * 8) = *(const uint4*)(lds + G_UT + i * S144 + part * 16);
        }
    }
    __syncthreads();
}


constexpr int R_KKT = 0;
constexpr int R_KHAT = R_KKT + 64 * S144;
constexpr int R_BHAT = R_KHAT + 64 * S144;
constexpr int R_RT = R_BHAT + 64 * S144;
constexpr int R_KBT = R_RT + 64 * S144;
constexpr int R_BBT = R_KBT + 64 * S144;
constexpr int R_VT = R_BBT + 64 * S144;
constexpr int R_AKK = R_VT + 64 * S144;
constexpr int R_ARK = R_AKK + 64 * S144;
constexpr int R_ARB = R_ARK + 64 * S144;
constexpr int R_M = R_ARB + 64 * S144;
constexpr int R_TT = R_M + 64 * S144;
constexpr int R_RHS = R_TT + 64 * S144;
constexpr int R_PT = R_RHS + 64 * S144;
constexpr int R_OT = R_PT + 64 * S144;
constexpr int R_LAML = R_OT + 64 * S144;
constexpr int R_END = R_LAML + 256;
static_assert(R_END <= LDS_MAIN, "RWKV chunk LDS map too large");

__device__ __forceinline__ void unpack8f(const uint4 v, float (&f)[8]) { unpack8(v, f); }

__device__ __forceinline__ void rwkv_chunk_unit(const Params& p, int sr, char* lds) {
    const int b = sr >> 4, h = (sr >> 1) & 7, dir = sr & 1;
    const bf16_t* EW = (const bf16_t*)(p.ws + B_EW) + (size_t)dir * NTOK * 512;
    const bf16_t* KD = (const bf16_t*)(p.ws + B_KD) + (size_t)dir * NTOK * 512;
    const bf16_t* BD = (const bf16_t*)(p.ws + B_BD) + (size_t)dir * NTOK * 512;
    const bf16_t* RR = (const bf16_t*)(p.ws + B_RR); const bf16_t* KK = (const bf16_t*)(p.ws + B_KK); const bf16_t* VV = (const bf16_t*)(p.ws + B_VV);
    const bf16_t* RM = (const bf16_t*)(p.ws + C_RM) + (size_t)sr * 36 * 4096;
    bf16_t* Y = (bf16_t*)(p.ws + (dir == 0 ? B_YF : B_YB));
    float* LAML = (float*)(lds + R_LAML);
    const int t = threadIdx.x, lane = t & 63, w = t >> 6, fr = lane & 15, fq = lane >> 4;
    for (int i = t; i < 3 * 64 * S144 / 16; i += NTHR) ((uint4*)(lds + R_AKK))[i] = make_uint4(0u, 0u, 0u, 0u);
    for (int i = t; i < 64 * S144 / 16; i += NTHR) ((uint4*)(lds + R_TT))[i] = make_uint4(0u, 0u, 0u, 0u);
    f32x4 Treg[2];
    Treg[0] = (f32x4){0.f, 0.f, 0.f, 0.f}; Treg[1] = Treg[0];
    const int ti = w >> 1;
    uint4 prr, pew, pkd, pvv, pkk, pbd, pmq;
    {
        const size_t o = (size_t)(b * TT + scan_token(dir, lane)) * 512 + h * 64 + w * 8;
        prr = *(const uint4*)(RR + o); pew = *(const uint4*)(EW + o); pkd = *(const uint4*)(KD + o);
        pvv = *(const uint4*)(VV + o); pkk = *(const uint4*)(KK + o); pbd = *(const uint4*)(BD + o);
        pmq = *(const uint4*)(RM + t * 8);
    }
    __syncthreads();
    for (int n = 0; n < TT / 64; ++n) {
        {
            const int i = lane, part = w;
            float rr[8], ew[8], kd[8], vv[8], kk[8], bd[8];
            PIN4(prr); PIN4(pew); PIN4(pkd); PIN4(pvv); PIN4(pkk); PIN4(pbd); PIN4(pmq);
            unpack8(prr, rr); unpack8(pew, ew); unpack8(pkd, kd); unpack8(pvv, vv); unpack8(pkk, kk); unpack8(pbd, bd);
            const uint4 mq = pmq;
            if (n + 1 < TT / 64) {
                const size_t o = (size_t)(b * TT + scan_token(dir, 64 * (n + 1) + i)) * 512 + h * 64 + part * 8;
                prr = *(const uint4*)(RR + o); pew = *(const uint4*)(EW + o); pkd = *(const uint4*)(KD + o);
                pvv = *(const uint4*)(VV + o); pkk = *(const uint4*)(KK + o); pbd = *(const uint4*)(BD + o);
                pmq = *(const uint4*)(RM + (size_t)(n + 1) * 4096 + t * 8);
            }
            *(uint4*)(lds + R_M + (t >> 3) * S144 + (t & 7) * 16) = mq;
            float o_kkt[8], o_khat[8], o_bhat[8], o_rt[8];
#pragma unroll
            for (int e = 0; e < 8; ++e) {
                const float lam = -wave_incl_scan(ew[e], lane);
                const float el = __expf(lam), eml = __builtin_amdgcn_rcpf(el);
                const float lamL = lane63(lam), edl = lane63(el) * eml;
                o_kkt[e] = kk[e] * (el * __expf(ew[e]));
                o_khat[e] = kd[e] * eml; o_bhat[e] = bd[e] * eml; o_rt[e] = rr[e] * el;
                const int c = part * 8 + e;
                *(bf16_t*)(lds + R_KBT + c * S144 + i * 2) = f2bf(kd[e] * edl);
                *(bf16_t*)(lds + R_BBT + c * S144 + i * 2) = f2bf(-(bd[e] * edl));
                *(bf16_t*)(lds + R_VT + c * S144 + i * 2) = f2bf(vv[e]);
                if (lane == 0) LAML[c] = lamL;
            }
            uint4 q;
            q.x = pack2(o_kkt[0], o_kkt[1]); q.y = pack2(o_kkt[2], o_kkt[3]); q.z = pack2(o_kkt[4], o_kkt[5]); q.w = pack2(o_kkt[6], o_kkt[7]);
            *(uint4*)(lds + R_KKT + i * S144 + part * 16) = q;
            q.x = pack2(o_khat[0], o_khat[1]); q.y = pack2(o_khat[2], o_khat[3]); q.z = pack2(o_khat[4], o_khat[5]); q.w = pack2(o_khat[6], o_khat[7]);
            *(uint4*)(lds + R_KHAT + i * S144 + part * 16) = q;
            q.x = pack2(o_bhat[0], o_bhat[1]); q.y = pack2(o_bhat[2], o_bhat[3]); q.z = pack2(o_bhat[4], o_bhat[5]); q.w = pack2(o_bhat[6], o_bhat[7]);
            *(uint4*)(lds + R_BHAT + i * S144 + part * 16) = q;
            q.x = pack2(o_rt[0], o_rt[1]); q.y = pack2(o_rt[2], o_rt[3]); q.z = pack2(o_rt[4], o_rt[5]); q.w = pack2(o_rt[6], o_rt[7]);
            *(uint4*)(lds + R_RT + i * S144 + part * 16) = q;
        }
        __syncthreads();
#pragma unroll
        for (int rep = 0; rep < 4; ++rep) {
            const int item = w + 8 * rep;
            if (item < 30) {
                const int idx = item / 3, mtx = item - 3 * idx;
                const int ta = idx >= 6 ? 3 : (idx >= 3 ? 2 : (idx >= 1 ? 1 : 0));
                const int tb = idx - ta * (ta + 1) / 2;
                f32x4 acc = (f32x4){0.f, 0.f, 0.f, 0.f};
                const char* xp = lds + (mtx == 0 ? R_KKT : R_RT) + (16 * ta + fr) * S144 + fq * 16;
                const char* yp = lds + (mtx == 2 ? R_BHAT : R_KHAT) + (16 * tb + fr) * S144 + fq * 16;
                mm_nt<64>(acc, xp, yp);
                char* dst = lds + (mtx == 0 ? R_AKK : (mtx == 1 ? R_ARK : R_ARB));
                const float sgn = mtx == 2 ? -1.f : 1.f;
                const int j = 16 * tb + fr;
#pragma unroll
                for (int r = 0; r < 4; ++r) {
                    const int i = 16 * ta + 4 * fq + r;
                    const bool keep = mtx == 0 ? (i > j) : (i >= j);
                    *(bf16_t*)(dst + i * S144 + j * 2) = f2bf(keep ? sgn * acc[r] : 0.f);
                }
            }
        }
        __syncthreads();
        f32x4 arkv[2], kbv[2];
#pragma unroll
        for (int c = 0; c < 2; ++c) {
            const int tv = 2 * (w & 1) + c;
            const char* yv = lds + R_VT + (16 * tv + fr) * S144 + fq * 16;
            f32x4 rhs = (f32x4){0.f, 0.f, 0.f, 0.f};
            arkv[c] = rhs; kbv[c] = rhs;
            mm_nt<64>(rhs, lds + R_AKK + (16 * ti + fr) * S144 + fq * 16, yv);
            mm_nt<64>(arkv[c], lds + R_ARK + (16 * ti + fr) * S144 + fq * 16, yv);
            mm_nt<64>(kbv[c], lds + R_KBT + (16 * ti + fr) * S144 + fq * 16, yv);
            mm_nt<64>(rhs, lds + R_KKT + (16 * ti + fr) * S144 + fq * 16, lds + R_TT + (16 * tv + fr) * S144 + fq * 16);
            *(uint2*)(lds + R_RHS + (16 * tv + fr) * S144 + (16 * ti + 4 * fq) * 2) = pk4(rhs);
        }
        __syncthreads();
#pragma unroll
        for (int c = 0; c < 2; ++c) {
            const int tv = 2 * (w & 1) + c;
            f32x4 pacc = (f32x4){0.f, 0.f, 0.f, 0.f};
            mm_nt<64>(pacc, lds + R_M + (16 * ti + fr) * S144 + fq * 16, lds + R_RHS + (16 * tv + fr) * S144 + fq * 16);
            *(uint2*)(lds + R_PT + (16 * tv + fr) * S144 + (16 * ti + 4 * fq) * 2) = pk4(pacc);
        }
        __syncthreads();
#pragma unroll
        for (int c = 0; c < 2; ++c) {
            const int tv = 2 * (w & 1) + c;
            const char* yt = lds + R_TT + (16 * tv + fr) * S144 + fq * 16;
            const char* yp = lds + R_PT + (16 * tv + fr) * S144 + fq * 16;
            f32x4 yacc = arkv[c];
            mm_nt<64>(yacc, lds + R_RT + (16 * ti + fr) * S144 + fq * 16, yt);
            mm_nt<64>(yacc, lds + R_ARB + (16 * ti + fr) * S144 + fq * 16, yp);
            const int i0 = 16 * ti + 4 * fq, val = 16 * tv + fr;
#pragma unroll
            for (int r = 0; r < 4; ++r) *(bf16_t*)(lds + R_OT + (i0 + r) * S144 + val * 2) = f2bf(yacc[r]);
            f32x4 tacc = kbv[c];
            mm_nt<64>(tacc, lds + R_BBT + (16 * ti + fr) * S144 + fq * 16, yp);
            const f32x4 dl = (f32x4){expf(LAML[i0]), expf(LAML[i0 + 1]), expf(LAML[i0 + 2]), expf(LAML[i0 + 3])};
            Treg[c] = Treg[c] * dl + tacc;
        }
        __syncthreads();
#pragma unroll
        for (int c = 0; c < 2; ++c) {
            const int tv = 2 * (w & 1) + c;
            *(uint2*)(lds + R_TT + (16 * tv + fr) * S144 + (16 * ti + 4 * fq) * 2) = pk4(Treg[c]);
        }
        {
            const int i = t >> 3, part = t & 7;
            const size_t R = (size_t)(b * TT + scan_token(dir, 64 * n + i));
            *(uint4*)(Y + R * 512 + h * 64 + part * 8) = *(const uint4*)(lds + R_OT + i * S144 + part * 16);
        }
    }
    __syncthreads();
}

__device__ __forceinline__ void phase4(const Params& p, char* lds, const XcdBarrier& xb) {
    phase4a(p, lds);
    xcd_barrier(xb);
    for (int u = blockIdx.x; u < 256; u += gridDim.x) {
        if (u < 128) gdn_chunk_unit(p, u, lds);
        else rwkv_chunk_unit(p, u - 128, lds);
    }
}

__device__ __forceinline__ void phase5(const Params& p, char* lds) {
    const int lane = threadIdx.x & 63, wg = blockIdx.x * 8 + (threadIdx.x >> 6), nw = gridDim.x * 8;
    const bf16_t* YF = (const bf16_t*)(p.ws + B_YF); const bf16_t* YB = (const bf16_t*)(p.ws + B_YB);
    const bf16_t* OF = (const bf16_t*)(p.ws + B_OF); const bf16_t* OB = (const bf16_t*)(p.ws + B_OB);
    const bf16_t* VV = (const bf16_t*)(p.ws + B_VV); const bf16_t* GG = (const bf16_t*)(p.ws + B_GG);
    const float* BC = (const float*)(p.ws + B_BC);
    const bf16_t* ZZ = (const bf16_t*)(p.ws + B_ZZ);
    bf16_t* MO = (bf16_t*)(p.ws + OFF_H);
    uint4 nA, nB, nV, nG, nOF, nOB, nZ; float nbc = 0.f;
    auto fetch = [&](int R) {
        const int c8 = lane * 8;
        nA = *(const uint4*)(YF + (size_t)R * 512 + c8); nB = *(const uint4*)(YB + (size_t)R * 512 + c8);
        nV = *(const uint4*)(VV + (size_t)R * 512 + c8); nG = *(const uint4*)(GG + (size_t)R * 512 + c8);
        nOF = *(const uint4*)(OF + (size_t)R * 512 + c8); nOB = *(const uint4*)(OB + (size_t)R * 512 + c8);
        nZ = *(const uint4*)(ZZ + (size_t)R * 512 + c8); nbc = BC[(size_t)R * 8 + (lane >> 3)];
    };
    if (wg < NTOK) fetch(wg);
    for (int R = wg; R < NTOK; R += nw) {
        const int c8 = lane * 8;
        const uint4 cA = nA, cB = nB, cV = nV, cG = nG, cOF = nOF, cOB = nOB, cZ = nZ; const float cbc = nbc;
        if (R + nw < NTOK) fetch(R + nw);
        {
            const uint4 a = cA, bq = cB, vq = cV, gq = cG;
            const unsigned au[4] = {a.x, a.y, a.z, a.w}, bu[4] = {bq.x, bq.y, bq.z, bq.w}, vu[4] = {vq.x, vq.y, vq.z, vq.w}, gu[4] = {gq.x, gq.y, gq.z, gq.w};
            float y[8], vv[8], gg[8];
#pragma unroll
            for (int j = 0; j < 4; ++j) {
                y[2 * j] = bf2f((bf16_t)(au[j] & 0xffff)) + bf2f((bf16_t)(bu[j] & 0xffff));
                y[2 * j + 1] = bf2f((bf16_t)(au[j] >> 16)) + bf2f((bf16_t)(bu[j] >> 16));
                vv[2 * j] = bf2f((bf16_t)(vu[j] & 0xffff)); vv[2 * j + 1] = bf2f((bf16_t)(vu[j] >> 16));
                gg[2 * j] = bf2f((bf16_t)(gu[j] & 0xffff)); gg[2 * j + 1] = bf2f((bf16_t)(gu[j] >> 16));
            }
            float sm = 0.f;
#pragma unroll
            for (int j = 0; j < 8; ++j) sm += y[j];
            sm += __shfl_xor(sm, 1); sm += __shfl_xor(sm, 2); sm += __shfl_xor(sm, 4);
            const float mean = sm * (1.f / 64.f);
            float sv = 0.f;
#pragma unroll
            for (int j = 0; j < 8; ++j) { const float d = y[j] - mean; sv += d * d; }
            sv += __shfl_xor(sv, 1); sv += __shfl_xor(sv, 2); sv += __shfl_xor(sv, 4);
            const float rstd = rsqrtf(sv * (1.f / 64.f) + 64e-5f);
            const float bc = cbc;
            float o[8];
#pragma unroll
            for (int j = 0; j < 8; ++j) {
                const float yn = (y[j] - mean) * rstd * p.in[19][c8 + j] + p.in[20][c8 + j];
                o[j] = (yn + bc * vv[j]) * gg[j];
            }
            uint4 ov; ov.x = pack2(o[0], o[1]); ov.y = pack2(o[2], o[3]); ov.z = pack2(o[4], o[5]); ov.w = pack2(o[6], o[7]);
            *(uint4*)(MO + (size_t)R * DM + c8) = ov;
        }
        {
            const uint4 a = cOF, bq = cOB;
            const uint4 zq = cZ;
            const unsigned au[4] = {a.x, a.y, a.z, a.w}, bu[4] = {bq.x, bq.y, bq.z, bq.w}, zu[4] = {zq.x, zq.y, zq.z, zq.w};
            float o[8], z[8];
#pragma unroll
            for (int j = 0; j < 4; ++j) {
                o[2 * j] = bf2f((bf16_t)(au[j] & 0xffff)) + bf2f((bf16_t)(bu[j] & 0xffff));
                o[2 * j + 1] = bf2f((bf16_t)(au[j] >> 16)) + bf2f((bf16_t)(bu[j] >> 16));
                z[2 * j] = bf2f((bf16_t)(zu[j] & 0xffff)); z[2 * j + 1] = bf2f((bf16_t)(zu[j] >> 16));
            }
            float ss = 0.f;
#pragma unroll
            for (int j = 0; j < 8; ++j) ss += o[j] * o[j];
            ss += __shfl_xor(ss, 1); ss += __shfl_xor(ss, 2); ss += __shfl_xor(ss, 4); ss += __shfl_xor(ss, 8);
            const float rs = rsqrtf(ss * (1.f / 128.f) + 1e-6f);
            float r[8];
#pragma unroll
            for (int j = 0; j < 8; ++j) r[j] = o[j] * rs * p.in[24][(c8 + j) & 127] * siluf(z[j]);
            uint4 ov; ov.x = pack2(r[0], r[1]); ov.y = pack2(r[2], r[3]); ov.z = pack2(r[4], r[5]); ov.w = pack2(r[6], r[7]);
            *(uint4*)(MO + (size_t)R * DM + 512 + c8) = ov;
        }
    }
}

struct SchedOut {
    const char* A; const char* W; int nM;
    __device__ __forceinline__ bool next(int i, g8::Unit& u) const {
        int pm, pn; if (!g8::grid_order(i, nM, 4, pm, pn)) return false;
        u.pm = pm; u.pn = pn; u.e = 0; u.half = 0; u.mh = 0; u.nh = 0;
        u.a0 = A + (size_t)pm * 256 * DM * 2; u.a1 = u.a0 + (size_t)128 * DM * 2;
        u.b0 = W + (size_t)pn * 256 * DM * 2; u.b1 = u.b0 + (size_t)128 * DM * 2;
        return true;
    }
    __device__ __forceinline__ unsigned aoff(const g8::Unit&, int, int, int) const { return 0u; }
    __device__ __forceinline__ int araw(const g8::Unit&, int, int) const { return 0; }
    __device__ __forceinline__ unsigned afrom(int, int) const { return 0u; }
};
struct EpiOut {
    static constexpr bool PERM = false;
    const Params* p; int layer;
    __device__ __forceinline__ void operator()(const f32x4 (&acc)[2][2][4][2], const g8::Unit& u, int wr, int wc, int fr, int fq) const {
        const int row0 = u.pm * 256;
        const int mr = layer == 0 ? mod_row(row0) : row0 / SEQ;
        const float* gate = mod_ptr(*p, layer, mr, 2) + u.pn * 256 + wc * 32 + 4 * fq;
        f32x4 gv[2][2];
#pragma unroll
        for (int bj = 0; bj < 2; ++bj)
#pragma unroll
            for (int n = 0; n < 2; ++n) gv[bj][n] = *(const f32x4*)(gate + bj * 128 + n * 16);
#pragma unroll
        for (int ai = 0; ai < 2; ++ai) {
            f32x4 xv[4][2][2];
            const float* srcp[4]; float* dstp[4];
#pragma unroll
            for (int m = 0; m < 4; ++m) {
                const int row = row0 + ai * 128 + wr * 64 + m * 16 + fr;
                if (layer == 0) { srcp[m] = xin_row(*p, row); dstp[m] = xs_row(*p, row); }
                else { dstp[m] = p->out + (size_t)row * DM; srcp[m] = dstp[m]; }
                srcp[m] += u.pn * 256 + wc * 32 + 4 * fq; dstp[m] += u.pn * 256 + wc * 32 + 4 * fq;
#pragma unroll
                for (int bj = 0; bj < 2; ++bj)
#pragma unroll
                    for (int n = 0; n < 2; ++n) xv[m][bj][n] = *(const f32x4*)(srcp[m] + bj * 128 + n * 16);
            }
#pragma unroll
            for (int m = 0; m < 4; ++m)
#pragma unroll
                for (int bj = 0; bj < 2; ++bj)
#pragma unroll
                    for (int n = 0; n < 2; ++n) *(f32x4*)(dstp[m] + bj * 128 + n * 16) = xv[m][bj][n] + gv[bj][n] * acc[ai][bj][m][n];
        }
    }
};
__device__ __forceinline__ void phase_outproj(const Params& p, int layer, char* lds) {
    SchedOut S{p.ws + (layer == 0 ? OFF_H : L_AO), p.ws + (layer == 0 ? OFF_WOUT0 : OFF_WOUT1), layer == 0 ? NTOK / 256 : NB * SEQ / 256};
    EpiOut E{&p, layer};
    g8::gemm_phase<false>((LAS unsigned char*)lds, DM, S, E);
    if (layer == 0) { const int nb = (int)gridDim.x; if (nb > 64) convert_moe(p, 0, lds, 32, nb - 32); else convert_moe(p, 0, lds, 0, nb); }
}

__device__ __forceinline__ void phase_ffn_norm(const Params& p, int layer, char* lds) {
    const int lane = threadIdx.x & 63, wg = blockIdx.x * 8 + (threadIdx.x >> 6), nw = gridDim.x * 8;
    bf16_t* H = (bf16_t*)(p.ws + OFF_H);
    float* AFF = (float*)(p.ws + M_AFF);
    const float* router = p.in[28] + (size_t)layer * 1024 * 16;
    float* rt = (float*)lds;
    for (int i = threadIdx.x; i < 16384; i += NTHR) rt[(i & 15) * 1024 + (i >> 4)] = router[i];
    __syncthreads();
    const int nrow = layer == 0 ? NTOK : NB * SEQ;
    auto rowof = [&](int q) { return layer == 0 ? q : (q / SEQ) * TT + LC + (q % SEQ); };
    f32x4 xn[4];
    if (wg < nrow) load_row(xs_row(p, rowof(wg)), lane, xn);
    for (int q = wg; q < nrow; q += nw) {
        const int R = rowof(q);
        f32x4 x[4], h[4];
#pragma unroll
        for (int i = 0; i < 4; ++i) x[i] = xn[i];
        if (q + nw < nrow) load_row(xs_row(p, rowof(q + nw)), lane, xn);
        const int mr = mod_row(R);
        norm_mod(x, p.in[7] + layer * 1024, mod_ptr(p, layer, mr, 3), mod_ptr(p, layer, mr, 4), lane, h);
        store_h(H + (size_t)R * DM, lane, h);
        router_row(h, rt, lane, AFF + (size_t)R * 16);
    }
    __syncthreads();
}

__device__ __forceinline__ void phase_topk(const Params& p, int layer, char* lds) {
    const float* AFF = (const float*)(p.ws + M_AFF);
    int* SEL = (int*)(p.ws + M_SEL); int* IDX = (int*)(p.ws + M_IDX); float* GATE = (float*)(p.ws + M_GATE);
    int* hist = (int*)lds;
    int* wtot = hist + 256;
    int* res = wtot + 16;
    const int t = threadIdx.x, lane = t & 63, w = t >> 6;
    const int nunit = layer == 0 ? 256 : 128;
    const int SLOTS = layer == 0 ? 288 : 256, SL = NB * SLOTS;
    for (int u = blockIdx.x; u < nunit; u += gridDim.x) {
        const int isctx = (u >= 128) ? 1 : 0;
        const int b = (u & 127) >> 4, e = u & 15;
        const int n = isctx ? LC : SEQ, cap = n >> 3;
        const int Rbase = b * TT + (isctx ? 0 : LC);
        const int off = (layer == 0 && !isctx) ? 32 : 0;
        unsigned key[4]; float val[4];
        const bool own = 4 * t < n;
#pragma unroll
        for (int q = 0; q < 4; ++q) { val[q] = own ? AFF[(size_t)(Rbase + 4 * t + q) * 16 + e] : 0.f; key[q] = __float_as_uint(val[q]); }
        unsigned prefix = 0u; int remaining = cap;
#pragma unroll 1
        for (int pass = 3; pass >= 0; --pass) {
            if (t < 256) hist[t] = 0;
            __syncthreads();
            if (own) {
#pragma unroll
                for (int q = 0; q < 4; ++q)
                    if (pass == 3 || (key[q] >> (8 * (pass + 1))) == prefix) atomicAdd(&hist[(key[q] >> (8 * pass)) & 255u], 1);
            }
            __syncthreads();
            if (w == 0) {
                const int g = 63 - lane;
                const int h0 = hist[4 * g], h1 = hist[4 * g + 1], h2 = hist[4 * g + 2], h3 = hist[4 * g + 3];
                const int v = h0 + h1 + h2 + h3;
                const int incl = (int)wave_incl_scan((float)v, lane);
                const int excl = incl - v;
                if (excl < remaining && remaining <= incl) {
                    int above = excl, bin;
                    if (above + h3 >= remaining) bin = 4 * g + 3;
                    else { above += h3; if (above + h2 >= remaining) bin = 4 * g + 2; else { above += h2; if (above + h1 >= remaining) bin = 4 * g + 1; else { above += h1; bin = 4 * g; } } }
                    res[0] = bin; res[1] = above;
                }
            }
            __syncthreads();
            prefix = (prefix << 8) | (unsigned)res[0];
            remaining -= res[1];
            __syncthreads();
        }
        int cg = 0, ce = 0;
#pragma unroll
        for (int q = 0; q < 4; ++q) { cg += (own && key[q] > prefix) ? 1 : 0; ce += (own && key[q] == prefix) ? 1 : 0; }
        const int ig = (int)wave_incl_scan((float)cg, lane), ie = (int)wave_incl_scan((float)ce, lane);
        if (lane == 63) { wtot[w] = ig; wtot[8 + w] = ie; }
        __syncthreads();
        int bg = ig - cg, be = ie - ce;
        for (int w2 = 0; w2 < w; ++w2) { bg += wtot[w2]; be += wtot[8 + w2]; }
        if (own) {
#pragma unroll
            for (int q = 0; q < 4; ++q) {
                const int R = Rbase + 4 * t + q;
                const bool gt = key[q] > prefix, eq = key[q] == prefix;
                const bool sel = gt || (eq && be < remaining);
                if (sel) {
                    const int slot = b * SLOTS + off + bg + (be < remaining ? be : remaining);
                    IDX[e * SL + slot] = R; GATE[e * SL + slot] = val[q]; SEL[(size_t)R * 16 + e] = slot;
                } else SEL[(size_t)R * 16 + e] = -1;
                bg += gt ? 1 : 0; be += eq ? 1 : 0;
            }
        }
        __syncthreads();
    }
}

struct SchedMoe1 {
    const char* H; const char* W1; const char* W3; const int* IDX; int SL, npm;
    __device__ __forceinline__ bool next(int i, g8::Unit& u) const {
        const int Q = 16 * npm;
        int q, pn, sub = 0, pieces = 1;
        if (gridDim.x == 256 && (Q & 15) == 0) {
            const int xcd = blockIdx.x & 7, j = blockIdx.x >> 3, R = Q / 32;
            if (i < R) { q = i * 32 + xcd * 4 + (j >> 3); pn = j & 7; }
            else if (i == R && Q - R * 32 == 16) { q = R * 32 + xcd * 2 + (j >> 4); pn = (j >> 1) & 7; sub = j & 1; pieces = 2; }
            else return false;
        } else {
            int L; if (!g8::tail_split(i, Q * 8, 2, L, sub, pieces)) return false;
            q = L >> 3; pn = L & 7;
        }
        const int e = q / npm;
        u.e = e; u.pm = q - e * npm; u.pn = pn; u.mh = sub; u.nh = 0; u.half = pieces == 2 ? 2 : 0;
        u.a0 = H; u.a1 = H;
        u.b0 = W1 + ((size_t)e * 1024 + u.pn * 128) * DM * 2; u.b1 = W3 + ((size_t)e * 1024 + u.pn * 128) * DM * 2;
        return true;
    }
    __device__ __forceinline__ unsigned aoff(const g8::Unit& u, int h, int R, int C) const {
        return (unsigned)(IDX[u.e * SL + u.pm * 256 + (h + u.mh) * 128 + R] * DM + C) * 2u;
    }
    __device__ __forceinline__ int araw(const g8::Unit& u, int h, int R) const { return IDX[u.e * SL + u.pm * 256 + (h + u.mh) * 128 + R]; }
    __device__ __forceinline__ unsigned afrom(int raw, int C) const { return (unsigned)(raw * DM + C) * 2u; }
};
struct EpiMoe1 {
    static constexpr bool PERM = true;
    bf16_t* HID; int SL;
    __device__ __forceinline__ void operator()(const f32x4 (&acc)[2][2][4][2], const g8::Unit& u, int wr, int wc, int fr, int fq) const {
#pragma unroll
        for (int ai = 0; ai < 2; ++ai)
#pragma unroll
            for (int m = 0; m < 4; ++m) {
                const int row = u.e * SL + u.pm * 256 + (ai + u.mh) * 128 + wr * 64 + m * 16 + fr;
                const int f = u.pn * 128 + wc * 32 + 8 * fq;
                if (ai == 1 && (u.half & 2)) continue;
                uint2 t[2];
#pragma unroll
                for (int n = 0; n < 2; ++n) {
                    const f32x4 a = acc[ai][0][m][n], g = acc[ai][1][m][n];
                    t[n] = pk4((f32x4){siluf(a[0]) * g[0], siluf(a[1]) * g[1], siluf(a[2]) * g[2], siluf(a[3]) * g[3]});
                }
                *(uint4*)(HID + (size_t)row * 1024 + f) = make_uint4(t[0].x, t[0].y, t[1].x, t[1].y);
            }
    }
};
__device__ __forceinline__ void phase_moe1(const Params& p, int layer, char* lds) {
    const int SL = layer == 0 ? 2304 : 2048;
    SchedMoe1 S{p.ws + OFF_H, p.ws + M_W, p.ws + M_W + 16ull * 1024 * 1024 * 2, (const int*)(p.ws + M_IDX), SL, SL / 256};
    EpiMoe1 E{(bf16_t*)(p.ws + M_HID), SL};
    g8::gemm_phase<true>((LAS unsigned char*)lds, DM, S, E);
}

struct SchedMoe2 {
    const char* HID; const char* W2; int SL, npm;
    __device__ __forceinline__ bool next(int i, g8::Unit& u) const {
        const int Q = 16 * npm;
        int q, pn, sub = 0, pieces = 1;
        if (gridDim.x == 256 && (Q & 15) == 0) {
            const int xcd = blockIdx.x & 7, j = blockIdx.x >> 3, R = Q / 64;
            if (i < R) { q = i * 64 + xcd * 8 + (j >> 2); pn = j & 3; }
            else if (i == R && Q - R * 64 == 16) { q = R * 64 + xcd * 2 + (j >> 4); pn = (j >> 2) & 3; sub = j & 3; pieces = 4; }
            else return false;
        } else {
            int L; if (!g8::tail_split(i, Q * 4, 4, L, sub, pieces)) return false;
            q = L >> 2; pn = L & 3;
        }
        const int e = q / npm;
        u.e = e; u.pm = q - e * npm; u.pn = pn;
        u.half = pieces == 4 ? 3 : pieces == 2 ? 1 : 0; u.nh = sub & 1; u.mh = pieces == 4 ? (sub >> 1) : 0;
        u.a0 = HID + ((size_t)e * SL + u.pm * 256 + u.mh * 128) * 1024 * 2; u.a1 = (u.half & 2) ? u.a0 : u.a0 + (size_t)128 * 1024 * 2;
        u.b0 = W2 + ((size_t)e * 1024 + u.pn * 256 + u.nh * 128) * 1024 * 2; u.b1 = (u.half & 1) ? u.b0 : u.b0 + (size_t)128 * 1024 * 2;
        return true;
    }
    __device__ __forceinline__ unsigned aoff(const g8::Unit&, int, int, int) const { return 0u; }
    __device__ __forceinline__ int araw(const g8::Unit&, int, int) const { return 0; }
    __device__ __forceinline__ unsigned afrom(int, int) const { return 0u; }
};
struct EpiMoe2 {
    static constexpr bool PERM = true;
    bf16_t* YE; const float* GATE; int SL;
    __device__ __forceinline__ void operator()(const f32x4 (&acc)[2][2][4][2], const g8::Unit& u, int wr, int wc, int fr, int fq) const {
#pragma unroll
        for (int ai = 0; ai < 2; ++ai)
#pragma unroll
            for (int m = 0; m < 4; ++m) {
                const int row = u.e * SL + u.pm * 256 + (ai + u.mh) * 128 + wr * 64 + m * 16 + fr;
                if (ai == 1 && (u.half & 2)) continue;
                const float g = GATE[row];
#pragma unroll
                for (int bj = 0; bj < 2; ++bj) {
                    const int col = u.pn * 256 + (bj + u.nh) * 128 + wc * 32 + 8 * fq;
                    if (bj == 1 && (u.half & 1)) continue;
                    const uint2 t0 = pk4(acc[ai][bj][m][0] * g), t1 = pk4(acc[ai][bj][m][1] * g);
                    *(uint4*)(YE + (size_t)row * 1024 + col) = make_uint4(t0.x, t0.y, t1.x, t1.y);
                }
            }
    }
};
__device__ __forceinline__ void phase_moe2(const Params& p, int layer, char* lds) {
    const int SL = layer == 0 ? 2304 : 2048;
    SchedMoe2 S{p.ws + M_HID, p.ws + M_W + 32ull * 1024 * 1024 * 2, SL, SL / 256};
    EpiMoe2 E{(bf16_t*)(p.ws + M_YE), (const float*)(p.ws + M_GATE), SL};
    g8::gemm_phase<false>((LAS unsigned char*)lds, 1024, S, E);
}

__device__ __forceinline__ void phase_combine(const Params& p, int layer, char* lds) {
    const int lane = threadIdx.x & 63, wg = blockIdx.x * 8 + (threadIdx.x >> 6), nw = gridDim.x * 8;
    const int* SEL = (const int*)(p.ws + M_SEL);
    const bf16_t* YE = (const bf16_t*)(p.ws + M_YE);
    bf16_t* H = (bf16_t*)(p.ws + OFF_H);
    const int SL = layer == 0 ? 2304 : 2048;
    const int nrow = layer == 0 ? NTOK : NB * SEQ;
    auto rowof = [&](int q) { return layer == 0 ? q : (q / SEQ) * TT + LC + (q % SEQ); };
    f32x4 xn[4]; int seln = -1;
    if (wg < nrow) { const int R0 = rowof(wg); load_row(xs_row(p, R0), lane, xn); seln = SEL[(size_t)R0 * 16 + (lane & 15)]; }
    for (int q = wg; q < nrow; q += nw) {
        const int R = rowof(q);
        float* xr = xs_row(p, R);
        f32x4 x[4], sum[4];
#pragma unroll
        for (int i = 0; i < 4; ++i) { x[i] = xn[i]; sum[i] = (f32x4){0.f, 0.f, 0.f, 0.f}; }
        const int selv = seln;
        if (q + nw < nrow) { const int Rn = rowof(q + nw); load_row(xs_row(p, Rn), lane, xn); seln = SEL[(size_t)Rn * 16 + (lane & 15)]; }
        unsigned mask = (unsigned)(__ballot(selv >= 0) & 0xFFFFull);
        while (mask) {
            const bf16_t* yr[4]; float wgt[4];
#pragma unroll
            for (int j = 0; j < 4; ++j) {
                const bool on = mask != 0u;
                const int e = on ? __builtin_ctz(mask) : 0;
                const int sl = __builtin_amdgcn_readlane(selv, e);
                mask = on ? (mask & (mask - 1u)) : 0u;
                yr[j] = YE + ((size_t)(on ? e : 0) * SL + (on ? sl : 0)) * 1024;
                wgt[j] = on ? 1.f : 0.f;
            }
            f32x4 v[4][4];
#pragma unroll
            for (int j = 0; j < 4; ++j)
#pragma unroll
                for (int i = 0; i < 4; ++i) v[j][i] = ld_bf4(yr[j] + 4 * lane + 256 * i);
#pragma unroll
            for (int j = 0; j < 4; ++j)
#pragma unroll
                for (int i = 0; i < 4; ++i) sum[i] += v[j][i] * wgt[j];
        }
        const int mr = mod_row(R);
        const float* g5 = mod_ptr(p, layer, mr, 5);
#pragma unroll
        for (int i = 0; i < 4; ++i) x[i] += *(const f32x4*)(g5 + 4 * lane + 256 * i) * sum[i];
        if (layer == 0) {
#pragma unroll
            for (int i = 0; i < 4; ++i) *(f32x4*)(xr + 4 * lane + 256 * i) = x[i];
            f32x4 h[4];
            norm_mod(x, p.in[6] + 1024, mod_ptr(p, 1, mr, 0), mod_ptr(p, 1, mr, 1), lane, h);
            store_h(H + (size_t)R * DM, lane, h);
        } else {
            const float rs = row_rs(x);
#pragma unroll
            for (int i = 0; i < 4; ++i) *(f32x4*)(xr + 4 * lane + 256 * i) = x[i] * rs * *(const f32x4*)(p.in[32] + 4 * lane + 256 * i);
        }
    }
}

struct SchedIn1 {
    const char* H; const char* W;
    __device__ __forceinline__ bool next(int i, g8::Unit& u) const {
        const long L = (long)i * gridDim.x + blockIdx.x; if (L >= 400) return false;
        int pm, pn;
        if (L < 384) { const int pl = (int)L / 6; pn = (int)L % 6; pm = (pl >> 3) * 9 + 1 + (pl & 7); }
        else { const int v = (int)L - 384; pm = (v >> 1) * 9; pn = 4 + (v & 1); }
        u.pm = pm; u.pn = pn; u.e = 0; u.half = 0; u.mh = 0; u.nh = 0;
        u.a0 = H + (size_t)pm * 256 * DM * 2; u.a1 = u.a0 + (size_t)128 * DM * 2;
        u.b0 = W + (size_t)pn * 256 * DM * 2; u.b1 = u.b0 + (size_t)128 * DM * 2;
        return true;
    }
    __device__ __forceinline__ unsigned aoff(const g8::Unit&, int, int, int) const { return 0u; }
    __device__ __forceinline__ int araw(const g8::Unit&, int, int) const { return 0; }
    __device__ __forceinline__ unsigned afrom(int, int) const { return 0u; }
};
struct EpiIn1 {
    static constexpr bool PERM = false;
    bf16_t* QB; bf16_t* KB; bf16_t* VT; const float* rope;
    __device__ __forceinline__ void operator()(const f32x4 (&acc)[2][2][4][2], const g8::Unit& u, int wr, int wc, int fr, int fq) const {
        const int bidx = u.pm / 9;
        const bool islat = (u.pm % 9) != 0;
        const bool dorope = islat && u.pn < 5;
        const float qs = u.pn < 4 ? 0.125f * 1.4426950408889634f : 1.f;
#pragma unroll
        for (int ai = 0; ai < 2; ++ai)
#pragma unroll
            for (int m = 0; m < 4; ++m) {
                const int row = u.pm * 256 + ai * 128 + wr * 64 + m * 16 + fr;
                const int sidx = row - bidx * TT, tl = sidx - LC;
                const int pos = (wc & 1) == 0 ? (tl >> 6) : (tl & 63);
                f32x4 cs = (f32x4){1.f, 1.f, 1.f, 1.f}, sn = (f32x4){0.f, 0.f, 0.f, 0.f};
                if (dorope) { cs = *(const f32x4*)(rope + pos * 16 + 4 * fq); sn = *(const f32x4*)(rope + 1024 + pos * 16 + 4 * fq); }
#pragma unroll
                for (int bj = 0; bj < 2; ++bj) {
                    const f32x4 p1 = acc[ai][bj][m][0], p2 = acc[ai][bj][m][1];
                    const f32x4 o1 = (p1 * cs - p2 * sn) * qs, o2 = (p2 * cs + p1 * sn) * qs;
                    const int col = u.pn * 256 + bj * 128 + wc * 32 + 4 * fq;
                    if (u.pn < 4) {
                        st_bf4(QB + (size_t)row * 1024 + col, o1); st_bf4(QB + (size_t)row * 1024 + col + 16, o2);
                    } else if (u.pn == 4) {
                        st_bf4(KB + (size_t)row * 256 + (col - 1024), o1); st_bf4(KB + (size_t)row * 256 + (col - 1024) + 16, o2);
                    } else {
                        const int hd = col - 1280;
                        bf16_t* vp = VT + ((size_t)(bidx * 256 + hd)) * TT + sidx;
                        vp[0] = f2bf(o1[0]); vp[TT] = f2bf(o1[1]); vp[2 * TT] = f2bf(o1[2]); vp[3 * TT] = f2bf(o1[3]);
                        vp[16 * TT] = f2bf(o2[0]); vp[17 * TT] = f2bf(o2[1]); vp[18 * TT] = f2bf(o2[2]); vp[19 * TT] = f2bf(o2[3]);
                    }
                }
            }
    }
};
__device__ __forceinline__ void phase_inproj1(const Params& p, char* lds) {
    SchedIn1 S{p.ws + OFF_H, p.ws + OFF_WIN1};
    EpiIn1 E{(bf16_t*)(p.ws + L_QB), (bf16_t*)(p.ws + L_KB), (bf16_t*)(p.ws + L_VT), (const float*)(p.ws + OFF_ROPE)};
    g8::gemm_phase<false>((LAS unsigned char*)lds, DM, S, E);
    { const int nb = (int)gridDim.x; if (nb > 200) convert_moe(p, 1, lds, 144, nb - 144); else convert_moe(p, 1, lds, 0, nb); }
}

typedef unsigned u32x2_t __attribute__((ext_vector_type(2)));
__device__ __forceinline__ float max_x16_x32(float v) {
    u32x2_t r = __builtin_amdgcn_permlane16_swap(__float_as_uint(v), __float_as_uint(v), false, false);
    v = fmaxf(__uint_as_float(r[0]), __uint_as_float(r[1]));
    r = __builtin_amdgcn_permlane32_swap(__float_as_uint(v), __float_as_uint(v), false, false);
    return fmaxf(__uint_as_float(r[0]), __uint_as_float(r[1]));
}
__device__ __forceinline__ float sum_x16_x32(float v) {
    u32x2_t r = __builtin_amdgcn_permlane16_swap(__float_as_uint(v), __float_as_uint(v), false, false);
    v = __uint_as_float(r[0]) + __uint_as_float(r[1]);
    r = __builtin_amdgcn_permlane32_swap(__float_as_uint(v), __float_as_uint(v), false, false);
    return __uint_as_float(r[0]) + __uint_as_float(r[1]);
}
__device__ __forceinline__ void phase_attn(const Params& p, char* lds) {
    const bf16_t* QB = (const bf16_t*)(p.ws + L_QB); const bf16_t* KB = (const bf16_t*)(p.ws + L_KB); const bf16_t* VT = (const bf16_t*)(p.ws + L_VT);
    bf16_t* AO = (bf16_t*)(p.ws + L_AO);
    constexpr int VROW = 136, STG = 8192 + 64 * VROW;
    const int t = threadIdx.x, lane = t & 63, w = t >> 6, fr = lane & 15, fq = lane >> 4;
    const int g = w & 3, qh = w >> 2;
    const int srow = t >> 3, sc16 = t & 7;
    for (int u = blockIdx.x; u < 512; u += gridDim.x) {
        const int qt = u & 15, hkv = (u >> 4) & 3, b = u >> 6;
        const int hq = hkv * 4 + g;
        const int q0 = qt * 128, qa = q0 + qh * 64;
        char* Qs = lds + 2 * STG + w * 8192;
        {
            const bf16_t* qsrc = QB + (size_t)(b * TT + LC + qa) * 1024 + hq * 64;
#pragma unroll
            for (int it = 0; it < 8; ++it) {
                const int row = it * 8 + (lane >> 3), ch = lane & 7;
                *(uint4*)(Qs + swz(row, ch)) = *(const uint4*)(qsrc + (size_t)row * 1024 + ch * 8);
            }
        }
        f32x4 O[4][4];
        float mrow[4], lrow[4];
#pragma unroll
        for (int mi = 0; mi < 4; ++mi) {
            mrow[mi] = -1e30f; lrow[mi] = 0.f;
#pragma unroll
            for (int dt = 0; dt < 4; ++dt) O[mi][dt] = (f32x4){0.f, 0.f, 0.f, 0.f};
        }
        const int c_lo = (q0 == 0) ? 2 : 0, c_hi = (q0 + 256 > SEQ) ? 4 : 6;
        const int nch = (c_hi - c_lo) + 4;
        const int nloc = c_hi - c_lo;
        const bf16_t* kbase = KB + (size_t)(b * TT) * 256 + hkv * 64 + sc16 * 8;
        const bf16_t* vbase = VT + ((size_t)((b * 4 + hkv) * 64 + srow)) * TT + sc16 * 8;
        uint4 kreg, vreg;
        {
            const int s0 = (0 < nloc) ? LC + q0 - 128 + 64 * c_lo : 0;
            kreg = *(const uint4*)(kbase + (size_t)(s0 + srow) * 256);
            vreg = *(const uint4*)(vbase + s0);
            char* Ks = lds; char* Vs = lds + 8192;
            *(uint4*)(Ks + swz(srow, sc16)) = kreg;
            *(uint2*)(Vs + srow * VROW + sc16 * 16) = make_uint2(vreg.x, vreg.y);
            *(uint2*)(Vs + srow * VROW + sc16 * 16 + 8) = make_uint2(vreg.z, vreg.w);
        }
        __syncthreads();
        for (int i = 0; i < nch; ++i) {
            const bool more = (i + 1 < nch);
            if (more) {
                const int i1 = i + 1;
                const int s1 = (i1 < nloc) ? LC + q0 - 128 + 64 * (c_lo + i1) : 64 * (i1 - nloc);
                kreg = *(const uint4*)(kbase + (size_t)(s1 + srow) * 256);
                vreg = *(const uint4*)(vbase + s1);
            }
            const bool isloc = i < nloc;
            const int kc = q0 - 128 + 64 * (c_lo + i);
            const bool relevant = !isloc || (kc + 63 >= qa - 128 && kc <= qa + 63 + 128);
            const bool needmask = isloc && !(kc >= qa + 63 - 128 && kc + 63 <= qa + 128);
            if (relevant) {
                const char* Ks = lds + (i & 1) * STG;
                const char* Vs = Ks + 8192;
#pragma unroll
                for (int mh = 0; mh < 2; ++mh) {
                    bf16x8 qf[2][2];
                    int qrow = mh * 32 + fr;
                    asm volatile("" : "+v"(qrow));
#pragma unroll
                    for (int m2 = 0; m2 < 2; ++m2)
#pragma unroll
                        for (int kk = 0; kk < 2; ++kk) qf[m2][kk] = *(const bf16x8*)(Qs + swz(qrow + 16 * m2, kk * 4 + fq));
                    f32x4 S[2][4];
#pragma unroll
                    for (int m2 = 0; m2 < 2; ++m2)
#pragma unroll
                        for (int ni = 0; ni < 4; ++ni) S[m2][ni] = (f32x4){0.f, 0.f, 0.f, 0.f};
#pragma unroll
                    for (int kk = 0; kk < 2; ++kk) {
                        bf16x8 kf[4];
#pragma unroll
                        for (int ni = 0; ni < 4; ++ni) kf[ni] = *(const bf16x8*)(Ks + swz(16 * ni + fr, kk * 4 + fq));
#pragma unroll
                        for (int m2 = 0; m2 < 2; ++m2)
#pragma unroll
                            for (int ni = 0; ni < 4; ++ni) S[m2][ni] = __builtin_amdgcn_mfma_f32_16x16x32_bf16(kf[ni], qf[m2][kk], S[m2][ni], 0, 0, 0);
                    }
                    bf16x8 pf[2][2];
#pragma unroll
                    for (int m2 = 0; m2 < 2; ++m2) {
                        const int mi = mh * 2 + m2;
                        if (needmask) {
                            const int qpos = qa + 16 * mi + fr;
#pragma unroll
                            for (int ni = 0; ni < 4; ++ni)
#pragma unroll
                                for (int r = 0; r < 4; ++r) {
                                    const int dist = qpos - (kc + 16 * ni + 4 * fq + r);
                                    S[m2][ni][r] = (dist <= 128 && dist >= -128) ? S[m2][ni][r] : -1e30f;
                                }
                        }
                        float mx = -1e30f;
#pragma unroll
                        for (int ni = 0; ni < 4; ++ni) mx = fmaxf(fmaxf(mx, fmaxf(S[m2][ni][0], S[m2][ni][1])), fmaxf(S[m2][ni][2], S[m2][ni][3]));
                        mx = max_x16_x32(mx);
                        const float mn = fmaxf(mrow[mi], mx);
                        const float scale = __builtin_amdgcn_exp2f(mrow[mi] - mn);
                        mrow[mi] = mn;
                        float ls = 0.f;
                        if (needmask) {
#pragma unroll
                            for (int ni = 0; ni < 4; ++ni)
#pragma unroll
                                for (int r = 0; r < 4; ++r) {
                                    const float pv = S[m2][ni][r] > -1e29f ? __builtin_amdgcn_exp2f(S[m2][ni][r] - mn) : 0.f;
                                    S[m2][ni][r] = pv; ls += pv;
                                }
                        } else {
#pragma unroll
                            for (int ni = 0; ni < 4; ++ni)
#pragma unroll
                                for (int r = 0; r < 4; ++r) {
                                    const float pv = __builtin_amdgcn_exp2f(S[m2][ni][r] - mn);
                                    S[m2][ni][r] = pv; ls += pv;
                                }
                        }
                        lrow[mi] = lrow[mi] * scale + ls;
#pragma unroll
                        for (int dt = 0; dt < 4; ++dt) O[mi][dt] *= scale;
#pragma unroll
                        for (int kk = 0; kk < 2; ++kk) {
                            union { bf16x8 v; unsigned u[4]; } pk;
                            pk.u[0] = pack2(S[m2][2 * kk][0], S[m2][2 * kk][1]); pk.u[1] = pack2(S[m2][2 * kk][2], S[m2][2 * kk][3]);
                            pk.u[2] = pack2(S[m2][2 * kk + 1][0], S[m2][2 * kk + 1][1]); pk.u[3] = pack2(S[m2][2 * kk + 1][2], S[m2][2 * kk + 1][3]);
                            pf[m2][kk] = pk.v;
                        }
                    }
#pragma unroll
                    for (int dt = 0; dt < 4; ++dt)
#pragma unroll
                        for (int kk = 0; kk < 2; ++kk) {
                            union { bf16x8 v; uint2 h[2]; } vf;
                            const char* vp = Vs + (16 * dt + fr) * VROW + (32 * kk + 4 * fq) * 2;
                            vf.h[0] = *(const uint2*)vp;
                            vf.h[1] = *(const uint2*)(vp + 32);
#pragma unroll
                            for (int m2 = 0; m2 < 2; ++m2) O[mh * 2 + m2][dt] = __builtin_amdgcn_mfma_f32_16x16x32_bf16(vf.v, pf[m2][kk], O[mh * 2 + m2][dt], 0, 0, 0);
                        }
                }
            }
            if (more) {
                char* Ks = lds + ((i + 1) & 1) * STG; char* Vs = Ks + 8192;
                *(uint4*)(Ks + swz(srow, sc16)) = kreg;
                *(uint2*)(Vs + srow * VROW + sc16 * 16) = make_uint2(vreg.x, vreg.y);
                *(uint2*)(Vs + srow * VROW + sc16 * 16 + 8) = make_uint2(vreg.z, vreg.w);
            }
            __syncthreads();
        }
        const float sk = p.in[27][hq] * 1.4426950408889634f;
#pragma unroll
        for (int mi = 0; mi < 4; ++mi) {
            const float mf = fmaxf(mrow[mi], sk);
            const float scale = __builtin_amdgcn_exp2f(mrow[mi] - mf);
            const float l = sum_x16_x32(lrow[mi]) * scale + __builtin_amdgcn_exp2f(sk - mf);
            const float inv = scale / l;
            bf16_t* op = AO + (size_t)(b * SEQ + qa + 16 * mi + fr) * DM + hq * 64 + 4 * fq;
#pragma unroll
            for (int dt = 0; dt < 4; ++dt) {
                uint2 o;
                o.x = pack2(O[mi][dt][0] * inv, O[mi][dt][1] * inv);
                o.y = pack2(O[mi][dt][2] * inv, O[mi][dt][3] * inv);
                *(uint2*)(op + 16 * dt) = o;
            }
        }
    }
}

constexpr int NPHASE = 20;
__global__ void __launch_bounds__(NTHR) mega(Params p) {
    extern __shared__ __attribute__((aligned(16))) char lds[];
    cg::grid_group grid = cg::this_grid();
    volatile LAS unsigned* xbst = (volatile LAS unsigned*)(lds + LDS_MAIN);
    if (threadIdx.x == 0) { xbst[0] = 0u; xbst[1] = 0u; xbst[2] = 0u; xbst[3] = 0u; }
    __syncthreads();
    const XcdBarrier xb = xcd_barrier_post((unsigned*)(p.ws + OFF_BAR), xbst);
    if (p.ph_lo < 0) grid.sync();
#ifndef PH_MASK
#define PH_MASK 0xFFFFF
#endif
#ifndef REP_MASK
#define REP_MASK 0
#endif
#define RUN(n, call) if (((PH_MASK >> n) & 1) && p.ph_lo <= n && n < p.ph_hi) { call; if ((REP_MASK >> n) & 1) { xcd_barrier(xb); call; } if (n + 1 < p.ph_hi) xcd_barrier(xb); }
    RUN(0, phase0(p, lds))
    RUN(1, phase1(p))
    RUN(2, phase2(p, lds))
    RUN(3, phase3(p, lds, xb))
    RUN(4, phase4(p, lds, xb))
    RUN(5, phase5(p, lds))
    RUN(6, phase_outproj(p, 0, lds))
    RUN(7, phase_ffn_norm(p, 0, lds))
    RUN(8, phase_topk(p, 0, lds))
    RUN(9, phase_moe1(p, 0, lds))
    RUN(10, phase_moe2(p, 0, lds))
    RUN(11, phase_combine(p, 0, lds))
    RUN(12, phase_inproj1(p, lds))
    RUN(13, phase_attn(p, lds))
    RUN(14, phase_outproj(p, 1, lds))
    RUN(15, phase_ffn_norm(p, 1, lds))
    RUN(16, phase_topk(p, 1, lds))
    RUN(17, phase_moe1(p, 1, lds))
    RUN(18, phase_moe2(p, 1, lds))
    RUN(19, phase_combine(p, 1, lds))
#undef RUN
}

extern "C" void kernel_launch(void* const* d_in, const int* in_sizes, int n_in, void* d_out, int out_size, void* d_ws, size_t ws_size, hipStream_t stream) {
    static int grid_blocks = 0;
    if (grid_blocks == 0) {
        if (n_in != 33 || ws_size < WS_NEED) { fprintf(stderr, "kernel_launch: unexpected n_in %d or ws_size %zu (need %zu)\n", n_in, ws_size, (size_t)WS_NEED); grid_blocks = -1; return; }
        int dev = 0, cus = 0, per_cu = 0;
        (void)hipGetDevice(&dev);
        (void)hipDeviceGetAttribute(&cus, hipDeviceAttributeMultiprocessorCount, dev);
        (void)hipFuncSetAttribute((const void*)mega, hipFuncAttributeMaxDynamicSharedMemorySize, LDS_BYTES);
        (void)hipOccupancyMaxActiveBlocksPerMultiprocessor(&per_cu, (const void*)mega, NTHR, LDS_BYTES);
        if (per_cu < 1) { fprintf(stderr, "kernel_launch: occupancy query says %d blocks per CU\n", per_cu); per_cu = 1; }
        if (per_cu > 1) per_cu = 1;
        grid_blocks = cus * per_cu;
        (void)hipGetLastError();
    }
    if (grid_blocks < 0) return;
    if (hipMemsetAsync((char*)d_ws + OFF_BAR, 0, SZ_BAR, stream) != hipSuccess) { fprintf(stderr, "kernel_launch: memset failed\n"); return; }
    Params p{};
    for (int i = 0; i < 33; ++i) p.in[i] = (const float*)d_in[i];
    p.out = (float*)d_out;
    p.ws = (char*)d_ws;
    p.ph_lo = 0; p.ph_hi = NPHASE;
    void* args[] = {&p};
    hipError_t e = hipLaunchCooperativeKernel((const void*)mega, dim3(grid_blocks), dim3(NTHR), args, LDS_BYTES, stream);
    if (e != hipSuccess) fprintf(stderr, "cooperative launch failed: %s (grid %d)\n", hipGetErrorString(e), grid_blocks);
}
```

```cpp
#include <hip/hip_runtime.h>
#include <hip/hip_cooperative_groups.h>
#include <cstdio>
#include <cstdint>
namespace cg = cooperative_groups;

typedef unsigned short bf16_t;
typedef short bf16x8 __attribute__((ext_vector_type(8)));
typedef float f32x4 __attribute__((ext_vector_type(4)));
typedef unsigned u32x4 __attribute__((ext_vector_type(4)));

constexpr int NB = 8, SEQ = 2048, LC = 256, TT = 2304, DM = 1024, NTOK = NB * TT;
constexpr int EIN = 3984;
constexpr int NTHR = 512;
constexpr int LDS_MAIN = 155648;
constexpr int LDS_BYTES = LDS_MAIN + 16;

constexpr size_t SZ_MOD = 2ull * 9 * 6144 * 4;
constexpr size_t OFF_BAR = 0;
constexpr size_t SZ_BAR = 16384;
constexpr size_t OFF_MOD = OFF_BAR + SZ_BAR;
constexpr size_t OFF_ROPE = OFF_MOD + SZ_MOD;
constexpr size_t OFF_WIN0 = OFF_ROPE + 8192;
constexpr size_t OFF_WOUT0 = OFF_WIN0 + 4096ull * 1024 * 2;
constexpr size_t OFF_WIN1 = OFF_WOUT0 + 1024ull * 1024 * 2;
constexpr size_t OFF_WOUT1 = OFF_WIN1 + 1536ull * 1024 * 2;
constexpr size_t OFF_LORA = OFF_WOUT1 + 1024ull * 1024 * 2;
constexpr size_t OFF_XCTX = OFF_LORA + 196608ull * 2;
constexpr size_t OFF_H = OFF_XCTX + (size_t)NB * LC * DM * 4;
constexpr size_t OFF_BIG = OFF_H + (size_t)NTOK * DM * 2;
constexpr size_t SZ_T512 = (size_t)NTOK * 512 * 2;
constexpr size_t B_EW = OFF_BIG;
constexpr size_t B_KD = B_EW + 2 * SZ_T512;
constexpr size_t B_BD = B_KD + 2 * SZ_T512;
constexpr size_t B_RR = B_BD + 2 * SZ_T512;
constexpr size_t B_KK = B_RR + SZ_T512;
constexpr size_t B_GQ = B_KK + SZ_T512;
constexpr size_t B_GK = B_GQ + SZ_T512;
constexpr size_t B_GV = B_GK + SZ_T512;
constexpr size_t B_VV = B_GV + SZ_T512;
constexpr size_t B_GG = B_VV + SZ_T512;
constexpr size_t B_BC = B_GG + SZ_T512;
constexpr size_t B_GDG = B_BC + (size_t)NTOK * 8 * 4;
constexpr size_t B_GDB = B_GDG + (size_t)NTOK * 8 * 4;
constexpr size_t B_P = B_GDB + (size_t)NTOK * 8 * 4;
constexpr size_t B_YF = B_P + (size_t)NTOK * EIN * 2;
constexpr size_t B_YB = B_YF + SZ_T512;
constexpr size_t B_OF = B_YB + SZ_T512;
constexpr size_t B_OB = B_OF + SZ_T512;
constexpr size_t B_ZZ = B_OB + SZ_T512;
constexpr size_t B_END = B_ZZ + SZ_T512;
constexpr size_t C_GMW = B_P;
constexpr size_t C_GMU = C_GMW + 2304ull * 4096 * 2;
constexpr size_t C_RM = C_GMU + 2304ull * 4096 * 2;
static_assert(C_RM + 4608ull * 4096 * 2 <= B_YF, "chunk inverses must fit inside P");
constexpr size_t M_W = OFF_BIG;
constexpr size_t M_AFF = M_W + 3ull * 16 * 1024 * 1024 * 2;
constexpr size_t M_SEL = M_AFF + (size_t)NTOK * 16 * 4;
constexpr size_t M_IDX = M_SEL + (size_t)NTOK * 16 * 4;
constexpr size_t M_GATE = M_IDX + 16ull * 2304 * 4;
constexpr size_t M_HID = M_GATE + 16ull * 2304 * 4;
constexpr size_t M_YE = M_HID + 16ull * 2304 * 1024 * 2;
constexpr size_t M_END = M_YE + 16ull * 2304 * 1024 * 4;
constexpr size_t L_QB = M_HID;
constexpr size_t L_KB = L_QB + (size_t)NTOK * 1024 * 2;
constexpr size_t L_VT = L_KB + (size_t)NTOK * 256 * 2;
constexpr size_t L_AO = L_VT + (size_t)NTOK * 256 * 2;
constexpr size_t L_END = L_AO + (size_t)NB * SEQ * DM * 2;
constexpr size_t WS_NEED = B_END > M_END ? B_END : M_END;
static_assert(L_END <= M_END, "layer-1 buffers must fit below the MoE buffers' end");
static_assert(M_AFF <= B_VV, "MoE weights must only alias buffers dead after the scans");
static_assert(WS_NEED <= 560000000ull, "workspace too large");

struct Params {
    const float* in[33];
    float* out;
    char* ws;
    int ph_lo, ph_hi;
};

__device__ __forceinline__ float bf2f(bf16_t v) { return __uint_as_float(((unsigned)v) << 16); }
typedef __bf16 bf16x2_t __attribute__((ext_vector_type(2)));
typedef float f32x2 __attribute__((ext_vector_type(2)));
__device__ __forceinline__ bf16_t f2bf(float f) { return __builtin_bit_cast(bf16_t, (__bf16)f); }
__device__ __forceinline__ unsigned pack2(float a, float b) { const bf16x2_t v = __builtin_convertvector((f32x2){a, b}, bf16x2_t); return __builtin_bit_cast(unsigned, v); }
__device__ __forceinline__ uint2 pk4(f32x4 v) { uint2 o; o.x = pack2(v[0], v[1]); o.y = pack2(v[2], v[3]); return o; }
__device__ __forceinline__ float sigm(float x) { return __builtin_amdgcn_rcpf(1.f + __expf(-x)); }
__device__ __forceinline__ float siluf(float x) { return x * __builtin_amdgcn_rcpf(1.f + __expf(-x)); }
__device__ __forceinline__ float softplusf(float x) { return x > 20.f ? x : log1pf(expf(x)); }
__device__ __forceinline__ float red16(float x);
__device__ __forceinline__ float wave_sum(float v) {
    v = red16(v);
    v += __builtin_bit_cast(float, __builtin_amdgcn_update_dpp(0, __builtin_bit_cast(int, v), 0x142, 0xa, 0xf, false));
    v += __builtin_bit_cast(float, __builtin_amdgcn_update_dpp(0, __builtin_bit_cast(int, v), 0x143, 0xc, 0xf, false));
    return __builtin_bit_cast(float, __builtin_amdgcn_readlane(__builtin_bit_cast(int, v), 63));
}
__device__ __forceinline__ float red16(float x) {
    x += __builtin_bit_cast(float, __builtin_amdgcn_update_dpp(0, __builtin_bit_cast(int, x), 0xB1, 0xf, 0xf, false));
    x += __builtin_bit_cast(float, __builtin_amdgcn_update_dpp(0, __builtin_bit_cast(int, x), 0x4E, 0xf, 0xf, false));
    x += __builtin_bit_cast(float, __builtin_amdgcn_update_dpp(0, __builtin_bit_cast(int, x), 0x124, 0xf, 0xf, false));
    x += __builtin_bit_cast(float, __builtin_amdgcn_update_dpp(0, __builtin_bit_cast(int, x), 0x128, 0xf, 0xf, false));
    return x;
}
__device__ __forceinline__ const float* xin_row(const Params& p, int R) {
    int b = R / TT, s = R - b * TT;
    return s < LC ? p.in[2] + (size_t)(b * LC + s) * DM : p.in[0] + (size_t)(b * SEQ + s - LC) * DM;
}
__device__ __forceinline__ float* xs_row(const Params& p, int R) {
    int b = R / TT, s = R - b * TT;
    return s < LC ? (float*)(p.ws + OFF_XCTX) + (size_t)(b * LC + s) * DM : p.out + (size_t)(b * SEQ + s - LC) * DM;
}
__device__ __forceinline__ int mod_row(int R) {
    int b = R / TT, s = R - b * TT;
    return s < LC ? 8 : b;
}
__device__ __forceinline__ const float* mod_ptr(const Params& p, int layer, int mrow, int j) {
    return (const float*)(p.ws + OFF_MOD) + ((size_t)(layer * 9 + mrow) * 6 + j) * 1024;
}


#define XB_TMO      128
#define XB_XCNT(j)  (256  + 64 * (j))
#define XB_XSUB(j)  (1280 + 64 * (j))
#define XB_XGEN(j)  (2304 + 64 * (j))
#define XB_TOP      3328
#define XB_TOPGEN   3392
#define XCD_BAR_WORDS 3456
#define XB_SPIN_CAP (1u << 22)
#define LAS __attribute__((address_space(3)))
__device__ __forceinline__ unsigned xb_ld(unsigned* p)              { return __hip_atomic_load(p, __ATOMIC_RELAXED, __HIP_MEMORY_SCOPE_AGENT); }
__device__ __forceinline__ unsigned xb_add(unsigned* p, unsigned v) { return __hip_atomic_fetch_add(p, v, __ATOMIC_RELAXED, __HIP_MEMORY_SCOPE_AGENT); }
__device__ __forceinline__ unsigned xb_xcc_id() { return (unsigned)__builtin_amdgcn_s_getreg((3 << 11) | 20) & 0xFu; }
#define XB_SPIN(cond, bar) do { unsigned _sp = 0; while (cond) { __builtin_amdgcn_s_sleep(1); \
    if ((++_sp & 255u) == 0u) { if (xb_ld(&(bar)[XB_TMO])) break; if (_sp > XB_SPIN_CAP) { atomicAdd(&(bar)[XB_TMO], 1u); break; } } } } while (0)
struct XcdBarrier { unsigned* bar; unsigned x; volatile LAS unsigned* st; };
__device__ __forceinline__ XcdBarrier xcd_barrier_post(unsigned* bar, volatile LAS unsigned* st) {
    XcdBarrier b; b.bar = bar; b.x = xb_xcc_id(); b.st = st;
    if (threadIdx.x == 0) (void)xb_add(&bar[XB_XCNT(b.x)], 1u);
    return b;
}
__device__ __forceinline__ void xcd_barrier_complete(unsigned* bar, unsigned x, unsigned& nloc, unsigned& nx) {
    const unsigned G = gridDim.x * gridDim.y * gridDim.z;
    unsigned sum, cnt, mine, sp = 0u;
    for (;;) {
        sum = 0u; cnt = 0u; mine = 0u;
#pragma unroll
        for (unsigned j = 0; j < 16; ++j) { const unsigned c = xb_ld(&bar[XB_XCNT(j)]); sum += c; cnt += (c > 0u) ? 1u : 0u; mine = (j == x) ? c : mine; }
        if (sum == G) break;
        __builtin_amdgcn_s_sleep(1);
        if ((++sp & 255u) == 0u) { if (xb_ld(&bar[XB_TMO])) break; if (sp > XB_SPIN_CAP) { atomicAdd(&bar[XB_TMO], 1u); break; } }
    }
    nloc = mine > 0u ? mine : 1u; nx = cnt > 0u ? cnt : 1u;
}
__device__ __forceinline__ void xcd_barrier(const XcdBarrier& b) {
    asm volatile("s_waitcnt vmcnt(0)" ::: "memory");
    __syncthreads();
    if (threadIdx.x == 0) {
        unsigned* bar = b.bar;
        __builtin_amdgcn_s_waitcnt(0);
        unsigned nloc = b.st[0], nx = b.st[1];
        if (nloc == 0u) { xcd_barrier_complete(bar, b.x, nloc, nx); b.st[0] = nloc; b.st[1] = nx; }
        const unsigned old = xb_add(&bar[XB_XSUB(b.x)], 1u);
        const unsigned gen = old / nloc;
        if (old + 1u == (gen + 1u) * nloc) {
            __builtin_amdgcn_fence(__ATOMIC_RELEASE, "agent");
            asm volatile("s_waitcnt vmcnt(0)" ::: "memory");
            const unsigned og = xb_add(&bar[XB_TOP], 1u);
            const unsigned tg = og / nx;
            if (og + 1u == (tg + 1u) * nx) xb_add(&bar[XB_TOPGEN], 1u);
            else XB_SPIN(xb_ld(&bar[XB_TOPGEN]) == tg, bar);
            __builtin_amdgcn_fence(__ATOMIC_ACQUIRE, "agent");
            xb_add(&bar[XB_XGEN(b.x)], 1u);
            asm volatile("s_waitcnt vmcnt(0)" ::: "memory");
        } else {
            XB_SPIN(xb_ld(&bar[XB_XGEN(b.x)]) == gen, bar);
            __builtin_amdgcn_fence(__ATOMIC_ACQUIRE, "agent");
            asm volatile("s_waitcnt vmcnt(0)" ::: "memory");
        }
    }
    __syncthreads();
}

__device__ __forceinline__ int swz(int row, int chunk) { return row * 128 + ((chunk ^ ((row >> 1) & 7)) << 4); }

namespace g8 {
constexpr int BM = 256, BK = 64, HALF = 128, HTB = HALF * BK * 2, STAGE_BYTES = 8 * HTB, NXCD = 8, WGM = 8;
__device__ __forceinline__ int lds_byte(int r, int c) { const int st = (r >> 4) * 2 + (c >> 5), rr = r & 15, cc = c & 31, ob = rr * 64 + cc * 2; return st * 1024 + (ob ^ (((ob >> 9) & 1) << 5)); }
__device__ __forceinline__ void stage_rc(int b, int& R, int& C) { const int st = b / 1024, sb = b % 1024, swz = sb ^ (((sb >> 9) & 1) << 5); R = (st >> 1) * 16 + swz / 64; C = (st & 1) * 32 + (swz % 64) / 2; }
__device__ __forceinline__ int perm32(int rho) { const int n = rho >> 4, i = rho & 15; return 8 * (i >> 2) + 4 * n + (i & 3); }
struct Unit { const char* a0; const char* a1; const char* b0; const char* b1; int pm, pn, e, half, mh, nh; };
__device__ __forceinline__ bool tail_split(int i, int U, int maxp, int& L, int& sub, int& pieces) {
    const int G = (int)gridDim.x, c = (int)blockIdx.x, R = U / G, T = U - R * G;
    pieces = 1; sub = 0;
    if (i < R) { L = i * G + c; return true; }
    if (i > R || T == 0) return false;
    pieces = (maxp >= 4 && 4 * T <= G) ? 4 : (maxp >= 2 && 2 * T <= G) ? 2 : 1;
    if (c >= pieces * T) return false;
    L = R * G + c / pieces; sub = c % pieces; return true;
}
__device__ __forceinline__ void grid_order_L(int L, int nM, int nN, int& pm, int& pn) {
    const int nwg = nM * nN;
    int wgid = L; { const int q = nwg / NXCD, r = nwg % NXCD, xcd = wgid % NXCD, off = wgid / NXCD; wgid = (xcd < r ? xcd * (q + 1) : r * (q + 1) + (xcd - r) * q) + off; }
    const int nig = WGM * nN, gid = wgid / nig, fm = gid * WGM, gsz = (nM - fm) < WGM ? (nM - fm) : WGM;
    pm = fm + ((wgid % nig) % gsz); pn = (wgid % nig) / gsz;
}
__device__ __forceinline__ bool grid_order(int i, int nM, int nN, int& pm, int& pn) {
    const long L = (long)i * gridDim.x + blockIdx.x; if (L >= nM * nN) return false;
    grid_order_L((int)L, nM, nN, pm, pn); return true;
}

template <bool GATHER, class Epi, class Sched>
__device__ __forceinline__ void gemm_phase(LAS unsigned char* lds, const int K, const Sched& S, const Epi& E) {
    const int tid = threadIdx.x, wid = __builtin_amdgcn_readfirstlane(tid >> 6), lane = tid & 63, wr = wid >> 2, wc = wid & 3, fr = lane & 15, fq = lane >> 4;
    const int nt = K / BK;
    int sR[2], sC[2];
    unsigned voffB[2], voffA0[2], voffA1[2], nvoffA0[2], nvoffA1[2];
#pragma unroll
    for (int i = 0; i < 2; ++i) {
        stage_rc(tid * 16 + i * 8192, sR[i], sC[i]);
        const unsigned va = (unsigned)(sR[i] * K + sC[i]) * 2u;
        const int Rb = Epi::PERM ? ((sR[i] & ~31) + perm32(sR[i] & 31)) : sR[i];
        voffB[i] = (unsigned)(Rb * K + sC[i]) * 2u; voffA0[i] = va; voffA1[i] = va; nvoffA0[i] = va; nvoffA1[i] = va;
    }
    const size_t kstep = (size_t)(BK * 2);
    const unsigned ldsw = (unsigned)wid * 1024u;
    const int aoff = lds_byte(wr * 64 + fr, fq * 8), boff = lds_byte(wc * 32 + fr, fq * 8);
#define G8_SA(b, h) (((b) * 2 + (h)) * HTB)
#define G8_SB(b, h) ((4 + (b) * 2 + (h)) * HTB)
#define G8_STAGE(bufoff, gbase, voff) do { _Pragma("unroll") for (int _i = 0; _i < 2; ++_i) \
        __builtin_amdgcn_global_load_lds((const unsigned*)((const char*)(gbase) + (voff)[_i]), (LAS unsigned*)(lds + (bufoff) + ldsw + _i * 8192), 16, 0, 0); } while (0)
#define G8_LDA(dst, b, h) do { _Pragma("unroll") for (int m = 0; m < 4; ++m) _Pragma("unroll") for (int k = 0; k < 2; ++k) dst[m][k] = *(const LAS bf16x8*)(lds + G8_SA(b, h) + aoff + m * 2048 + k * 1024); } while (0)
#define G8_LDB(dst, b, h) do { _Pragma("unroll") for (int n = 0; n < 2; ++n) _Pragma("unroll") for (int k = 0; k < 2; ++k) dst[n][k] = *(const LAS bf16x8*)(lds + G8_SB(b, h) + boff + n * 2048 + k * 1024); } while (0)
#define G8_MMA(ai, bj, At, Bt) do { __builtin_amdgcn_s_setprio(1); _Pragma("unroll") for (int m = 0; m < 4; ++m) _Pragma("unroll") for (int n = 0; n < 2; ++n) _Pragma("unroll") for (int k = 0; k < 2; ++k) \
        acc[ai][bj][m][n] = __builtin_amdgcn_mfma_f32_16x16x32_bf16(Bt[n][k], At[m][k], acc[ai][bj][m][n], 0, 0, 0); __builtin_amdgcn_s_setprio(0); } while (0)
#define G8_WAIT_V(n) asm volatile("s_waitcnt vmcnt(" #n ")" ::: "memory")
#define G8_WAIT_L(n) asm volatile("s_waitcnt lgkmcnt(" #n ")" ::: "memory")
#define G8_BAR __builtin_amdgcn_s_barrier()
#define G8_SCHED __builtin_amdgcn_sched_barrier(0)
    Unit cur, nxt; int ui = 0;
    if (!S.next(0, cur)) return;
    if (GATHER) {
#pragma unroll
        for (int i = 0; i < 2; ++i) { voffA0[i] = S.aoff(cur, 0, sR[i], sC[i]); voffA1[i] = (cur.half & 2) ? 0u : S.aoff(cur, 1, sR[i], sC[i]); }
    } else {
#pragma unroll
        for (int i = 0; i < 2; ++i) voffA1[i] = (cur.half & 2) ? 0u : voffA0[i];
    }
    unsigned cB1[2], nB1[2];
#pragma unroll
    for (int i = 0; i < 2; ++i) { cB1[i] = (cur.half & 1) ? 0u : voffB[i]; nB1[i] = cB1[i]; }
    int raw0[2] = {0, 0}, raw1[2] = {0, 0};
    if (GATHER) {
        Unit u1;
        if (S.next(1, u1)) {
#pragma unroll
            for (int i = 0; i < 2; ++i) { raw0[i] = S.araw(u1, 0, sR[i]); raw1[i] = (u1.half & 2) ? 0 : S.araw(u1, 1, sR[i]); }
        }
    }
    f32x4 acc[2][2][4][2];
#pragma unroll
    for (int a = 0; a < 2; ++a)
#pragma unroll
        for (int b = 0; b < 2; ++b)
#pragma unroll
            for (int m = 0; m < 4; ++m)
#pragma unroll
                for (int n = 0; n < 2; ++n) acc[a][b][m][n] = (f32x4){0.f, 0.f, 0.f, 0.f};
    bf16x8 At[4][2], B0[2][2], B1[2][2];
    G8_STAGE(G8_SB(0, 0), cur.b0, voffB); G8_STAGE(G8_SA(0, 0), cur.a0, voffA0); G8_STAGE(G8_SB(0, 1), cur.b1, cB1); G8_STAGE(G8_SA(0, 1), cur.a1, voffA1);
    if (wr == 1) G8_BAR;
    G8_WAIT_V(4); G8_BAR;
    G8_STAGE(G8_SB(1, 0), cur.b0 + kstep, voffB); G8_STAGE(G8_SA(1, 0), cur.a0 + kstep, voffA0); G8_STAGE(G8_SB(1, 1), cur.b1 + kstep, cB1);
    G8_WAIT_V(6); G8_BAR;
    for (;;) {
        const bool has_next = S.next(ui + 1, nxt);
        if (!has_next) nxt = cur;
        if (GATHER) {
#pragma unroll
            for (int i = 0; i < 2; ++i) { nvoffA0[i] = has_next ? S.afrom(raw0[i], sC[i]) : voffA0[i]; nvoffA1[i] = has_next ? ((nxt.half & 2) ? 0u : S.afrom(raw1[i], sC[i])) : voffA1[i]; }
            Unit u2;
            if (S.next(ui + 2, u2)) {
#pragma unroll
                for (int i = 0; i < 2; ++i) { raw0[i] = S.araw(u2, 0, sR[i]); raw1[i] = (u2.half & 2) ? 0 : S.araw(u2, 1, sR[i]); }
            }
        } else {
#pragma unroll
            for (int i = 0; i < 2; ++i) nvoffA1[i] = (nxt.half & 2) ? 0u : voffA0[i];
        }
#pragma unroll
        for (int i = 0; i < 2; ++i) nB1[i] = (nxt.half & 1) ? 0u : voffB[i];
        const bool liveB = !(cur.half & 1), liveA = !(cur.half & 2), liveAB = cur.half == 0;
        for (int t = 0; t < nt; t += 2) {
            const bool last = (t == nt - 2);
            const char* a1h1 = cur.a1 + (size_t)(t + 1) * kstep;
            const char* a2h0 = last ? nxt.a0 : cur.a0 + (size_t)(t + 2) * kstep; const char* a2h1 = last ? nxt.a1 : cur.a1 + (size_t)(t + 2) * kstep;
            const char* b2h0 = last ? nxt.b0 : cur.b0 + (size_t)(t + 2) * kstep; const char* b2h1 = last ? nxt.b1 : cur.b1 + (size_t)(t + 2) * kstep;
            const char* a3h0 = a2h0 + kstep; const char* b3h0 = b2h0 + kstep; const char* b3h1 = b2h1 + kstep;
            unsigned v2a0[2], v2a1[2], v2b1[2];
#pragma unroll
            for (int i = 0; i < 2; ++i) { v2a0[i] = (GATHER && last) ? nvoffA0[i] : voffA0[i]; v2a1[i] = last ? nvoffA1[i] : voffA1[i]; v2b1[i] = last ? nB1[i] : cB1[i]; }
            G8_LDB(B0, 0, 0); G8_SCHED; G8_LDA(At, 0, 0); G8_STAGE(G8_SA(1, 1), a1h1, voffA1);
            G8_WAIT_L(8); G8_BAR; G8_WAIT_L(0); G8_MMA(0, 0, At, B0); G8_BAR; G8_SCHED;
            G8_LDB(B1, 0, 1); G8_STAGE(G8_SB(0, 0), b2h0, voffB);
            G8_BAR; G8_WAIT_L(0); if (liveB) G8_MMA(0, 1, At, B1); G8_BAR;
            G8_LDA(At, 0, 1); G8_STAGE(G8_SA(0, 0), a2h0, v2a0);
            G8_BAR; G8_WAIT_L(0); if (liveA) G8_MMA(1, 0, At, B0); G8_BAR; G8_SCHED;
            G8_STAGE(G8_SB(0, 1), b2h1, v2b1);
            G8_WAIT_V(6); G8_BAR; if (liveAB) G8_MMA(1, 1, At, B1); G8_BAR;
            G8_LDB(B0, 1, 0); G8_SCHED; G8_LDA(At, 1, 0); G8_STAGE(G8_SA(0, 1), a2h1, v2a1);
            G8_WAIT_L(8); G8_BAR; G8_WAIT_L(0); G8_MMA(0, 0, At, B0); G8_BAR; G8_SCHED;
            G8_LDB(B1, 1, 1); G8_STAGE(G8_SB(1, 0), b3h0, voffB);
            G8_BAR; G8_WAIT_L(0); if (liveB) G8_MMA(0, 1, At, B1); G8_BAR;
            G8_LDA(At, 1, 1); G8_STAGE(G8_SA(1, 0), a3h0, v2a0);
            G8_BAR; G8_WAIT_L(0); if (liveA) G8_MMA(1, 0, At, B0); G8_BAR; G8_SCHED;
            G8_STAGE(G8_SB(1, 1), b3h1, v2b1);
            G8_WAIT_V(6); G8_BAR; if (liveAB) G8_MMA(1, 1, At, B1); G8_BAR;
        }
        E(acc, cur, wr, wc, fr, fq);
        if (!has_next) break;
#pragma unroll
        for (int a = 0; a < 2; ++a)
#pragma unroll
            for (int b = 0; b < 2; ++b)
#pragma unroll
                for (int m = 0; m < 4; ++m)
#pragma unroll
                    for (int n = 0; n < 2; ++n) acc[a][b][m][n] = (f32x4){0.f, 0.f, 0.f, 0.f};
        cur = nxt; ++ui;
#pragma unroll
        for (int i = 0; i < 2; ++i) { if (GATHER) voffA0[i] = nvoffA0[i]; voffA1[i] = nvoffA1[i]; cB1[i] = nB1[i]; }
    }
    G8_WAIT_V(0);
    if (wr == 0) G8_BAR;
    G8_BAR;
#undef G8_SA
#undef G8_SB
#undef G8_STAGE
#undef G8_LDA
#undef G8_LDB
#undef G8_MMA
#undef G8_WAIT_V
#undef G8_WAIT_L
#undef G8_BAR
#undef G8_SCHED
}
}

__device__ __forceinline__ void transpose_tile(const float* __restrict__ src, bf16_t* __restrict__ dst, int K, int N, int kt, int nt, float* tile) {
    const int t = threadIdx.x;
    {
        const int k = t >> 3, n4 = (t & 7) * 4;
        const int n = nt * 64 + n4;
        f32x4 v0 = (f32x4){0.f, 0.f, 0.f, 0.f}, v1 = v0;
        const float* sp = src + (size_t)(kt * 64 + k) * N + n;
        if (n < N) v0 = *(const f32x4*)sp;
        if (n + 32 < N) v1 = *(const f32x4*)(sp + 32);
        float* tp = tile + k * 65 + n4;
        tp[0] = v0[0]; tp[1] = v0[1]; tp[2] = v0[2]; tp[3] = v0[3];
        tp[32] = v1[0]; tp[33] = v1[1]; tp[34] = v1[2]; tp[35] = v1[3];
    }
    __syncthreads();
    {
        const int n = t >> 3, k8 = (t & 7) * 8;
        if (nt * 64 + n < N) {
            uint4 o;
            o.x = pack2(tile[(k8 + 0) * 65 + n], tile[(k8 + 1) * 65 + n]);
            o.y = pack2(tile[(k8 + 2) * 65 + n], tile[(k8 + 3) * 65 + n]);
            o.z = pack2(tile[(k8 + 4) * 65 + n], tile[(k8 + 5) * 65 + n]);
            o.w = pack2(tile[(k8 + 6) * 65 + n], tile[(k8 + 7) * 65 + n]);
            *(uint4*)(dst + (size_t)(nt * 64 + n) * K + kt * 64 + k8) = o;
        }
    }
    __syncthreads();
}

__device__ __forceinline__ void adaln_unit(const Params& p, int u, float* lds) {
    float* sc = lds;
    float* red = lds + 9216;
    const int t = threadIdx.x;
    for (int i = t; i < 9216; i += NTHR) {
        const int r = i >> 10, k = i & 1023;
        const float v = (r < 8) ? p.in[1][r * 1024 + k] : p.in[3][k];
        sc[i] = siluf(v);
    }
    __syncthreads();
    const int w = t >> 6, lane = t & 63;
    const int l = u / 96, nc = u % 96;
    const float* W = p.in[4] + (size_t)l * 1024 * 6144 + nc * 64 + lane;
    float acc[9];
#pragma unroll
    for (int r = 0; r < 9; ++r) acc[r] = 0.f;
#pragma unroll 8
    for (int k = w * 128; k < w * 128 + 128; ++k) {
        const float wv = W[(size_t)k * 6144];
#pragma unroll
        for (int r = 0; r < 9; ++r) acc[r] += sc[r * 1024 + k] * wv;
    }
#pragma unroll
    for (int r = 0; r < 9; ++r) red[(w * 9 + r) * 64 + lane] = acc[r];
    __syncthreads();
    float* mod = (float*)(p.ws + OFF_MOD);
    for (int i = t; i < 576; i += NTHR) {
        const int r = i >> 6, ln = i & 63;
        float s = 0.f;
#pragma unroll
        for (int w2 = 0; w2 < 8; ++w2) s += red[(w2 * 9 + r) * 64 + ln];
        const int n = nc * 64 + ln;
        mod[(size_t)(l * 9 + r) * 6144 + n] = s + p.in[5][l * 6144 + n];
    }
    __syncthreads();
}

__device__ __forceinline__ void phase0(const Params& p, char* lds) {
    constexpr int T_WIN0 = 16 * 63, T_WOUT = 16 * 16, T_WIN1 = 16 * 24;
    constexpr int U0 = 193, U1 = U0 + T_WIN0, U2 = U1 + T_WOUT, U3 = U2 + T_WIN1, U4 = U3 + T_WOUT;
    for (int u = blockIdx.x; u < U4 + 49; u += gridDim.x) {
        if (u < 192) {
            adaln_unit(p, u, (float*)lds);
        } else if (u == 192) {
            float* rope = (float*)(p.ws + OFF_ROPE);
            for (int idx = threadIdx.x; idx < 1024; idx += NTHR) {
                const int pos = idx >> 4, i = idx & 15;
                const double inv = pow(10000.0, -(double)i / 16.0);
                const double ang = (double)pos * inv;
                rope[idx] = (float)cos(ang);
                rope[1024 + idx] = (float)sin(ang);
            }
        } else if (u < U1) {
            const int v = u - U0;
            transpose_tile(p.in[8], (bf16_t*)(p.ws + OFF_WIN0), 1024, EIN, v / 63, v % 63, (float*)lds);
        } else if (u < U2) {
            const int v = u - U1;
            transpose_tile(p.in[9], (bf16_t*)(p.ws + OFF_WOUT0), 1024, 1024, v / 16, v % 16, (float*)lds);
        } else if (u < U3) {
            const int v = u - U2;
            transpose_tile(p.in[25], (bf16_t*)(p.ws + OFF_WIN1), 1024, 1536, v / 24, v % 24, (float*)lds);
        } else if (u < U4) {
            const int v = u - U3;
            transpose_tile(p.in[26], (bf16_t*)(p.ws + OFF_WOUT1), 1024, 1024, v / 16, v % 16, (float*)lds);
        } else if (u == U4 + 48) {
            uint4* z = (uint4*)(p.ws + OFF_WIN0 + (size_t)EIN * 1024 * 2);
            for (int i = threadIdx.x; i < (4096 - EIN) * 1024 * 2 / 16; i += NTHR) z[i] = make_uint4(0u, 0u, 0u, 0u);
        } else {
            const int v = u - U4;
            bf16_t* LW = (bf16_t*)(p.ws + OFF_LORA);
            if (v < 16) transpose_tile(p.in[12] + (v >> 3) * 64 * 512, LW + (v >> 3) * 32768, 64, 512, 0, v & 7, (float*)lds);
            else if (v < 32) transpose_tile(p.in[14] + ((v - 16) >> 3) * 64 * 512, LW + 65536 + ((v - 16) >> 3) * 32768, 64, 512, 0, v & 7, (float*)lds);
            else transpose_tile(p.in[15], LW + 131072, 128, 512, (v - 32) >> 3, v & 7, (float*)lds);
        }
    }
}

__device__ __forceinline__ void convert_moe(const Params& p, int layer, char* lds, int first, int count) {
    const int me = (int)blockIdx.x - first;
    if (me < 0 || me >= count) return;
    bf16_t* dstb = (bf16_t*)(p.ws + M_W);
    float* tile = (float*)lds;
    const int t = threadIdx.x;
    const int k = t >> 3, n4 = (t & 7) * 4;
    constexpr int NT = 48 * 256;
    const int stride = count * 4;
    f32x4 a0[4], a1[4], b0[4], b1[4];
    auto fetch = [&](int u0, f32x4 (&v0)[4], f32x4 (&v1)[4]) {
#pragma unroll
        for (int q = 0; q < 4; ++q) {
            const int u = u0 + q, mat = u >> 8, tl = u & 255;
            const float* src = p.in[29 + (mat >> 4)] + (size_t)(layer * 16 + (mat & 15)) * 1024 * 1024;
            const float* sp = src + (size_t)((tl >> 4) * 64 + k) * 1024 + (tl & 15) * 64 + n4;
            v0[q] = *(const f32x4*)sp; v1[q] = *(const f32x4*)(sp + 32);
        }
    };
    auto to_lds = [&](const f32x4 (&v0)[4], const f32x4 (&v1)[4]) {
#pragma unroll
        for (int q = 0; q < 4; ++q) {
            float* tp = tile + q * 4160 + k * 65 + n4;
            tp[0] = v0[q][0]; tp[1] = v0[q][1]; tp[2] = v0[q][2]; tp[3] = v0[q][3];
            tp[32] = v1[q][0]; tp[33] = v1[q][1]; tp[34] = v1[q][2]; tp[35] = v1[q][3];
        }
    };
    auto store = [&](int u0) {
        const int n = t >> 3, k8 = (t & 7) * 8;
#pragma unroll
        for (int q = 0; q < 4; ++q) {
            const int u = u0 + q, mat = u >> 8, tl = u & 255;
            const float* tq = tile + q * 4160;
            uint4 o;
            o.x = pack2(tq[(k8 + 0) * 65 + n], tq[(k8 + 1) * 65 + n]);
            o.y = pack2(tq[(k8 + 2) * 65 + n], tq[(k8 + 3) * 65 + n]);
            o.z = pack2(tq[(k8 + 4) * 65 + n], tq[(k8 + 5) * 65 + n]);
            o.w = pack2(tq[(k8 + 6) * 65 + n], tq[(k8 + 7) * 65 + n]);
            *(uint4*)(dstb + (size_t)mat * 1024 * 1024 + (size_t)((tl & 15) * 64 + n) * 1024 + (tl >> 4) * 64 + k8) = o;
        }
    };
    int u0 = me * 4;
    if (u0 < NT) fetch(u0, a0, a1);
    if (u0 + stride < NT) fetch(u0 + stride, b0, b1);
    for (; u0 < NT; u0 += 2 * stride) {
        to_lds(a0, a1);
        if (u0 + 2 * stride < NT) fetch(u0 + 2 * stride, a0, a1);
        __syncthreads();
        store(u0);
        __syncthreads();
        if (u0 + stride >= NT) break;
        to_lds(b0, b1);
        if (u0 + 3 * stride < NT) fetch(u0 + 3 * stride, b0, b1);
        __syncthreads();
        store(u0 + stride);
        __syncthreads();
    }
}

__device__ __forceinline__ void load_row(const float* src, int lane, f32x4 (&x)[4]) {
#pragma unroll
    for (int i = 0; i < 4; ++i) x[i] = *(const f32x4*)(src + 4 * lane + 256 * i);
}
__device__ __forceinline__ float row_rs(const f32x4 (&x)[4]) {
    float ss = 0.f;
#pragma unroll
    for (int i = 0; i < 4; ++i) ss += x[i][0] * x[i][0] + x[i][1] * x[i][1] + x[i][2] * x[i][2] + x[i][3] * x[i][3];
    ss = wave_sum(ss);
    return rsqrtf(ss * (1.f / 1024.f) + 1e-6f);
}
__device__ __forceinline__ void norm_mod(const f32x4 (&x)[4], const float* gain, const float* shift, const float* scale, int lane, f32x4 (&h)[4]) {
    const float rs = row_rs(x);
#pragma unroll
    for (int i = 0; i < 4; ++i) {
        const int c = 4 * lane + 256 * i;
        const f32x4 g = *(const f32x4*)(gain + c), sh = *(const f32x4*)(shift + c), sc = *(const f32x4*)(scale + c);
        h[i] = x[i] * rs * g * (1.f + sc) + sh;
    }
}
__device__ __forceinline__ void store_h(bf16_t* dst, int lane, const f32x4 (&h)[4]) {
#pragma unroll
    for (int i = 0; i < 4; ++i) {
        uint2 o;
        o.x = pack2(h[i][0], h[i][1]);
        o.y = pack2(h[i][2], h[i][3]);
        *(uint2*)(dst + 4 * lane + 256 * i) = o;
    }
}
__device__ __forceinline__ void router_row(const f32x4 (&h)[4], const float* rt, int lane, float* aff) {
    float mylog = 0.f;
#pragma unroll 2
    for (int e = 0; e < 16; ++e) {
        f32x4 a = (f32x4){0.f, 0.f, 0.f, 0.f};
#pragma unroll
        for (int i = 0; i < 4; ++i) a += h[i] * *(const f32x4*)(rt + e * 1024 + 4 * lane + 256 * i);
        const float v = wave_sum((a[0] + a[1]) + (a[2] + a[3]));
        mylog = ((lane & 15) == e) ? v : mylog;
    }
    float mx = mylog;
    mx = fmaxf(mx, __shfl_xor(mx, 1)); mx = fmaxf(mx, __shfl_xor(mx, 2)); mx = fmaxf(mx, __shfl_xor(mx, 4)); mx = fmaxf(mx, __shfl_xor(mx, 8));
    const float ex = expf(mylog - mx);
    float sum = ex;
    sum += __shfl_xor(sum, 1); sum += __shfl_xor(sum, 2); sum += __shfl_xor(sum, 4); sum += __shfl_xor(sum, 8);
    if (lane < 16) aff[lane] = ex / sum;
}

__device__ __forceinline__ void phase1(const Params& p) {
    const int lane = threadIdx.x & 63, wg = blockIdx.x * 8 + (threadIdx.x >> 6), nw = gridDim.x * 8;
    bf16_t* H = (bf16_t*)(p.ws + OFF_H);
    f32x4 xn[4];
    if (wg < NTOK) load_row(xin_row(p, wg), lane, xn);
    for (int R = wg; R < NTOK; R += nw) {
        f32x4 x[4], h[4];
#pragma unroll
        for (int i = 0; i < 4; ++i) x[i] = xn[i];
        if (R + nw < NTOK) load_row(xin_row(p, R + nw), lane, xn);
        const int mr = mod_row(R);
        norm_mod(x, p.in[6], mod_ptr(p, 0, mr, 0), mod_ptr(p, 0, mr, 1), lane, h);
        store_h(H + (size_t)R * DM, lane, h);
    }
}

__device__ __forceinline__ f32x4 ld_bf4(const bf16_t* q) {
    const uint2 v = *(const uint2*)q;
    return (f32x4){bf2f((bf16_t)(v.x & 0xffff)), bf2f((bf16_t)(v.x >> 16)), bf2f((bf16_t)(v.y & 0xffff)), bf2f((bf16_t)(v.y >> 16))};
}
__device__ __forceinline__ void st_bf4(bf16_t* q, f32x4 v) {
    uint2 o; o.x = pack2(v[0], v[1]); o.y = pack2(v[2], v[3]);
    *(uint2*)q = o;
}
struct Sched2 {
    const char* H; const char* W;
    __device__ __forceinline__ bool next(int i, g8::Unit& u) const {
        int L, sub, pieces; if (!g8::tail_split(i, 72 * 16, 2, L, sub, pieces)) return false;
        int pm, pn; g8::grid_order_L(L, 72, 16, pm, pn);
        u.pm = pm; u.pn = pn; u.e = 0; u.mh = 0; u.nh = sub; u.half = pieces == 2 ? 1 : 0;
        u.a0 = H + (size_t)pm * 256 * DM * 2; u.a1 = u.a0 + (size_t)128 * DM * 2;
        u.b0 = W + (size_t)(pn * 256 + sub * 128) * DM * 2; u.b1 = u.half ? u.b0 : u.b0 + (size_t)128 * DM * 2;
        return true;
    }
    __device__ __forceinline__ unsigned aoff(const g8::Unit&, int, int, int) const { return 0u; }
    __device__ __forceinline__ int araw(const g8::Unit&, int, int) const { return 0; }
    __device__ __forceinline__ unsigned afrom(int, int) const { return 0u; }
};
struct Epi2 {
    static constexpr bool PERM = true;
    bf16_t* P;
    __device__ __forceinline__ void operator()(const f32x4 (&acc)[2][2][4][2], const g8::Unit& u, int wr, int wc, int fr, int fq) const {
#pragma unroll
        for (int ai = 0; ai < 2; ++ai)
#pragma unroll
            for (int m = 0; m < 4; ++m) {
                const int row = u.pm * 256 + ai * 128 + wr * 64 + m * 16 + fr;
#pragma unroll
                for (int bj = 0; bj < 2; ++bj) {
                    const int col = u.pn * 256 + (bj + u.nh) * 128 + wc * 32 + 8 * fq;
                    if (col < EIN && !(bj == 1 && (u.half & 1))) {
                        const uint2 t0 = pk4(acc[ai][bj][m][0]), t1 = pk4(acc[ai][bj][m][1]);
                        *(uint4*)(P + (size_t)row * EIN + col) = make_uint4(t0.x, t0.y, t1.x, t1.y);
                    }
                }
            }
    }
};
__device__ __forceinline__ void phase2(const Params& p, char* lds) {
    Sched2 S{p.ws + OFF_H, p.ws + OFF_WIN0};
    Epi2 E{(bf16_t*)(p.ws + B_P)};
    g8::gemm_phase<false>((LAS unsigned char*)lds, DM, S, E);
}

__device__ __forceinline__ f32x4 sigm4(f32x4 x) { return (f32x4){sigm(x[0]), sigm(x[1]), sigm(x[2]), sigm(x[3])}; }
__device__ __forceinline__ f32x4 shifted4(const bf16_t* P, int R, int s, int lo, int hi, int c, const float* mu) {
    const f32x4 pc = ld_bf4(P + (size_t)R * EIN + c);
    f32x4 pm = (f32x4){0.f, 0.f, 0.f, 0.f}, pp = pm;
    if (s - 1 >= lo) pm = ld_bf4(P + (size_t)(R - 1) * EIN + c);
    if (s + 1 < hi) pp = ld_bf4(P + (size_t)(R + 1) * EIN + c);
    return pc + *(const f32x4*)(mu + c) * (0.5f * (pm + pp) - pc);
}
__device__ __forceinline__ void unpack8(const uint4 v, float (&f)[8]) {
    f[0] = bf2f((bf16_t)(v.x & 0xffff)); f[1] = bf2f((bf16_t)(v.x >> 16)); f[2] = bf2f((bf16_t)(v.y & 0xffff)); f[3] = bf2f((bf16_t)(v.y >> 16));
    f[4] = bf2f((bf16_t)(v.z & 0xffff)); f[5] = bf2f((bf16_t)(v.z >> 16)); f[6] = bf2f((bf16_t)(v.w & 0xffff)); f[7] = bf2f((bf16_t)(v.w >> 16));
}

__device__ __forceinline__ void phase3a(const Params& p, char* lds) {
    const bf16_t* P = (const bf16_t*)(p.ws + B_P);
    bf16_t* EW = (bf16_t*)(p.ws + B_EW); bf16_t* KD = (bf16_t*)(p.ws + B_KD); bf16_t* BD = (bf16_t*)(p.ws + B_BD);
    bf16_t* RR = (bf16_t*)(p.ws + B_RR); bf16_t* KK = (bf16_t*)(p.ws + B_KK); bf16_t* VV = (bf16_t*)(p.ws + B_VV); bf16_t* GG = (bf16_t*)(p.ws + B_GG);
    bf16_t* GQ = (bf16_t*)(p.ws + B_GQ); bf16_t* GK = (bf16_t*)(p.ws + B_GK); bf16_t* GV = (bf16_t*)(p.ws + B_GV);
    float* BC = (float*)(p.ws + B_BC); float* GDG = (float*)(p.ws + B_GDG); float* GDB = (float*)(p.ws + B_GDB);
    bf16_t* LIN = (bf16_t*)(p.ws + OFF_H);
    constexpr int PT = 16, LROW = 784;
    const int t = threadIdx.x, lane = t & 63, w = t >> 6, fr = lane & 15, fq = lane >> 4;
    const float* mu = p.in[10];
    for (int u = blockIdx.x; u < NB * (TT / PT); u += gridDim.x) {
        const int b = u / (TT / PT), s0 = (u % (TT / PT)) * PT;
        const int lo = (s0 < LC) ? 0 : LC, hi = (s0 < LC) ? LC : TT;
        const int R0 = b * TT + s0;
        for (int gi = t; gi < PT * 48; gi += NTHR) {
            const int tok = gi / 48, c8 = (gi % 48) * 8;
            const int col = 1536 + c8, R = R0 + tok, s = s0 + tok;
            float pc[8], pm[8], pp[8];
            unpack8(*(const uint4*)(P + (size_t)R * EIN + col), pc);
#pragma unroll
            for (int j = 0; j < 8; ++j) { pm[j] = 0.f; pp[j] = 0.f; }
            if (s - 1 >= lo) unpack8(*(const uint4*)(P + (size_t)(R - 1) * EIN + col), pm);
            if (s + 1 < hi) unpack8(*(const uint4*)(P + (size_t)(R + 1) * EIN + col), pp);
            float v[8];
#pragma unroll
            for (int j = 0; j < 8; ++j) {
                float x = pc[j] + mu[col + j] * (0.5f * (pm[j] + pp[j]) - pc[j]);
                if (c8 < 128) x = tanhf(x);
                else if (c8 >= 256) x = sigm(x);
                v[j] = x;
            }
            uint4 o; o.x = pack2(v[0], v[1]); o.y = pack2(v[2], v[3]); o.z = pack2(v[4], v[5]); o.w = pack2(v[6], v[7]);
            *(uint4*)(LIN + (size_t)R * 384 + c8) = o;
        }
        if (t < 384) {
            const int cg = t % 192, seg = t / 192;
            const int ch = cg * 8;
            const float* cw = p.in[21];
            float wj[5][8];
#pragma unroll
            for (int j = 0; j < 5; ++j) {
                const f32x4 w0 = *(const f32x4*)(cw + j * 1536 + ch), w1 = *(const f32x4*)(cw + j * 1536 + ch + 4);
                wj[j][0] = w0[0]; wj[j][1] = w0[1]; wj[j][2] = w0[2]; wj[j][3] = w0[3]; wj[j][4] = w1[0]; wj[j][5] = w1[1]; wj[j][6] = w1[2]; wj[j][7] = w1[3];
            }
            const int typ = cg >> 6;
            const int sb = s0 + seg * 8 - 2;
            const bf16_t* Pc = P + (size_t)(b * TT) * EIN + 1920 + ch;
            uint4 r0 = make_uint4(0u, 0u, 0u, 0u), r1 = r0, r2 = r0, r3 = r0, r4 = r0;
            if (sb + 0 >= lo && sb + 0 < hi) r0 = *(const uint4*)(Pc + (size_t)(sb + 0) * EIN);
            if (sb + 1 >= lo && sb + 1 < hi) r1 = *(const uint4*)(Pc + (size_t)(sb + 1) * EIN);
            if (sb + 2 >= lo && sb + 2 < hi) r2 = *(const uint4*)(Pc + (size_t)(sb + 2) * EIN);
            if (sb + 3 >= lo && sb + 3 < hi) r3 = *(const uint4*)(Pc + (size_t)(sb + 3) * EIN);
            if (sb + 4 >= lo && sb + 4 < hi) r4 = *(const uint4*)(Pc + (size_t)(sb + 4) * EIN);
#pragma unroll 1
            for (int k = 0; k < 8; ++k) {
                const int sn = sb + k + 5;
                uint4 nxt = make_uint4(0u, 0u, 0u, 0u);
                if (sn >= lo && sn < hi) nxt = *(const uint4*)(Pc + (size_t)sn * EIN);
                float a[8], x[8];
                unpack8(r0, x);
#pragma unroll
                for (int i = 0; i < 8; ++i) a[i] = x[i] * wj[0][i];
                unpack8(r1, x);
#pragma unroll
                for (int i = 0; i < 8; ++i) a[i] += x[i] * wj[1][i];
                unpack8(r2, x);
#pragma unroll
                for (int i = 0; i < 8; ++i) a[i] += x[i] * wj[2][i];
                unpack8(r3, x);
#pragma unroll
                for (int i = 0; i < 8; ++i) a[i] += x[i] * wj[3][i];
                unpack8(r4, x);
#pragma unroll
                for (int i = 0; i < 8; ++i) a[i] += x[i] * wj[4][i];
                float ssq = 0.f;
#pragma unroll
                for (int i = 0; i < 8; ++i) { a[i] = siluf(a[i]); ssq += a[i] * a[i]; }
                ssq = red16(ssq);
                float sc = 1.f;
                if (typ == 0) sc = rsqrtf(ssq + 1e-6f) * 0.08838834764831845f;
                else if (typ == 1) sc = rsqrtf(ssq + 1e-6f);
                uint4 o; o.x = pack2(a[0] * sc, a[1] * sc); o.y = pack2(a[2] * sc, a[3] * sc); o.z = pack2(a[4] * sc, a[5] * sc); o.w = pack2(a[6] * sc, a[7] * sc);
                bf16_t* dst = (typ == 0 ? GQ : (typ == 1 ? GK : GV)) + (size_t)(R0 + seg * 8 + k) * 512 + (ch & 511);
                *(uint4*)dst = o;
                r0 = r1; r1 = r2; r2 = r3; r3 = r4; r4 = nxt;
            }
        } else {
            const int tt = t - 384;
            {
                bf16_t* ZZ = (bf16_t*)(p.ws + B_ZZ);
#pragma unroll
                for (int q = 0; q < 8; ++q) {
                    const int pc = tt * 8 + q, k = pc >> 6, c8 = (pc & 63) * 8;
                    *(uint4*)(ZZ + (size_t)(R0 + k) * 512 + c8) = *(const uint4*)(P + (size_t)(R0 + k) * EIN + 3472 + c8);
                }
            }
#pragma unroll
            for (int q = 0; q < 2; ++q) {
                const int idx = tt * 2 + q, k = idx >> 4, j = idx & 15;
                const int R = R0 + k;
                if (j < 8) {
                    const float al = bf2f(P[(size_t)R * EIN + 3456 + j]);
                    GDG[(size_t)R * 8 + j] = -expf(p.in[22][j]) * softplusf(al + p.in[23][j]);
                } else {
                    const float be = bf2f(P[(size_t)R * EIN + 3464 + (j - 8)]);
                    GDB[(size_t)R * 8 + (j - 8)] = sigm(be);
                }
            }
        }
    }
}


__device__ __forceinline__ void phase3b(const Params& p, char* lds) {
    const bf16_t* P = (const bf16_t*)(p.ws + B_P);
    bf16_t* EW = (bf16_t*)(p.ws + B_EW); bf16_t* KD = (bf16_t*)(p.ws + B_KD); bf16_t* BD = (bf16_t*)(p.ws + B_BD);
    bf16_t* RR = (bf16_t*)(p.ws + B_RR); bf16_t* KK = (bf16_t*)(p.ws + B_KK); bf16_t* VV = (bf16_t*)(p.ws + B_VV); bf16_t* GG = (bf16_t*)(p.ws + B_GG);
    float* BC = (float*)(p.ws + B_BC);
    const bf16_t* LW = (const bf16_t*)(p.ws + OFF_LORA);
    const bf16_t* LIN = (const bf16_t*)(p.ws + OFF_H);
    const int t = threadIdx.x, lane = t & 63, w = t >> 6, fr = lane & 15, fq = lane >> 4;
    const float* mu = p.in[10];
    const int hd = blockIdx.x & 7, grp = blockIdx.x >> 3, ngrp = gridDim.x >> 3;
    for (int i = t; i < 4 * 64 * 8; i += NTHR) {
        const int mtx = i >> 9, row = (i >> 3) & 63, c16 = i & 7;
        *(uint4*)(lds + mtx * 64 * 144 + row * 144 + c16 * 16) = *(const uint4*)(LW + (size_t)mtx * 32768 + (size_t)(64 * hd + row) * 64 + c16 * 8);
    }
    for (int i = t; i < 64 * 16; i += NTHR) {
        const int row = i >> 4, c16 = i & 15;
        *(uint4*)(lds + 4 * 64 * 144 + row * 272 + c16 * 16) = *(const uint4*)(LW + 131072 + (size_t)(64 * hd + row) * 128 + c16 * 8);
    }
    __syncthreads();
    if (grp < ngrp) {
        for (int tile = grp * 8 + w; tile < NB * (TT / 16); tile += ngrp * 8) {
            const int b = tile / (TT / 16), s0 = (tile % (TT / 16)) * 16;
            const int lo = (s0 < LC) ? 0 : LC, hi = (s0 < LC) ? LC : TT;
            const int R0 = b * TT + s0;
        {
            const int cb = 64 * hd;
            const int R = R0 + fr, s = s0 + fr;
            const int c0 = cb + 16 * fq;
            const char* Wl = lds + (16 * (fr >> 2) + (fr & 3)) * 144 + fq * 16;
            const char* Wg = lds + 4 * 64 * 144 + (16 * (fr >> 2) + (fr & 3)) * 272 + fq * 16;
            const bf16_t* Lrow = LIN + (size_t)R * 384 + 8 * fq;
            f32x4 rq[4], kq[4], kkn[4];
            float ss = 0.f;
            {
                auto shift16 = [&](int which, f32x4 (&o)[4]) {
                    const bf16_t* pc = P + (size_t)R * EIN + which * 512 + c0;
#pragma unroll
                    for (int hh = 0; hh < 2; ++hh) {
                        float xc[8], xm[8], xp[8];
                        unpack8(*(const uint4*)(pc + 8 * hh), xc);
#pragma unroll
                        for (int j = 0; j < 8; ++j) { xm[j] = 0.f; xp[j] = 0.f; }
                        if (s - 1 >= lo) unpack8(*(const uint4*)(pc - EIN + 8 * hh), xm);
                        if (s + 1 < hi) unpack8(*(const uint4*)(pc + EIN + 8 * hh), xp);
                        const f32x4 m0 = *(const f32x4*)(mu + which * 512 + c0 + 8 * hh), m1 = *(const f32x4*)(mu + which * 512 + c0 + 8 * hh + 4);
#pragma unroll
                        for (int j = 0; j < 4; ++j) {
                            o[2 * hh][j] = xc[j] + m0[j] * (0.5f * (xm[j] + xp[j]) - xc[j]);
                            o[2 * hh + 1][j] = xc[4 + j] + m1[j] * (0.5f * (xm[4 + j] + xp[4 + j]) - xc[4 + j]);
                        }
                    }
                };
                auto store16 = [&](bf16_t* dst, const f32x4 (&o)[4]) {
                    const uint2 t0 = pk4(o[0]), t1 = pk4(o[1]), t2 = pk4(o[2]), t3 = pk4(o[3]);
                    *(uint4*)dst = make_uint4(t0.x, t0.y, t1.x, t1.y); *(uint4*)(dst + 8) = make_uint4(t2.x, t2.y, t3.x, t3.y);
                };
                { f32x4 vq[4]; shift16(2, vq); store16(VV + (size_t)R * 512 + c0, vq); }
                shift16(0, rq); store16(RR + (size_t)R * 512 + c0, rq);
                shift16(1, kq);
#pragma unroll
                for (int ni = 0; ni < 4; ++ni) {
                    kkn[ni] = kq[ni] * *(const f32x4*)(p.in[16] + c0 + 4 * ni);
                    ss += kkn[ni][0] * kkn[ni][0] + kkn[ni][1] * kkn[ni][1] + kkn[ni][2] * kkn[ni][2] + kkn[ni][3] * kkn[ni][3];
                }
            }
            ss += __shfl_xor(ss, 16); ss += __shfl_xor(ss, 32);
            const float rn = rsqrtf(ss + 1e-6f);
#pragma unroll
            for (int ni = 0; ni < 4; ++ni) kkn[ni] *= rn;
            { uint4 o0, o1; uint2 t0 = pk4(kkn[0]), t1 = pk4(kkn[1]), t2 = pk4(kkn[2]), t3 = pk4(kkn[3]);
              o0 = make_uint4(t0.x, t0.y, t1.x, t1.y); o1 = make_uint4(t2.x, t2.y, t3.x, t3.y);
              *(uint4*)(KK + (size_t)R * 512 + c0) = o0; *(uint4*)(KK + (size_t)R * 512 + c0 + 8) = o1; }
            float bon = 0.f;
#pragma unroll
            for (int d = 0; d < 2; ++d) {
                f32x4 acc[4];
#pragma unroll
                for (int ni = 0; ni < 4; ++ni) acc[ni] = (f32x4){0.f, 0.f, 0.f, 0.f};
#pragma unroll
                for (int kk = 0; kk < 2; ++kk) {
                    const bf16x8 af = *(const bf16x8*)(Lrow + 128 + 64 * d + 32 * kk);
#pragma unroll
                    for (int ni = 0; ni < 4; ++ni) {
                        const bf16x8 bfr = *(const bf16x8*)(Wl + (2 + d) * 64 * 144 + ni * 4 * 144 + kk * 64);
                        acc[ni] = __builtin_amdgcn_mfma_f32_16x16x32_bf16(bfr, af, acc[ni], 0, 0, 0);
                    }
                }
                f32x4 kdv[4], bdv[4];
#pragma unroll
                for (int ni = 0; ni < 4; ++ni) {
                    const int c = c0 + 4 * ni;
                    const f32x4 a = sigm4(acc[ni] + *(const f32x4*)(p.in[13] + d * 512 + c));
                    kdv[ni] = kq[ni] * (1.f + (a - 1.f) * *(const f32x4*)(p.in[17] + c));
                    bdv[ni] = kkn[ni] * a;
                    const f32x4 bt = rq[ni] * kdv[ni] * *(const f32x4*)(p.in[18] + c);
                    bon += (bt[0] + bt[1]) + (bt[2] + bt[3]);
                }
                { uint2 t0 = pk4(kdv[0]), t1 = pk4(kdv[1]), t2 = pk4(kdv[2]), t3 = pk4(kdv[3]);
                  bf16_t* dst = KD + (size_t)d * NTOK * 512 + (size_t)R * 512 + c0;
                  *(uint4*)dst = make_uint4(t0.x, t0.y, t1.x, t1.y); *(uint4*)(dst + 8) = make_uint4(t2.x, t2.y, t3.x, t3.y); }
                { uint2 t0 = pk4(bdv[0]), t1 = pk4(bdv[1]), t2 = pk4(bdv[2]), t3 = pk4(bdv[3]);
                  bf16_t* dst = BD + (size_t)d * NTOK * 512 + (size_t)R * 512 + c0;
                  *(uint4*)dst = make_uint4(t0.x, t0.y, t1.x, t1.y); *(uint4*)(dst + 8) = make_uint4(t2.x, t2.y, t3.x, t3.y); }
            }
            bon += __shfl_xor(bon, 16); bon += __shfl_xor(bon, 32);
            if (fq == 0) BC[(size_t)R * 8 + hd] = bon;
#pragma unroll
            for (int d = 0; d < 2; ++d) {
                f32x4 acc[4];
#pragma unroll
                for (int ni = 0; ni < 4; ++ni) acc[ni] = (f32x4){0.f, 0.f, 0.f, 0.f};
#pragma unroll
                for (int kk = 0; kk < 2; ++kk) {
                    const bf16x8 af = *(const bf16x8*)(Lrow + 64 * d + 32 * kk);
#pragma unroll
                    for (int ni = 0; ni < 4; ++ni) {
                        const bf16x8 bfr = *(const bf16x8*)(Wl + d * 64 * 144 + ni * 4 * 144 + kk * 64);
                        acc[ni] = __builtin_amdgcn_mfma_f32_16x16x32_bf16(bfr, af, acc[ni], 0, 0, 0);
                    }
                }
                uint2 tq[4];
#pragma unroll
                for (int ni = 0; ni < 4; ++ni) tq[ni] = pk4(0.60653066f * sigm4(acc[ni] + *(const f32x4*)(p.in[11] + d * 512 + c0 + 4 * ni)));
                bf16_t* dst = EW + (size_t)d * NTOK * 512 + (size_t)R * 512 + c0;
                *(uint4*)dst = make_uint4(tq[0].x, tq[0].y, tq[1].x, tq[1].y); *(uint4*)(dst + 8) = make_uint4(tq[2].x, tq[2].y, tq[3].x, tq[3].y);
            }
            {
                f32x4 acc[4];
#pragma unroll
                for (int ni = 0; ni < 4; ++ni) acc[ni] = (f32x4){0.f, 0.f, 0.f, 0.f};
#pragma unroll
                for (int kk = 0; kk < 4; ++kk) {
                    const bf16x8 af = *(const bf16x8*)(Lrow + 256 + 32 * kk);
#pragma unroll
                    for (int ni = 0; ni < 4; ++ni) {
                        const bf16x8 bfr = *(const bf16x8*)(Wg + ni * 4 * 272 + kk * 64);
                        acc[ni] = __builtin_amdgcn_mfma_f32_16x16x32_bf16(bfr, af, acc[ni], 0, 0, 0);
                    }
                }
                uint2 tq[4];
#pragma unroll
                for (int ni = 0; ni < 4; ++ni) tq[ni] = pk4(acc[ni]);
                bf16_t* dst = GG + (size_t)R * 512 + c0;
                *(uint4*)dst = make_uint4(tq[0].x, tq[0].y, tq[1].x, tq[1].y); *(uint4*)(dst + 8) = make_uint4(tq[2].x, tq[2].y, tq[3].x, tq[3].y);
            }
        }
        }
    }
}

__device__ __forceinline__ void phase3(const Params& p, char* lds, const XcdBarrier& xb) {
    phase3a(p, lds);
    xcd_barrier(xb);
    phase3b(p, lds);
}

__device__ __forceinline__ int scan_token(int dir, int j) { return dir == 0 ? j : (j < LC ? (LC - 1 - j) : (TT + LC - 1 - j)); }

__device__ __forceinline__ f32x4 bf4_lo(const uint4 v) { return (f32x4){bf2f((bf16_t)(v.x & 0xffff)), bf2f((bf16_t)(v.x >> 16)), bf2f((bf16_t)(v.y & 0xffff)), bf2f((bf16_t)(v.y >> 16))}; }
__device__ __forceinline__ f32x4 bf4_hi(const uint4 v) { return (f32x4){bf2f((bf16_t)(v.z & 0xffff)), bf2f((bf16_t)(v.z >> 16)), bf2f((bf16_t)(v.w & 0xffff)), bf2f((bf16_t)(v.w >> 16))}; }
__device__ __forceinline__ f32x4 exp4n(f32x4 x) { return (f32x4){expf(-x[0]), expf(-x[1]), expf(-x[2]), expf(-x[3])}; }

__device__ __forceinline__ void dot2r_4(float& d0, float& d1, float a0_0, float a0_1, float a0_2, float a0_3, float a1_0, float a1_1, float a1_2, float a1_3, float x0, float x1, float x2, float x3) {
    asm("v_mul_f32 %0, %2, %10\n\t"
        "v_mul_f32 %1, %6, %10\n\t"
        "v_fma_f32 %0, %3, %11, %0\n\t"
        "v_fma_f32 %1, %7, %11, %1\n\t"
        "v_fma_f32 %0, %4, %12, %0\n\t"
        "v_fma_f32 %1, %8, %12, %1\n\t"
        "v_fma_f32 %0, %5, %13, %0\n\t"
        "v_fma_f32 %1, %9, %13, %1\n\t"
        "s_nop 0\n\t"
        "v_add_f32_dpp %0, %0, %0 quad_perm:[1,0,3,2] row_mask:0xf bank_mask:0xf bound_ctrl:1\n\t"
        "v_add_f32_dpp %1, %1, %1 quad_perm:[1,0,3,2] row_mask:0xf bank_mask:0xf bound_ctrl:1\n\t"
        "s_nop 0\n\t"
        "v_add_f32_dpp %0, %0, %0 quad_perm:[2,3,0,1] row_mask:0xf bank_mask:0xf bound_ctrl:1\n\t"
        "v_add_f32_dpp %1, %1, %1 quad_perm:[2,3,0,1] row_mask:0xf bank_mask:0xf bound_ctrl:1\n\t"
        "s_nop 0\n\t"
        "v_add_f32_dpp %0, %0, %0 row_ror:4 row_mask:0xf bank_mask:0xf bound_ctrl:1\n\t"
        "v_add_f32_dpp %1, %1, %1 row_ror:4 row_mask:0xf bank_mask:0xf bound_ctrl:1\n\t"
        "s_nop 0\n\t"
        "v_add_f32_dpp %0, %0, %0 row_ror:8 row_mask:0xf bank_mask:0xf bound_ctrl:1\n\t"
        "v_add_f32_dpp %1, %1, %1 row_ror:8 row_mask:0xf bank_mask:0xf bound_ctrl:1\n\t"
        "s_nop 1\n\t"
        : "=&v"(d0), "=&v"(d1)
        : "v"(a0_0), "v"(a0_1), "v"(a0_2), "v"(a0_3), "v"(a1_0), "v"(a1_1), "v"(a1_2), "v"(a1_3), "v"(x0), "v"(x1), "v"(x2), "v"(x3));
}

__device__ __forceinline__ void dot2r_8(float& d0, float& d1, float a0_0, float a0_1, float a0_2, float a0_3, float a0_4, float a0_5, float a0_6, float a0_7, float a1_0, float a1_1, float a1_2, float a1_3, float a1_4, float a1_5, float a1_6, float a1_7, float x0, float x1, float x2, float x3, float x4, float x5, float x6, float x7) {
    asm("v_mul_f32 %0, %2, %18\n\t"
        "v_mul_f32 %1, %10, %18\n\t"
        "v_fma_f32 %0, %3, %19, %0\n\t"
        "v_fma_f32 %1, %11, %19, %1\n\t"
        "v_fma_f32 %0, %4, %20, %0\n\t"
        "v_fma_f32 %1, %12, %20, %1\n\t"
        "v_fma_f32 %0, %5, %21, %0\n\t"
        "v_fma_f32 %1, %13, %21, %1\n\t"
        "v_fma_f32 %0, %6, %22, %0\n\t"
        "v_fma_f32 %1, %14, %22, %1\n\t"
        "v_fma_f32 %0, %7, %23, %0\n\t"
        "v_fma_f32 %1, %15, %23, %1\n\t"
        "v_fma_f32 %0, %8, %24, %0\n\t"
        "v_fma_f32 %1, %16, %24, %1\n\t"
        "v_fma_f32 %0, %9, %25, %0\n\t"
        "v_fma_f32 %1, %17, %25, %1\n\t"
        "s_nop 0\n\t"
        "v_add_f32_dpp %0, %0, %0 quad_perm:[1,0,3,2] row_mask:0xf bank_mask:0xf bound_ctrl:1\n\t"
        "v_add_f32_dpp %1, %1, %1 quad_perm:[1,0,3,2] row_mask:0xf bank_mask:0xf bound_ctrl:1\n\t"
        "s_nop 0\n\t"
        "v_add_f32_dpp %0, %0, %0 quad_perm:[2,3,0,1] row_mask:0xf bank_mask:0xf bound_ctrl:1\n\t"
        "v_add_f32_dpp %1, %1, %1 quad_perm:[2,3,0,1] row_mask:0xf bank_mask:0xf bound_ctrl:1\n\t"
        "s_nop 0\n\t"
        "v_add_f32_dpp %0, %0, %0 row_ror:4 row_mask:0xf bank_mask:0xf bound_ctrl:1\n\t"
        "v_add_f32_dpp %1, %1, %1 row_ror:4 row_mask:0xf bank_mask:0xf bound_ctrl:1\n\t"
        "s_nop 0\n\t"
        "v_add_f32_dpp %0, %0, %0 row_ror:8 row_mask:0xf bank_mask:0xf bound_ctrl:1\n\t"
        "v_add_f32_dpp %1, %1, %1 row_ror:8 row_mask:0xf bank_mask:0xf bound_ctrl:1\n\t"
        "s_nop 1\n\t"
        : "=&v"(d0), "=&v"(d1)
        : "v"(a0_0), "v"(a0_1), "v"(a0_2), "v"(a0_3), "v"(a0_4), "v"(a0_5), "v"(a0_6), "v"(a0_7), "v"(a1_0), "v"(a1_1), "v"(a1_2), "v"(a1_3), "v"(a1_4), "v"(a1_5), "v"(a1_6), "v"(a1_7), "v"(x0), "v"(x1), "v"(x2), "v"(x3), "v"(x4), "v"(x5), "v"(x6), "v"(x7));
}

__device__ __forceinline__ void rwkv_upd2(float (&s0)[4], float (&s1)[4], f32x4 w, f32x4 kd, f32x4 bb, float v0, float v1, float sa0, float sa1) {
    float t0, t1;
    asm("v_mul_f32 %8, %22, %14\n\t"
        "v_mul_f32 %9, %23, %14\n\t"
        "v_fma_f32 %8, -%24, %18, %8\n\t"
        "v_fma_f32 %9, -%25, %18, %9\n\t"
        "v_fma_f32 %0, %0, %10, %8\n\t"
        "v_fma_f32 %4, %4, %10, %9\n\t"
        "v_mul_f32 %8, %22, %15\n\t"
        "v_mul_f32 %9, %23, %15\n\t"
        "v_fma_f32 %8, -%24, %19, %8\n\t"
        "v_fma_f32 %9, -%25, %19, %9\n\t"
        "v_fma_f32 %1, %1, %11, %8\n\t"
        "v_fma_f32 %5, %5, %11, %9\n\t"
        "v_mul_f32 %8, %22, %16\n\t"
        "v_mul_f32 %9, %23, %16\n\t"
        "v_fma_f32 %8, -%24, %20, %8\n\t"
        "v_fma_f32 %9, -%25, %20, %9\n\t"
        "v_fma_f32 %2, %2, %12, %8\n\t"
        "v_fma_f32 %6, %6, %12, %9\n\t"
        "v_mul_f32 %8, %22, %17\n\t"
        "v_mul_f32 %9, %23, %17\n\t"
        "v_fma_f32 %8, -%24, %21, %8\n\t"
        "v_fma_f32 %9, -%25, %21, %9\n\t"
        "v_fma_f32 %3, %3, %13, %8\n\t"
        "v_fma_f32 %7, %7, %13, %9\n\t"
        : "+v"(s0[0]), "+v"(s0[1]), "+v"(s0[2]), "+v"(s0[3]), "+v"(s1[0]), "+v"(s1[1]), "+v"(s1[2]), "+v"(s1[3]), "=&v"(t0), "=&v"(t1)
        : "v"(w[0]), "v"(w[1]), "v"(w[2]), "v"(w[3]), "v"(kd[0]), "v"(kd[1]), "v"(kd[2]), "v"(kd[3]), "v"(bb[0]), "v"(bb[1]), "v"(bb[2]), "v"(bb[3]), "v"(v0), "v"(v1), "v"(sa0), "v"(sa1));
}

__device__ __forceinline__ void gdn_upd2(float (&s0)[8], float (&s1)[8], f32x4 ka, f32x4 kb, float eg, float d0, float d1) {
    float t0, t1;
    asm("v_mul_f32 %16, %18, %27\n\t"
        "v_mul_f32 %17, %18, %28\n\t"
        "v_fma_f32 %0, %26, %0, %16\n\t"
        "v_fma_f32 %8, %26, %8, %17\n\t"
        "v_mul_f32 %16, %19, %27\n\t"
        "v_mul_f32 %17, %19, %28\n\t"
        "v_fma_f32 %1, %26, %1, %16\n\t"
        "v_fma_f32 %9, %26, %9, %17\n\t"
        "v_mul_f32 %16, %20, %27\n\t"
        "v_mul_f32 %17, %20, %28\n\t"
        "v_fma_f32 %2, %26, %2, %16\n\t"
        "v_fma_f32 %10, %26, %10, %17\n\t"
        "v_mul_f32 %16, %21, %27\n\t"
        "v_mul_f32 %17, %21, %28\n\t"
        "v_fma_f32 %3, %26, %3, %16\n\t"
        "v_fma_f32 %11, %26, %11, %17\n\t"
        "v_mul_f32 %16, %22, %27\n\t"
        "v_mul_f32 %17, %22, %28\n\t"
        "v_fma_f32 %4, %26, %4, %16\n\t"
        "v_fma_f32 %12, %26, %12, %17\n\t"
        "v_mul_f32 %16, %23, %27\n\t"
        "v_mul_f32 %17, %23, %28\n\t"
        "v_fma_f32 %5, %26, %5, %16\n\t"
        "v_fma_f32 %13, %26, %13, %17\n\t"
        "v_mul_f32 %16, %24, %27\n\t"
        "v_mul_f32 %17, %24, %28\n\t"
        "v_fma_f32 %6, %26, %6, %16\n\t"
        "v_fma_f32 %14, %26, %14, %17\n\t"
        "v_mul_f32 %16, %25, %27\n\t"
        "v_mul_f32 %17, %25, %28\n\t"
        "v_fma_f32 %7, %26, %7, %16\n\t"
        "v_fma_f32 %15, %26, %15, %17\n\t"
        : "+v"(s0[0]), "+v"(s0[1]), "+v"(s0[2]), "+v"(s0[3]), "+v"(s0[4]), "+v"(s0[5]), "+v"(s0[6]), "+v"(s0[7]), "+v"(s1[0]), "+v"(s1[1]), "+v"(s1[2]), "+v"(s1[3]), "+v"(s1[4]), "+v"(s1[5]), "+v"(s1[6]), "+v"(s1[7]), "=&v"(t0), "=&v"(t1)
        : "v"(ka[0]), "v"(ka[1]), "v"(ka[2]), "v"(ka[3]), "v"(kb[0]), "v"(kb[1]), "v"(kb[2]), "v"(kb[3]), "v"(eg), "v"(d0), "v"(d1));
}

template <bool DO_R, bool DO_G>
__device__ __forceinline__ void phase4_seq(const Params& p, char* lds) {
    float* Ws = (float*)lds;
    float* Ks = Ws + 2048;
    float* Bs = Ks + 2048;
    float* Ds = Bs + 2048;
    float* Rs = Ds + 2048;
    float* Vs = Rs + 2048;
    float* Yo = Vs + 1024;
    float* Kc = Yo + 1024;
    float* Qc = Kc + 4096;
    float* Vc = Qc + 4096;
    float* Oo = Vc + 1024;
    float* Gc = Oo + 1024;
    float* Bc = Gc + 32;
    const int t = threadIdx.x;
    const bool isR = t < 256;
    const bool act = isR ? DO_R : DO_G;
    const int tl = t & 255;
    const int grp = tl >> 4, sub = tl & 15;
    const int sstep = tl >> 3, sq = tl & 7;
    for (int u = blockIdx.x; u < 256; u += gridDim.x) {
        const int rscan = u >> 1, rhalf = u & 1;
        const int rb = rscan >> 4, rh = (rscan >> 1) & 7, rdir = rscan & 1;
        const int gscan = u >> 2, gquart = u & 3;
        const int gb = gscan >> 3, gh = (gscan >> 1) & 3, gdir = gscan & 1;
        const bf16_t* EW = (const bf16_t*)(p.ws + B_EW) + (size_t)rdir * NTOK * 512;
        const bf16_t* KD = (const bf16_t*)(p.ws + B_KD) + (size_t)rdir * NTOK * 512;
        const bf16_t* BD = (const bf16_t*)(p.ws + B_BD) + (size_t)rdir * NTOK * 512;
        const bf16_t* RR = (const bf16_t*)(p.ws + B_RR); const bf16_t* KK = (const bf16_t*)(p.ws + B_KK); const bf16_t* VV = (const bf16_t*)(p.ws + B_VV);
        bf16_t* Y = (bf16_t*)(p.ws + (rdir == 0 ? B_YF : B_YB));
        const bf16_t* GQ = (const bf16_t*)(p.ws + B_GQ); const bf16_t* GK = (const bf16_t*)(p.ws + B_GK); const bf16_t* GV = (const bf16_t*)(p.ws + B_GV);
        const float* GDG = (const float*)(p.ws + B_GDG); const float* GDB = (const float*)(p.ws + B_GDB);
        bf16_t* O = (bf16_t*)(p.ws + (gdir == 0 ? B_OF : B_OB));
        float SR[2][4], SG[2][8];
#pragma unroll
        for (int i = 0; i < 4; ++i) { SR[0][i] = 0.f; SR[1][i] = 0.f; }
#pragma unroll
        for (int i = 0; i < 8; ++i) { SG[0][i] = 0.f; SG[1][i] = 0.f; }
        for (int chunk = 0; chunk < TT / 32; ++chunk) {
            if (!act) {
            } else if (isR) {
                const int s = scan_token(rdir, chunk * 32 + sstep);
                const size_t o = (size_t)(rb * TT + s) * 512 + rh * 64 + sq * 8;
                const uint4 e = *(const uint4*)(EW + o), kk = *(const uint4*)(KK + o), bb = *(const uint4*)(BD + o), kd = *(const uint4*)(KD + o), rr = *(const uint4*)(RR + o);
                const int li = sstep * 64 + sq * 8;
                *(f32x4*)(Ws + li) = exp4n(bf4_lo(e)); *(f32x4*)(Ws + li + 4) = exp4n(bf4_hi(e));
                *(f32x4*)(Ks + li) = bf4_lo(kk); *(f32x4*)(Ks + li + 4) = bf4_hi(kk);
                *(f32x4*)(Bs + li) = bf4_lo(bb); *(f32x4*)(Bs + li + 4) = bf4_hi(bb);
                *(f32x4*)(Ds + li) = bf4_lo(kd); *(f32x4*)(Ds + li + 4) = bf4_hi(kd);
                *(f32x4*)(Rs + li) = bf4_lo(rr); *(f32x4*)(Rs + li + 4) = bf4_hi(rr);
                *(f32x4*)(Vs + sstep * 32 + sq * 4) = ld_bf4(VV + (size_t)(rb * TT + s) * 512 + rh * 64 + rhalf * 32 + sq * 4);
            } else {
                const int s = scan_token(gdir, chunk * 32 + sstep);
                const size_t R = (size_t)(gb * TT + s);
                const uint4 k0 = *(const uint4*)(GK + R * 512 + gh * 128 + sq * 16), k1 = *(const uint4*)(GK + R * 512 + gh * 128 + sq * 16 + 8);
                const uint4 q0 = *(const uint4*)(GQ + R * 512 + gh * 128 + sq * 16), q1 = *(const uint4*)(GQ + R * 512 + gh * 128 + sq * 16 + 8);
                float* kd = Kc + sstep * 128 + sq * 16; float* qd = Qc + sstep * 128 + sq * 16;
                *(f32x4*)(kd) = bf4_lo(k0); *(f32x4*)(kd + 4) = bf4_hi(k0); *(f32x4*)(kd + 8) = bf4_lo(k1); *(f32x4*)(kd + 12) = bf4_hi(k1);
                *(f32x4*)(qd) = bf4_lo(q0); *(f32x4*)(qd + 4) = bf4_hi(q0); *(f32x4*)(qd + 8) = bf4_lo(q1); *(f32x4*)(qd + 12) = bf4_hi(q1);
                *(f32x4*)(Vc + sstep * 32 + sq * 4) = ld_bf4(GV + R * 512 + gh * 128 + gquart * 32 + sq * 4);
                if (tl < 32) {
                    const int s2 = scan_token(gdir, chunk * 32 + tl);
                    const size_t R2 = (size_t)(gb * TT + s2);
                    Gc[tl] = expf(GDG[R2 * 8 + gdir * 4 + gh]);
                    Bc[tl] = GDB[R2 * 8 + gdir * 4 + gh];
                }
            }
            __syncthreads();
            if (!act) {
            } else if (isR) {
                const int c4 = sub * 4;
                f32x4 kk = *(const f32x4*)(Ks + c4), wv = *(const f32x4*)(Ws + c4), bb = *(const f32x4*)(Bs + c4), kd = *(const f32x4*)(Ds + c4), rv = *(const f32x4*)(Rs + c4);
                float v0 = Vs[grp], v1 = Vs[16 + grp];
#pragma unroll 2
                for (int step = 0; step < 32; ++step) {
                    const int nx = (step + 1 < 32 ? step + 1 : step) * 64 + c4;
                    const f32x4 kkn = *(const f32x4*)(Ks + nx), wvn = *(const f32x4*)(Ws + nx), bbn = *(const f32x4*)(Bs + nx), kdn = *(const f32x4*)(Ds + nx), rvn = *(const f32x4*)(Rs + nx);
                    const int nv = (step + 1 < 32 ? step + 1 : step) * 32;
                    const float v0n = Vs[nv + grp], v1n = Vs[nv + 16 + grp];
                    float sa0, sa1, y0, y1;
                    dot2r_4(sa0, sa1, SR[0][0], SR[0][1], SR[0][2], SR[0][3], SR[1][0], SR[1][1], SR[1][2], SR[1][3], kk[0], kk[1], kk[2], kk[3]);
                    rwkv_upd2(SR[0], SR[1], wv, kd, bb, v0, v1, sa0, sa1);
                    dot2r_4(y0, y1, SR[0][0], SR[0][1], SR[0][2], SR[0][3], SR[1][0], SR[1][1], SR[1][2], SR[1][3], rv[0], rv[1], rv[2], rv[3]);
                    if (sub == 0) { Yo[step * 32 + grp] = y0; Yo[step * 32 + 16 + grp] = y1; }
                    kk = kkn; wv = wvn; bb = bbn; kd = kdn; rv = rvn; v0 = v0n; v1 = v1n;
                }
            } else {
                const int k8 = sub * 8;
                f32x4 ka = *(const f32x4*)(Kc + k8), kb = *(const f32x4*)(Kc + k8 + 4), qa = *(const f32x4*)(Qc + k8), qb = *(const f32x4*)(Qc + k8 + 4);
                float v0 = Vc[grp], v1 = Vc[16 + grp], eg = Gc[0], be = Bc[0];
#pragma unroll 2
                for (int step = 0; step < 32; ++step) {
                    const int ns = (step + 1 < 32 ? step + 1 : step);
                    const f32x4 kan = *(const f32x4*)(Kc + ns * 128 + k8), kbn = *(const f32x4*)(Kc + ns * 128 + k8 + 4), qan = *(const f32x4*)(Qc + ns * 128 + k8), qbn = *(const f32x4*)(Qc + ns * 128 + k8 + 4);
                    const float v0n = Vc[ns * 32 + grp], v1n = Vc[ns * 32 + 16 + grp], egn = Gc[ns], ben = Bc[ns];
                    float ks0, ks1, o0, o1;
                    dot2r_8(ks0, ks1, SG[0][0], SG[0][1], SG[0][2], SG[0][3], SG[0][4], SG[0][5], SG[0][6], SG[0][7], SG[1][0], SG[1][1], SG[1][2], SG[1][3], SG[1][4], SG[1][5], SG[1][6], SG[1][7],
                            ka[0], ka[1], ka[2], ka[3], kb[0], kb[1], kb[2], kb[3]);
                    const float d0 = be * (v0 - eg * ks0), d1 = be * (v1 - eg * ks1);
                    gdn_upd2(SG[0], SG[1], ka, kb, eg, d0, d1);
                    dot2r_8(o0, o1, SG[0][0], SG[0][1], SG[0][2], SG[0][3], SG[0][4], SG[0][5], SG[0][6], SG[0][7], SG[1][0], SG[1][1], SG[1][2], SG[1][3], SG[1][4], SG[1][5], SG[1][6], SG[1][7],
                            qa[0], qa[1], qa[2], qa[3], qb[0], qb[1], qb[2], qb[3]);
                    if (sub == 0) { Oo[step * 32 + grp] = o0; Oo[step * 32 + 16 + grp] = o1; }
                    ka = kan; kb = kbn; qa = qan; qb = qbn; v0 = v0n; v1 = v1n; eg = egn; be = ben;
                }
            }
            __syncthreads();
            if (!act) {
            } else if (isR) {
                const int s = scan_token(rdir, chunk * 32 + sstep);
                st_bf4(Y + (size_t)(rb * TT + s) * 512 + rh * 64 + rhalf * 32 + sq * 4, *(const f32x4*)(Yo + sstep * 32 + sq * 4));
            } else {
                const int s = scan_token(gdir, chunk * 32 + sstep);
                st_bf4(O + (size_t)(gb * TT + s) * 512 + gh * 128 + gquart * 32 + sq * 4, *(const f32x4*)(Oo + sstep * 32 + sq * 4));
            }
        }
        __syncthreads();
    }
}


template <int I> __device__ __forceinline__ void fs_load_row(const LAS char* L, f32x4 (&l)[16]) {
#pragma unroll
    for (int j4 = 0; j4 < (I + 3) / 4; ++j4) l[j4] = *(const LAS f32x4*)(L + I * 256 + j4 * 16);
}
template <int I> __device__ __forceinline__ void fs_do_row(const f32x4 (&l)[16], float (&m)[64], int lane) {
    float a0 = (I == lane) ? 1.f : 0.f, a1 = 0.f, a2 = 0.f, a3 = 0.f;
#pragma unroll
    for (int j4 = 0; j4 < (I + 3) / 4; ++j4) {
        if (4 * j4 + 0 < I) a0 -= l[j4][0] * m[4 * j4 + 0];
        if (4 * j4 + 1 < I) a1 -= l[j4][1] * m[4 * j4 + 1];
        if (4 * j4 + 2 < I) a2 -= l[j4][2] * m[4 * j4 + 2];
        if (4 * j4 + 3 < I) a3 -= l[j4][3] * m[4 * j4 + 3];
    }
    m[I] = (a0 + a1) + (a2 + a3);
}
template <int I> struct FsRows {
    static __device__ __forceinline__ void run(const LAS char* L, float (&m)[64], int lane) {
        f32x4 ra[16];
        fs_load_row<I>(L, ra);
        fs_do_row<I>(ra, m, lane);
        __builtin_amdgcn_sched_barrier(0);
        if constexpr (I + 1 < 64) FsRows<I + 1>::run(L, m, lane);
    }
};
__device__ __forceinline__ void fs_solve(const LAS char* L, float (&m)[64], int lane) { FsRows<0>::run(L, m, lane); }

__device__ __forceinline__ float wave_incl_scan(float x, int lane) {
    (void)lane;
    x += __builtin_bit_cast(float, __builtin_amdgcn_update_dpp(0, __builtin_bit_cast(int, x), 0x111, 0xf, 0xf, true));
    x += __builtin_bit_cast(float, __builtin_amdgcn_update_dpp(0, __builtin_bit_cast(int, x), 0x112, 0xf, 0xf, true));
    x += __builtin_bit_cast(float, __builtin_amdgcn_update_dpp(0, __builtin_bit_cast(int, x), 0x114, 0xf, 0xf, true));
    x += __builtin_bit_cast(float, __builtin_amdgcn_update_dpp(0, __builtin_bit_cast(int, x), 0x118, 0xf, 0xf, true));
    x += __builtin_bit_cast(float, __builtin_amdgcn_update_dpp(0, __builtin_bit_cast(int, x), 0x142, 0xa, 0xf, false));
    x += __builtin_bit_cast(float, __builtin_amdgcn_update_dpp(0, __builtin_bit_cast(int, x), 0x143, 0xc, 0xf, false));
    return x;
}
__device__ __forceinline__ float lane63(float x) { return __builtin_bit_cast(float, __builtin_amdgcn_readlane(__builtin_bit_cast(int, x), 63)); }

__device__ __forceinline__ void phase4a(const Params& p, char* lds) {
    const int t = threadIdx.x, lane = t & 63, w = t >> 6, fr = lane & 15, fq = lane >> 4;
    unsigned lb = (unsigned)(w * 16384);
    asm volatile("" : "+v"(lb));
    LAS char* Lw = (LAS char*)lds + lb;
    LAS float* GCw = (LAS float*)((LAS char*)lds + 131072 + w * 512);
    const bf16_t* GK = (const bf16_t*)(p.ws + B_GK);
    const float* GDG = (const float*)(p.ws + B_GDG); const float* GDB = (const float*)(p.ws + B_GDB);
    const bf16_t* KK = (const bf16_t*)(p.ws + B_KK);
    bf16_t* GMW = (bf16_t*)(p.ws + C_GMW); bf16_t* GMU = (bf16_t*)(p.ws + C_GMU); bf16_t* RM = (bf16_t*)(p.ws + C_RM);
    const int nwave = gridDim.x * 8;
    for (int q = blockIdx.x * 8 + w; q < 6912; q += nwave) {
        float m[64];
        float gcl = 0.f, bel = 0.f;
        if (q >= 4608) {
            const int qq = q - 4608, sg = qq / 36, n = qq % 36;
            const int b = sg >> 3, h = (sg >> 1) & 3, dir = sg & 1;
            {
                const size_t R = (size_t)(b * TT + scan_token(dir, 64 * n + lane));
                gcl = wave_incl_scan(GDG[R * 8 + dir * 4 + h], lane);
                bel = GDB[R * 8 + dir * 4 + h];
                GCw[lane] = gcl; GCw[64 + lane] = bel;
            }
            bf16x8 kf[4][4];
#pragma unroll
            for (int tt = 0; tt < 4; ++tt) {
                const size_t R = (size_t)(b * TT + scan_token(dir, 64 * n + 16 * tt + fr));
#pragma unroll
                for (int kk = 0; kk < 4; ++kk) kf[tt][kk] = *(const bf16x8*)(GK + R * 512 + h * 128 + 32 * kk + 8 * fq);
            }
#pragma unroll
            for (int ti = 0; ti < 4; ++ti)
#pragma unroll
                for (int tj = 0; tj <= ti; ++tj) {
                    f32x4 acc = (f32x4){0.f, 0.f, 0.f, 0.f};
#pragma unroll
                    for (int kk = 0; kk < 4; ++kk) acc = __builtin_amdgcn_mfma_f32_16x16x32_bf16(kf[ti][kk], kf[tj][kk], acc, 0, 0, 0);
                    const int j = 16 * tj + fr;
                    const float gcj = GCw[j];
#pragma unroll
                    for (int r = 0; r < 4; ++r) {
                        const int i = 16 * ti + 4 * fq + r;
                        const float v = (i > j) ? GCw[64 + i] * acc[r] * expf(fminf(GCw[i] - gcj, 0.f)) : 0.f;
                        *(LAS float*)(Lw + i * 256 + j * 4) = v;
                    }
                }
        } else {
            const int sr = q / 36, n = q % 36;
            const int b = sr >> 4, h = (sr >> 1) & 7, dir = sr & 1;
            const bf16_t* EW = (const bf16_t*)(p.ws + B_EW) + (size_t)dir * NTOK * 512;
            const bf16_t* BD = (const bf16_t*)(p.ws + B_BD) + (size_t)dir * NTOK * 512;
            {
                const size_t o = (size_t)(b * TT + scan_token(dir, 64 * n + lane)) * 512 + h * 64;
                uint4 ewq[8], kkq[8], bdq[8];
#pragma unroll
                for (int part = 0; part < 8; ++part) { ewq[part] = *(const uint4*)(EW + o + part * 8); kkq[part] = *(const uint4*)(KK + o + part * 8); bdq[part] = *(const uint4*)(BD + o + part * 8); }
#pragma unroll
                for (int part = 0; part < 8; ++part) {
                    float ew[8], kkv[8], bv[8], okt[8], obh[8];
                    unpack8(ewq[part], ew); unpack8(kkq[part], kkv); unpack8(bdq[part], bv);
#pragma unroll
                    for (int e = 0; e < 8; ++e) {
                        const float lam = -wave_incl_scan(ew[e], lane);
                        const float el = __expf(lam);
                        okt[e] = kkv[e] * (el * __expf(ew[e]));
                        obh[e] = bv[e] * __builtin_amdgcn_rcpf(el);
                    }
                    const u32x4 q1 = (u32x4){pack2(okt[0], okt[1]), pack2(okt[2], okt[3]), pack2(okt[4], okt[5]), pack2(okt[6], okt[7])};
                    const u32x4 q2 = (u32x4){pack2(obh[0], obh[1]), pack2(obh[2], obh[3]), pack2(obh[4], obh[5]), pack2(obh[6], obh[7])};
                    *(LAS u32x4*)(Lw + lane * 128 + part * 16) = q1;
                    *(LAS u32x4*)(Lw + 8192 + lane * 128 + part * 16) = q2;
                }
            }
            f32x4 acc[10];
            {
                int tix = 0;
#pragma unroll
                for (int ti = 0; ti < 4; ++ti)
#pragma unroll
                    for (int tj = 0; tj <= ti; ++tj) {
                        f32x4 a = (f32x4){0.f, 0.f, 0.f, 0.f};
#pragma unroll
                        for (int kk = 0; kk < 2; ++kk) {
                            const bf16x8 xf = *(const LAS bf16x8*)(Lw + (16 * ti + fr) * 128 + (32 * kk + 8 * fq) * 2);
                            const bf16x8 yf = *(const LAS bf16x8*)(Lw + 8192 + (16 * tj + fr) * 128 + (32 * kk + 8 * fq) * 2);
                            a = __builtin_amdgcn_mfma_f32_16x16x32_bf16(xf, yf, a, 0, 0, 0);
                        }
                        acc[tix++] = a;
                    }
            }
            asm volatile("s_waitcnt lgkmcnt(0)" ::: "memory");
            {
                int tix = 0;
#pragma unroll
                for (int ti = 0; ti < 4; ++ti)
#pragma unroll
                    for (int tj = 0; tj <= ti; ++tj) {
                        const f32x4 a = acc[tix++];
                        const int j = 16 * tj + fr;
#pragma unroll
                        for (int r = 0; r < 4; ++r) {
                            const int i = 16 * ti + 4 * fq + r;
                            *(LAS float*)(Lw + i * 256 + j * 4) = (i > j) ? a[r] : 0.f;
                        }
                    }
            }
        }
        asm volatile("s_waitcnt lgkmcnt(0)" ::: "memory");
        fs_solve(Lw, m, lane);
        if (q >= 4608) {
            const float su = bel, sw = bel * expf(gcl);
            bf16_t* dw = GMW + (size_t)(q - 4608) * 4096 + lane; bf16_t* du = GMU + (size_t)(q - 4608) * 4096 + lane;
#pragma unroll
            for (int i = 0; i < 64; ++i) { dw[i * 64] = f2bf(m[i] * sw); du[i * 64] = f2bf(m[i] * su); }
        } else {
            bf16_t* dm = RM + (size_t)q * 4096 + lane;
#pragma unroll
            for (int i = 0; i < 64; ++i) dm[i * 64] = f2bf(m[i]);
        }
        asm volatile("s_waitcnt lgkmcnt(0)" ::: "memory");
    }
}

#define PIN4(q) asm volatile("" : "+v"((q).x), "+v"((q).y), "+v"((q).z), "+v"((q).w))
constexpr int S144 = 144, S272 = 272;
constexpr int G_KROW = 0;
constexpr int G_QROW = G_KROW + 64 * S272;
constexpr int G_W = G_QROW + 64 * S272;
constexpr int G_ST = G_W + 64 * S272;
constexpr int G_KT = G_ST + 64 * S272;
constexpr int G_VT = G_KT + 128 * S144;
constexpr int G_MW = G_VT + 64 * S144;
constexpr int G_MU = G_MW + 64 * S144;
constexpr int G_AQK = G_MU + 64 * S144;
constexpr int G_UT = G_AQK + 64 * S144;
constexpr int G_VNT = G_UT + 64 * S144;
constexpr int G_VST = G_VNT + 64 * S144;
constexpr int G_GC = G_VST + 64 * S144;
constexpr int G_END = G_GC + 256;
static_assert(G_END <= LDS_MAIN, "DeltaNet chunk LDS map too large");

template <int K>
__device__ __forceinline__ void mm_nt(f32x4& acc, const char* xrow, const char* yrow) {
#pragma unroll
    for (int kk = 0; kk < K / 32; ++kk) {
        const bf16x8 xf = *(const bf16x8*)(xrow + kk * 64), yf = *(const bf16x8*)(yrow + kk * 64);
        acc = __builtin_amdgcn_mfma_f32_16x16x32_bf16(xf, yf, acc, 0, 0, 0);
    }
}

__device__ __forceinline__ void gdn_chunk_unit(const Params& p, int u, char* lds) {
    const int scan = u >> 1, hf = u & 1;
    const int b = scan >> 3, h = (scan >> 1) & 3, dir = scan & 1;
    const bf16_t* GQ = (const bf16_t*)(p.ws + B_GQ); const bf16_t* GK = (const bf16_t*)(p.ws + B_GK); const bf16_t* GV = (const bf16_t*)(p.ws + B_GV);
    const float* GDG = (const float*)(p.ws + B_GDG);
    const bf16_t* GMW = (const bf16_t*)(p.ws + C_GMW) + (size_t)scan * 36 * 4096; const bf16_t* GMU = (const bf16_t*)(p.ws + C_GMU) + (size_t)scan * 36 * 4096;
    bf16_t* O = (bf16_t*)(p.ws + (dir == 0 ? B_OF : B_OB));
    float* GC = (float*)(lds + G_GC);
    const int t = threadIdx.x, lane = t & 63, w = t >> 6, fr = lane & 15, fq = lane >> 4;
    for (int i = t; i < 64 * S272 / 16; i += NTHR) ((uint4*)(lds + G_ST))[i] = make_uint4(0u, 0u, 0u, 0u);
    f32x4 Sreg[4];
#pragma unroll
    for (int tc = 0; tc < 4; ++tc) Sreg[tc] = (f32x4){0.f, 0.f, 0.f, 0.f};
    uint4 pk0, pk1, pq0, pq1, pv0, pmw, pmu; float pg;
    {
        const size_t R0 = (size_t)(b * TT + scan_token(dir, lane));
        pk0 = *(const uint4*)(GK + R0 * 512 + h * 128 + w * 16); pk1 = *(const uint4*)(GK + R0 * 512 + h * 128 + w * 16 + 8);
        pq0 = *(const uint4*)(GQ + R0 * 512 + h * 128 + w * 16); pq1 = *(const uint4*)(GQ + R0 * 512 + h * 128 + w * 16 + 8);
        pv0 = *(const uint4*)(GV + R0 * 512 + h * 128 + 64 * hf + w * 8);
        pmw = *(const uint4*)(GMW + t * 8); pmu = *(const uint4*)(GMU + t * 8);
        pg = GDG[R0 * 8 + dir * 4 + h];
    }
    __syncthreads();
    for (int n = 0; n < TT / 64; ++n) {
        {
            const int i = lane, part = w;
            PIN4(pk0); PIN4(pk1); PIN4(pq0); PIN4(pq1); PIN4(pv0); PIN4(pmw); PIN4(pmu); asm volatile("" : "+v"(pg));
            const uint4 k0 = pk0, k1 = pk1, q0 = pq0, q1 = pq1, v0 = pv0, mw = pmw, mu = pmu;
            const float gcur = pg;
            if (n + 1 < TT / 64) {
                const size_t Rn = (size_t)(b * TT + scan_token(dir, 64 * (n + 1) + i));
                pk0 = *(const uint4*)(GK + Rn * 512 + h * 128 + part * 16); pk1 = *(const uint4*)(GK + Rn * 512 + h * 128 + part * 16 + 8);
                pq0 = *(const uint4*)(GQ + Rn * 512 + h * 128 + part * 16); pq1 = *(const uint4*)(GQ + Rn * 512 + h * 128 + part * 16 + 8);
                pv0 = *(const uint4*)(GV + Rn * 512 + h * 128 + 64 * hf + part * 8);
                pmw = *(const uint4*)(GMW + (size_t)(n + 1) * 4096 + t * 8); pmu = *(const uint4*)(GMU + (size_t)(n + 1) * 4096 + t * 8);
                pg = GDG[Rn * 8 + dir * 4 + h];
            }
            *(uint4*)(lds + G_KROW + i * S272 + part * 32) = k0; *(uint4*)(lds + G_KROW + i * S272 + part * 32 + 16) = k1;
            *(uint4*)(lds + G_QROW + i * S272 + part * 32) = q0; *(uint4*)(lds + G_QROW + i * S272 + part * 32 + 16) = q1;
            *(uint4*)(lds + G_MW + (t >> 3) * S144 + (t & 7) * 16) = mw; *(uint4*)(lds + G_MU + (t >> 3) * S144 + (t & 7) * 16) = mu;
            const unsigned kw[8] = {k0.x, k0.y, k0.z, k0.w, k1.x, k1.y, k1.z, k1.w};
#pragma unroll
            for (int e = 0; e < 8; ++e) {
                *(bf16_t*)(lds + G_KT + (part * 16 + 2 * e) * S144 + i * 2) = (bf16_t)(kw[e] & 0xffff);
                *(bf16_t*)(lds + G_KT + (part * 16 + 2 * e + 1) * S144 + i * 2) = (bf16_t)(kw[e] >> 16);
            }
            const unsigned vw[4] = {v0.x, v0.y, v0.z, v0.w};
#pragma unroll
            for (int e = 0; e < 4; ++e) {
                *(bf16_t*)(lds + G_VT + (part * 8 + 2 * e) * S144 + i * 2) = (bf16_t)(vw[e] & 0xffff);
                *(bf16_t*)(lds + G_VT + (part * 8 + 2 * e + 1) * S144 + i * 2) = (bf16_t)(vw[e] >> 16);
            }
            if (w == 0) GC[lane] = wave_incl_scan(gcur, lane);
        }
        __syncthreads();
        {
            const int ti = w >> 1;
#pragma unroll
            for (int tjj = 0; tjj < 2; ++tjj) {
                const int tj = 2 * (w & 1) + tjj;
                f32x4 aqk = (f32x4){0.f, 0.f, 0.f, 0.f};
                if (tj <= ti) mm_nt<128>(aqk, lds + G_QROW + (16 * ti + fr) * S272 + fq * 16, lds + G_KROW + (16 * tj + fr) * S272 + fq * 16);
                const int j = 16 * tj + fr;
                const float gcj = GC[j];
#pragma unroll
                for (int r = 0; r < 4; ++r) {
                    const int i = 16 * ti + 4 * fq + r;
                    *(bf16_t*)(lds + G_AQK + i * S144 + j * 2) = f2bf((i >= j) ? aqk[r] * expf(fminf(GC[i] - gcj, 0.f)) : 0.f);
                }
            }
#pragma unroll
            for (int ti2 = 0; ti2 < 4; ++ti2) {
                f32x4 acc = (f32x4){0.f, 0.f, 0.f, 0.f};
                mm_nt<64>(acc, lds + G_KT + (16 * w + fr) * S144 + fq * 16, lds + G_MW + (16 * ti2 + fr) * S144 + fq * 16);
                *(uint2*)(lds + G_W + (16 * ti2 + fr) * S272 + (16 * w + 4 * fq) * 2) = pk4(acc);
            }
#pragma unroll
            for (int tcc = 0; tcc < 2; ++tcc) {
                const int tc = 2 * (w & 1) + tcc;
                f32x4 acc = (f32x4){0.f, 0.f, 0.f, 0.f};
                mm_nt<64>(acc, lds + G_MU + (16 * ti + fr) * S144 + fq * 16, lds + G_VT + (16 * tc + fr) * S144 + fq * 16);
                *(uint2*)(lds + G_UT + (16 * tc + fr) * S144 + (16 * ti + 4 * fq) * 2) = pk4(acc);
            }
        }
        __syncthreads();
        const float gL = GC[63];
        {
            const int ti = w >> 1;
#pragma unroll
            for (int tcc = 0; tcc < 2; ++tcc) {
                const int tc = 2 * (w & 1) + tcc;
                f32x4 acc = (f32x4){0.f, 0.f, 0.f, 0.f};
                mm_nt<128>(acc, lds + G_W + (16 * ti + fr) * S272 + fq * 16, lds + G_ST + (16 * tc + fr) * S272 + fq * 16);
                const int i0 = 16 * ti + 4 * fq, col = 16 * tc + fr;
                const f32x4 vn = ld_bf4((const bf16_t*)(lds + G_UT + col * S144 + i0 * 2)) - acc;
                *(uint2*)(lds + G_VNT + col * S144 + i0 * 2) = pk4(vn);
                const f32x4 sc = (f32x4){expf(gL - GC[i0]), expf(gL - GC[i0 + 1]), expf(gL - GC[i0 + 2]), expf(gL - GC[i0 + 3])};
                *(uint2*)(lds + G_VST + col * S144 + i0 * 2) = pk4(vn * sc);
            }
        }
        __syncthreads();
        {
            const int ti = w >> 1;
#pragma unroll
            for (int tcc = 0; tcc < 2; ++tcc) {
                const int tc = 2 * (w & 1) + tcc;
                f32x4 a1 = (f32x4){0.f, 0.f, 0.f, 0.f}, a2 = a1;
                mm_nt<128>(a1, lds + G_QROW + (16 * ti + fr) * S272 + fq * 16, lds + G_ST + (16 * tc + fr) * S272 + fq * 16);
                mm_nt<64>(a2, lds + G_AQK + (16 * ti + fr) * S144 + fq * 16, lds + G_VNT + (16 * tc + fr) * S144 + fq * 16);
                const int i0 = 16 * ti + 4 * fq, col = 16 * tc + fr;
#pragma unroll
                for (int r = 0; r < 4; ++r) *(bf16_t*)(lds + G_UT + (i0 + r) * S144 + col * 2) = f2bf(expf(GC[i0 + r]) * a1[r] + a2[r]);
            }
            const float egL = expf(gL);
#pragma unroll
            for (int tc = 0; tc < 4; ++tc) {
                f32x4 acc = (f32x4){0.f, 0.f, 0.f, 0.f};
                mm_nt<64>(acc, lds + G_KT + (16 * w + fr) * S144 + fq * 16, lds + G_VST + (16 * tc + fr) * S144 + fq * 16);
                Sreg[tc] = Sreg[tc] * egL + acc;
            }
        }
        __syncthreads();
#pragma unroll
        for (int tc = 0; tc < 4; ++tc) *(uint2*)(lds + G_ST + (16 * tc + fr) * S272 + (16 * w + 4 * fq) * 2) = pk4(Sreg[tc]);
        {
            const int i = t >> 3, part = t & 7;
            const size_t R = (size_t)(b * TT + scan_token(dir, 64 * n + i));
            *(uint4*)(O + R * 512 + h * 128 + 64 * hf + part * 8) = *(const uint4*)(lds + G_UT + i * S144 + part * 16);
        }
    }
    __syncthreads();
}


constexpr int R_KKT = 0;
constexpr int R_KHAT = R_KKT + 64 * S144;
constexpr int R_BHAT = R_KHAT + 64 * S144;
constexpr int R_RT = R_BHAT + 64 * S144;
constexpr int R_KBT = R_RT + 64 * S144;
constexpr int R_BBT = R_KBT + 64 * S144;
constexpr int R_VT = R_BBT + 64 * S144;
constexpr int R_AKK = R_VT + 64 * S144;
constexpr int R_ARK = R_AKK + 64 * S144;
constexpr int R_ARB = R_ARK + 64 * S144;
constexpr int R_M = R_ARB + 64 * S144;
constexpr int R_TT = R_M + 64 * S144;
constexpr int R_RHS = R_TT + 64 * S144;
constexpr int R_PT = R_RHS + 64 * S144;
constexpr int R_OT = R_PT + 64 * S144;
constexpr int R_LAML = R_OT + 64 * S144;
constexpr int R_END = R_LAML + 256;
static_assert(R_END <= LDS_MAIN, "RWKV chunk LDS map too large");

__device__ __forceinline__ void unpack8f(const uint4 v, float (&f)[8]) { unpack8(v, f); }

__device__ __forceinline__ void rwkv_chunk_unit(const Params& p, int sr, char* lds) {
    const int b = sr >> 4, h = (sr >> 1) & 7, dir = sr & 1;
    const bf16_t* EW = (const bf16_t*)(p.ws + B_EW) + (size_t)dir * NTOK * 512;
    const bf16_t* KD = (const bf16_t*)(p.ws + B_KD) + (size_t)dir * NTOK * 512;
    const bf16_t* BD = (const bf16_t*)(p.ws + B_BD) + (size_t)dir * NTOK * 512;
    const bf16_t* RR = (const bf16_t*)(p.ws + B_RR); const bf16_t* KK = (const bf16_t*)(p.ws + B_KK); const bf16_t* VV = (const bf16_t*)(p.ws + B_VV);
    const bf16_t* RM = (const bf16_t*)(p.ws + C_RM) + (size_t)sr * 36 * 4096;
    bf16_t* Y = (bf16_t*)(p.ws + (dir == 0 ? B_YF : B_YB));
    float* LAML = (float*)(lds + R_LAML);
    const int t = threadIdx.x, lane = t & 63, w = t >> 6, fr = lane & 15, fq = lane >> 4;
    for (int i = t; i < 3 * 64 * S144 / 16; i += NTHR) ((uint4*)(lds + R_AKK))[i] = make_uint4(0u, 0u, 0u, 0u);
    for (int i = t; i < 64 * S144 / 16; i += NTHR) ((uint4*)(lds + R_TT))[i] = make_uint4(0u, 0u, 0u, 0u);
    f32x4 Treg[2];
    Treg[0] = (f32x4){0.f, 0.f, 0.f, 0.f}; Treg[1] = Treg[0];
    const int ti = w >> 1;
    uint4 prr, pew, pkd, pvv, pkk, pbd, pmq;
    {
        const size_t o = (size_t)(b * TT + scan_token(dir, lane)) * 512 + h * 64 + w * 8;
        prr = *(const uint4*)(RR + o); pew = *(const uint4*)(EW + o); pkd = *(const uint4*)(KD + o);
        pvv = *(const uint4*)(VV + o); pkk = *(const uint4*)(KK + o); pbd = *(const uint4*)(BD + o);
        pmq = *(const uint4*)(RM + t * 8);
    }
    __syncthreads();
    for (int n = 0; n < TT / 64; ++n) {
        {
            const int i = lane, part = w;
            float rr[8], ew[8], kd[8], vv[8], kk[8], bd[8];
            PIN4(prr); PIN4(pew); PIN4(pkd); PIN4(pvv); PIN4(pkk); PIN4(pbd); PIN4(pmq);
            unpack8(prr, rr); unpack8(pew, ew); unpack8(pkd, kd); unpack8(pvv, vv); unpack8(pkk, kk); unpack8(pbd, bd);
            const uint4 mq = pmq;
            if (n + 1 < TT / 64) {
                const size_t o = (size_t)(b * TT + scan_token(dir, 64 * (n + 1) + i)) * 512 + h * 64 + part * 8;
                prr = *(const uint4*)(RR + o); pew = *(const uint4*)(EW + o); pkd = *(const uint4*)(KD + o);
                pvv = *(const uint4*)(VV + o); pkk = *(const uint4*)(KK + o); pbd = *(const uint4*)(BD + o);
                pmq = *(const uint4*)(RM + (size_t)(n + 1) * 4096 + t * 8);
            }
            *(uint4*)(lds + R_M + (t >> 3) * S144 + (t & 7) * 16) = mq;
            float o_kkt[8], o_khat[8], o_bhat[8], o_rt[8];
#pragma unroll
            for (int e = 0; e < 8; ++e) {
                const float lam = -wave_incl_scan(ew[e], lane);
                const float el = __expf(lam), eml = __builtin_amdgcn_rcpf(el);
                const float lamL = lane63(lam), edl = lane63(el) * eml;
                o_kkt[e] = kk[e] * (el * __expf(ew[e]));
                o_khat[e] = kd[e] * eml; o_bhat[e] = bd[e] * eml; o_rt[e] = rr[e] * el;
                const int c = part * 8 + e;
                *(bf16_t*)(lds + R_KBT + c * S144 + i * 2) = f2bf(kd[e] * edl);
                *(bf16_t*)(lds + R_BBT + c * S144 + i * 2) = f2bf(-(bd[e] * edl));
                *(bf16_t*)(lds + R_VT + c * S144 + i * 2) = f2bf(vv[e]);
                if (lane == 0) LAML[c] = lamL;
            }
            uint4 q;
            q.x = pack2(o_kkt[0], o_kkt[1]); q.y = pack2(o_kkt[2], o_kkt[3]); q.z = pack2(o_kkt[4], o_kkt[5]); q.w = pack2(o_kkt[6], o_kkt[7]);
            *(uint4*)(lds + R_KKT + i * S144 + part * 16) = q;
            q.x = pack2(o_khat[0], o_khat[1]); q.y = pack2(o_khat[2], o_khat[3]); q.z = pack2(o_khat[4], o_khat[5]); q.w = pack2(o_khat[6], o_khat[7]);
            *(uint4*)(lds + R_KHAT + i * S144 + part * 16) = q;
            q.x = pack2(o_bhat[0], o_bhat[1]); q.y = pack2(o_bhat[2], o_bhat[3]); q.z = pack2(o_bhat[4], o_bhat[5]); q.w = pack2(o_bhat[6], o_bhat[7]);
            *(uint4*)(lds + R_BHAT + i * S144 + part * 16) = q;
            q.x = pack2(o_rt[0], o_rt[1]); q.y = pack2(o_rt[2], o_rt[3]); q.z = pack2(o_rt[4], o_rt[5]); q.w = pack2(o_rt[6], o_rt[7]);
            *(uint4*)(lds + R_RT + i * S144 + part * 16) = q;
        }
        __syncthreads();
#pragma unroll
        for (int rep = 0; rep < 4; ++rep) {
            const int item = w + 8 * rep;
            if (item < 30) {
                const int idx = item / 3, mtx = item - 3 * idx;
                const int ta = idx >= 6 ? 3 : (idx >= 3 ? 2 : (idx >= 1 ? 1 : 0));
                const int tb = idx - ta * (ta + 1) / 2;
                f32x4 acc = (f32x4){0.f, 0.f, 0.f, 0.f};
                const char* xp = lds + (mtx == 0 ? R_KKT : R_RT) + (16 * ta + fr) * S144 + fq * 16;
                const char* yp = lds + (mtx == 2 ? R_BHAT : R_KHAT) + (16 * tb + fr) * S144 + fq * 16;
                mm_nt<64>(acc, xp, yp);
                char* dst = lds + (mtx == 0 ? R_AKK : (mtx == 1 ? R_ARK : R_ARB));
                const float sgn = mtx == 2 ? -1.f : 1.f;
                const int j = 16 * tb + fr;
#pragma unroll
                for (int r = 0; r < 4; ++r) {
                    const int i = 16 * ta + 4 * fq + r;
                    const bool keep = mtx == 0 ? (i > j) : (i >= j);
                    *(bf16_t*)(dst + i * S144 + j * 2) = f2bf(keep ? sgn * acc[r] : 0.f);
                }
            }
        }
        __syncthreads();
        f32x4 arkv[2], kbv[2];
#pragma unroll
        for (int c = 0; c < 2; ++c) {
            const int tv = 2 * (w & 1) + c;
            const char* yv = lds + R_VT + (16 * tv + fr) * S144 + fq * 16;
            f32x4 rhs = (f32x4){0.f, 0.f, 0.f, 0.f};
            arkv[c] = rhs; kbv[c] = rhs;
            mm_nt<64>(rhs, lds + R_AKK + (16 * ti + fr) * S144 + fq * 16, yv);
            mm_nt<64>(arkv[c], lds + R_ARK + (16 * ti + fr) * S144 + fq * 16, yv);
            mm_nt<64>(kbv[c], lds + R_KBT + (16 * ti + fr) * S144 + fq * 16, yv);
            mm_nt<64>(rhs, lds + R_KKT + (16 * ti + fr) * S144 + fq * 16, lds + R_TT + (16 * tv + fr) * S144 + fq * 16);
            *(uint2*)(lds + R_RHS + (16 * tv + fr) * S144 + (16 * ti + 4 * fq) * 2) = pk4(rhs);
        }
        __syncthreads();
#pragma unroll
        for (int c = 0; c < 2; ++c) {
            const int tv = 2 * (w & 1) + c;
            f32x4 pacc = (f32x4){0.f, 0.f, 0.f, 0.f};
            mm_nt<64>(pacc, lds + R_M + (16 * ti + fr) * S144 + fq * 16, lds + R_RHS + (16 * tv + fr) * S144 + fq * 16);
            *(uint2*)(lds + R_PT + (16 * tv + fr) * S144 + (16 * ti + 4 * fq) * 2) = pk4(pacc);
        }
        __syncthreads();
#pragma unroll
        for (int c = 0; c < 2; ++c) {
            const int tv = 2 * (w & 1) + c;
            const char* yt = lds + R_TT + (16 * tv + fr) * S144 + fq * 16;
            const char* yp = lds + R_PT + (16 * tv + fr) * S144 + fq * 16;
            f32x4 yacc = arkv[c];
            mm_nt<64>(yacc, lds + R_RT + (16 * ti + fr) * S144 + fq * 16, yt);
            mm_nt<64>(yacc, lds + R_ARB + (16 * ti + fr) * S144 + fq * 16, yp);
            const int i0 = 16 * ti + 4 * fq, val = 16 * tv + fr;
#pragma unroll
            for (int r = 0; r < 4; ++r) *(bf16_t*)(lds + R_OT + (i0 + r) * S144 + val * 2) = f2bf(yacc[r]);
            f32x4 tacc = kbv[c];
            mm_nt<64>(tacc, lds + R_BBT + (16 * ti + fr) * S144 + fq * 16, yp);
            const f32x4 dl = (f32x4){expf(LAML[i0]), expf(LAML[i0 + 1]), expf(LAML[i0 + 2]), expf(LAML[i0 + 3])};
            Treg[c] = Treg[c] * dl + tacc;
        }
        __syncthreads();
#pragma unroll
        for (int c = 0; c < 2; ++c) {
            const int tv = 2 * (w & 1) + c;
            *(uint2*)(lds + R_TT + (16 * tv + fr) * S144 + (16 * ti + 4 * fq) * 2) = pk4(Treg[c]);
        }
        {
            const int i = t >> 3, part = t & 7;
            const size_t R = (size_t)(b * TT + scan_token(dir, 64 * n + i));
            *(uint4*)(Y + R * 512 + h * 64 + part * 8) = *(const uint4*)(lds + R_OT + i * S144 + part * 16);
        }
    }
    __syncthreads();
}

__device__ __forceinline__ void phase4(const Params& p, char* lds, const XcdBarrier& xb) {
    phase4a(p, lds);
    xcd_barrier(xb);
    for (int u = blockIdx.x; u < 256; u += gridDim.x) {
        if (u < 128) gdn_chunk_unit(p, u, lds);
        else rwkv_chunk_unit(p, u - 128, lds);
    }
}

__device__ __forceinline__ void phase5(const Params& p, char* lds) {
    const int lane = threadIdx.x & 63, wg = blockIdx.x * 8 + (threadIdx.x >> 6), nw = gridDim.x * 8;
    const bf16_t* YF = (const bf16_t*)(p.ws + B_YF); const bf16_t* YB = (const bf16_t*)(p.ws + B_YB);
    const bf16_t* OF = (const bf16_t*)(p.ws + B_OF); const bf16_t* OB = (const bf16_t*)(p.ws + B_OB);
    const bf16_t* VV = (const bf16_t*)(p.ws + B_VV); const bf16_t* GG = (const bf16_t*)(p.ws + B_GG);
    const float* BC = (const float*)(p.ws + B_BC);
    const bf16_t* ZZ = (const bf16_t*)(p.ws + B_ZZ);
    bf16_t* MO = (bf16_t*)(p.ws + OFF_H);
    uint4 nA, nB, nV, nG, nOF, nOB, nZ; float nbc = 0.f;
    auto fetch = [&](int R) {
        const int c8 = lane * 8;
        nA = *(const uint4*)(YF + (size_t)R * 512 + c8); nB = *(const uint4*)(YB + (size_t)R * 512 + c8);
        nV = *(const uint4*)(VV + (size_t)R * 512 + c8); nG = *(const uint4*)(GG + (size_t)R * 512 + c8);
        nOF = *(const uint4*)(OF + (size_t)R * 512 + c8); nOB = *(const uint4*)(OB + (size_t)R * 512 + c8);
        nZ = *(const uint4*)(ZZ + (size_t)R * 512 + c8); nbc = BC[(size_t)R * 8 + (lane >> 3)];
    };
    if (wg < NTOK) fetch(wg);
    for (int R = wg; R < NTOK; R += nw) {
        const int c8 = lane * 8;
        const uint4 cA = nA, cB = nB, cV = nV, cG = nG, cOF = nOF, cOB = nOB, cZ = nZ; const float cbc = nbc;
        if (R + nw < NTOK) fetch(R + nw);
        {
            const uint4 a = cA, bq = cB, vq = cV, gq = cG;
            const unsigned au[4] = {a.x, a.y, a.z, a.w}, bu[4] = {bq.x, bq.y, bq.z, bq.w}, vu[4] = {vq.x, vq.y, vq.z, vq.w}, gu[4] = {gq.x, gq.y, gq.z, gq.w};
            float y[8], vv[8], gg[8];
#pragma unroll
            for (int j = 0; j < 4; ++j) {
                y[2 * j] = bf2f((bf16_t)(au[j] & 0xffff)) + bf2f((bf16_t)(bu[j] & 0xffff));
                y[2 * j + 1] = bf2f((bf16_t)(au[j] >> 16)) + bf2f((bf16_t)(bu[j] >> 16));
                vv[2 * j] = bf2f((bf16_t)(vu[j] & 0xffff)); vv[2 * j + 1] = bf2f((bf16_t)(vu[j] >> 16));
                gg[2 * j] = bf2f((bf16_t)(gu[j] & 0xffff)); gg[2 * j + 1] = bf2f((bf16_t)(gu[j] >> 16));
            }
            float sm = 0.f;
#pragma unroll
            for (int j = 0; j < 8; ++j) sm += y[j];
            sm += __shfl_xor(sm, 1); sm += __shfl_xor(sm, 2); sm += __shfl_xor(sm, 4);
            const float mean = sm * (1.f / 64.f);
            float sv = 0.f;
#pragma unroll
            for (int j = 0; j < 8; ++j) { const float d = y[j] - mean; sv += d * d; }
            sv += __shfl_xor(sv, 1); sv += __shfl_xor(sv, 2); sv += __shfl_xor(sv, 4);
            const float rstd = rsqrtf(sv * (1.f / 64.f) + 64e-5f);
            const float bc = cbc;
            float o[8];
#pragma unroll
            for (int j = 0; j < 8; ++j) {
                const float yn = (y[j] - mean) * rstd * p.in[19][c8 + j] + p.in[20][c8 + j];
                o[j] = (yn + bc * vv[j]) * gg[j];
            }
            uint4 ov; ov.x = pack2(o[0], o[1]); ov.y = pack2(o[2], o[3]); ov.z = pack2(o[4], o[5]); ov.w = pack2(o[6], o[7]);
            *(uint4*)(MO + (size_t)R * DM + c8) = ov;
        }
        {
            const uint4 a = cOF, bq = cOB;
            const uint4 zq = cZ;
            const unsigned au[4] = {a.x, a.y, a.z, a.w}, bu[4] = {bq.x, bq.y, bq.z, bq.w}, zu[4] = {zq.x, zq.y, zq.z, zq.w};
            float o[8], z[8];
#pragma unroll
            for (int j = 0; j < 4; ++j) {
                o[2 * j] = bf2f((bf16_t)(au[j] & 0xffff)) + bf2f((bf16_t)(bu[j] & 0xffff));
                o[2 * j + 1] = bf2f((bf16_t)(au[j] >> 16)) + bf2f((bf16_t)(bu[j] >> 16));
                z[2 * j] = bf2f((bf16_t)(zu[j] & 0xffff)); z[2 * j + 1] = bf2f((bf16_t)(zu[j] >> 16));
            }
            float ss = 0.f;
#pragma unroll
            for (int j = 0; j < 8; ++j) ss += o[j] * o[j];
            ss += __shfl_xor(ss, 1); ss += __shfl_xor(ss, 2); ss += __shfl_xor(ss, 4); ss += __shfl_xor(ss, 8);
            const float rs = rsqrtf(ss * (1.f / 128.f) + 1e-6f);
            float r[8];
#pragma unroll
            for (int j = 0; j < 8; ++j) r[j] = o[j] * rs * p.in[24][(c8 + j) & 127] * siluf(z[j]);
            uint4 ov; ov.x = pack2(r[0], r[1]); ov.y = pack2(r[2], r[3]); ov.z = pack2(r[4], r[5]); ov.w = pack2(r[6], r[7]);
            *(uint4*)(MO + (size_t)R * DM + 512 + c8) = ov;
        }
    }
}

struct SchedOut {
    const char* A; const char* W; int nM;
    __device__ __forceinline__ bool next(int i, g8::Unit& u) const {
        int pm, pn; if (!g8::grid_order(i, nM, 4, pm, pn)) return false;
        u.pm = pm; u.pn = pn; u.e = 0; u.half = 0; u.mh = 0; u.nh = 0;
        u.a0 = A + (size_t)pm * 256 * DM * 2; u.a1 = u.a0 + (size_t)128 * DM * 2;
        u.b0 = W + (size_t)pn * 256 * DM * 2; u.b1 = u.b0 + (size_t)128 * DM * 2;
        return true;
    }
    __device__ __forceinline__ unsigned aoff(const g8::Unit&, int, int, int) const { return 0u; }
    __device__ __forceinline__ int araw(const g8::Unit&, int, int) const { return 0; }
    __device__ __forceinline__ unsigned afrom(int, int) const { return 0u; }
};
struct EpiOut {
    static constexpr bool PERM = false;
    const Params* p; int layer;
    __device__ __forceinline__ void operator()(const f32x4 (&acc)[2][2][4][2], const g8::Unit& u, int wr, int wc, int fr, int fq) const {
        const int row0 = u.pm * 256;
        const int mr = layer == 0 ? mod_row(row0) : row0 / SEQ;
        const float* gate = mod_ptr(*p, layer, mr, 2) + u.pn * 256 + wc * 32 + 4 * fq;
        f32x4 gv[2][2];
#pragma unroll
        for (int bj = 0; bj < 2; ++bj)
#pragma unroll
            for (int n = 0; n < 2; ++n) gv[bj][n] = *(const f32x4*)(gate + bj * 128 + n * 16);
#pragma unroll
        for (int ai = 0; ai < 2; ++ai) {
            f32x4 xv[4][2][2];
            const float* srcp[4]; float* dstp[4];
#pragma unroll
            for (int m = 0; m < 4; ++m) {
                const int row = row0 + ai * 128 + wr * 64 + m * 16 + fr;
                if (layer == 0) { srcp[m] = xin_row(*p, row); dstp[m] = xs_row(*p, row); }
                else { dstp[m] = p->out + (size_t)row * DM; srcp[m] = dstp[m]; }
                srcp[m] += u.pn * 256 + wc * 32 + 4 * fq; dstp[m] += u.pn * 256 + wc * 32 + 4 * fq;
#pragma unroll
                for (int bj = 0; bj < 2; ++bj)
#pragma unroll
                    for (int n = 0; n < 2; ++n) xv[m][bj][n] = *(const f32x4*)(srcp[m] + bj * 128 + n * 16);
            }
#pragma unroll
            for (int m = 0; m < 4; ++m)
#pragma unroll
                for (int bj = 0; bj < 2; ++bj)
#pragma unroll
                    for (int n = 0; n < 2; ++n) *(f32x4*)(dstp[m] + bj * 128 + n * 16) = xv[m][bj][n] + gv[bj][n] * acc[ai][bj][m][n];
        }
    }
};
__device__ __forceinline__ void phase_outproj(const Params& p, int layer, char* lds) {
    SchedOut S{p.ws + (layer == 0 ? OFF_H : L_AO), p.ws + (layer == 0 ? OFF_WOUT0 : OFF_WOUT1), layer == 0 ? NTOK / 256 : NB * SEQ / 256};
    EpiOut E{&p, layer};
    g8::gemm_phase<false>((LAS unsigned char*)lds, DM, S, E);
    if (layer == 0) { const int nb = (int)gridDim.x; if (nb > 64) convert_moe(p, 0, lds, 32, nb - 32); else convert_moe(p, 0, lds, 0, nb); }
}

__device__ __forceinline__ void phase_ffn_norm(const Params& p, int layer, char* lds) {
    const int lane = threadIdx.x & 63, wg = blockIdx.x * 8 + (threadIdx.x >> 6), nw = gridDim.x * 8;
    bf16_t* H = (bf16_t*)(p.ws + OFF_H);
    float* AFF = (float*)(p.ws + M_AFF);
    const float* router = p.in[28] + (size_t)layer * 1024 * 16;
    float* rt = (float*)lds;
    for (int i = threadIdx.x; i < 16384; i += NTHR) rt[(i & 15) * 1024 + (i >> 4)] = router[i];
    __syncthreads();
    const int nrow = layer == 0 ? NTOK : NB * SEQ;
    auto rowof = [&](int q) { return layer == 0 ? q : (q / SEQ) * TT + LC + (q % SEQ); };
    f32x4 xn[4];
    if (wg < nrow) load_row(xs_row(p, rowof(wg)), lane, xn);
    for (int q = wg; q < nrow; q += nw) {
        const int R = rowof(q);
        f32x4 x[4], h[4];
#pragma unroll
        for (int i = 0; i < 4; ++i) x[i] = xn[i];
        if (q + nw < nrow) load_row(xs_row(p, rowof(q + nw)), lane, xn);
        const int mr = mod_row(R);
        norm_mod(x, p.in[7] + layer * 1024, mod_ptr(p, layer, mr, 3), mod_ptr(p, layer, mr, 4), lane, h);
        store_h(H + (size_t)R * DM, lane, h);
        router_row(h, rt, lane, AFF + (size_t)R * 16);
    }
    __syncthreads();
}

__device__ __forceinline__ void phase_topk(const Params& p, int layer, char* lds) {
    const float* AFF = (const float*)(p.ws + M_AFF);
    int* SEL = (int*)(p.ws + M_SEL); int* IDX = (int*)(p.ws + M_IDX); float* GATE = (float*)(p.ws + M_GATE);
    int* hist = (int*)lds;
    int* wtot = hist + 256;
    int* res = wtot + 16;
    const int t = threadIdx.x, lane = t & 63, w = t >> 6;
    const int nunit = layer == 0 ? 256 : 128;
    const int SLOTS = layer == 0 ? 288 : 256, SL = NB * SLOTS;
    for (int u = blockIdx.x; u < nunit; u += gridDim.x) {
        const int isctx = (u >= 128) ? 1 : 0;
        const int b = (u & 127) >> 4, e = u & 15;
        const int n = isctx ? LC : SEQ, cap = n >> 3;
        const int Rbase = b * TT + (isctx ? 0 : LC);
        const int off = (layer == 0 && !isctx) ? 32 : 0;
        unsigned key[4]; float val[4];
        const bool own = 4 * t < n;
#pragma unroll
        for (int q = 0; q < 4; ++q) { val[q] = own ? AFF[(size_t)(Rbase + 4 * t + q) * 16 + e] : 0.f; key[q] = __float_as_uint(val[q]); }
        unsigned prefix = 0u; int remaining = cap;
#pragma unroll 1
        for (int pass = 3; pass >= 0; --pass) {
            if (t < 256) hist[t] = 0;
            __syncthreads();
            if (own) {
#pragma unroll
                for (int q = 0; q < 4; ++q)
                    if (pass == 3 || (key[q] >> (8 * (pass + 1))) == prefix) atomicAdd(&hist[(key[q] >> (8 * pass)) & 255u], 1);
            }
            __syncthreads();
            if (w == 0) {
                const int g = 63 - lane;
                const int h0 = hist[4 * g], h1 = hist[4 * g + 1], h2 = hist[4 * g + 2], h3 = hist[4 * g + 3];
                const int v = h0 + h1 + h2 + h3;
                const int incl = (int)wave_incl_scan((float)v, lane);
                const int excl = incl - v;
                if (excl < remaining && remaining <= incl) {
                    int above = excl, bin;
                    if (above + h3 >= remaining) bin = 4 * g + 3;
                    else { above += h3; if (above + h2 >= remaining) bin = 4 * g + 2; else { above += h2; if (above + h1 >= remaining) bin = 4 * g + 1; else { above += h1; bin = 4 * g; } } }
                    res[0] = bin; res[1] = above;
                }
            }
            __syncthreads();
            prefix = (prefix << 8) | (unsigned)res[0];
            remaining -= res[1];
            __syncthreads();
        }
        int cg = 0, ce = 0;
#pragma unroll
        for (int q = 0; q < 4; ++q) { cg += (own && key[q] > prefix) ? 1 : 0; ce += (own && key[q] == prefix) ? 1 : 0; }
        const int ig = (int)wave_incl_scan((float)cg, lane), ie = (int)wave_incl_scan((float)ce, lane);
        if (lane == 63) { wtot[w] = ig; wtot[8 + w] = ie; }
        __syncthreads();
        int bg = ig - cg, be = ie - ce;
        for (int w2 = 0; w2 < w; ++w2) { bg += wtot[w2]; be += wtot[8 + w2]; }
        if (own) {
#pragma unroll
            for (int q = 0; q < 4; ++q) {
                const int R = Rbase + 4 * t + q;
                const bool gt = key[q] > prefix, eq = key[q] == prefix;
                const bool sel = gt || (eq && be < remaining);
                if (sel) {
                    const int slot = b * SLOTS + off + bg + (be < remaining ? be : remaining);
                    IDX[e * SL + slot] = R; GATE[e * SL + slot] = val[q]; SEL[(size_t)R * 16 + e] = slot;
                } else SEL[(size_t)R * 16 + e] = -1;
                bg += gt ? 1 : 0; be += eq ? 1 : 0;
            }
        }
        __syncthreads();
    }
}

struct SchedMoe1 {
    const char* H; const char* W1; const char* W3; const int* IDX; int SL, npm;
    __device__ __forceinline__ bool next(int i, g8::Unit& u) const {
        const int Q = 16 * npm;
        int q, pn, sub = 0, pieces = 1;
        if (gridDim.x == 256 && (Q & 15) == 0) {
            const int xcd = blockIdx.x & 7, j = blockIdx.x >> 3, R = Q / 32;
            if (i < R) { q = i * 32 + xcd * 4 + (j >> 3); pn = j & 7; }
            else if (i == R && Q - R * 32 == 16) { q = R * 32 + xcd * 2 + (j >> 4); pn = (j >> 1) & 7; sub = j & 1; pieces = 2; }
            else return false;
        } else {
            int L; if (!g8::tail_split(i, Q * 8, 2, L, sub, pieces)) return false;
            q = L >> 3; pn = L & 7;
        }
        const int e = q / npm;
        u.e = e; u.pm = q - e * npm; u.pn = pn; u.mh = sub; u.nh = 0; u.half = pieces == 2 ? 2 : 0;
        u.a0 = H; u.a1 = H;
        u.b0 = W1 + ((size_t)e * 1024 + u.pn * 128) * DM * 2; u.b1 = W3 + ((size_t)e * 1024 + u.pn * 128) * DM * 2;
        return true;
    }
    __device__ __forceinline__ unsigned aoff(const g8::Unit& u, int h, int R, int C) const {
        return (unsigned)(IDX[u.e * SL + u.pm * 256 + (h + u.mh) * 128 + R] * DM + C) * 2u;
    }
    __device__ __forceinline__ int araw(const g8::Unit& u, int h, int R) const { return IDX[u.e * SL + u.pm * 256 + (h + u.mh) * 128 + R]; }
    __device__ __forceinline__ unsigned afrom(int raw, int C) const { return (unsigned)(raw * DM + C) * 2u; }
};
struct EpiMoe1 {
    static constexpr bool PERM = true;
    bf16_t* HID; int SL;
    __device__ __forceinline__ void operator()(const f32x4 (&acc)[2][2][4][2], const g8::Unit& u, int wr, int wc, int fr, int fq) const {
#pragma unroll
        for (int ai = 0; ai < 2; ++ai)
#pragma unroll
            for (int m = 0; m < 4; ++m) {
                const int row = u.e * SL + u.pm * 256 + (ai + u.mh) * 128 + wr * 64 + m * 16 + fr;
                const int f = u.pn * 128 + wc * 32 + 8 * fq;
                if (ai == 1 && (u.half & 2)) continue;
                uint2 t[2];
#pragma unroll
                for (int n = 0; n < 2; ++n) {
                    const f32x4 a = acc[ai][0][m][n], g = acc[ai][1][m][n];
                    t[n] = pk4((f32x4){siluf(a[0]) * g[0], siluf(a[1]) * g[1], siluf(a[2]) * g[2], siluf(a[3]) * g[3]});
                }
                *(uint4*)(HID + (size_t)row * 1024 + f) = make_uint4(t[0].x, t[0].y, t[1].x, t[1].y);
            }
    }
};
__device__ __forceinline__ void phase_moe1(const Params& p, int layer, char* lds) {
    const int SL = layer == 0 ? 2304 : 2048;
    SchedMoe1 S{p.ws + OFF_H, p.ws + M_W, p.ws + M_W + 16ull * 1024 * 1024 * 2, (const int*)(p.ws + M_IDX), SL, SL / 256};
    EpiMoe1 E{(bf16_t*)(p.ws + M_HID), SL};
    g8::gemm_phase<true>((LAS unsigned char*)lds, DM, S, E);
}

struct SchedMoe2 {
    const char* HID; const char* W2; int SL, npm;
    __device__ __forceinline__ bool next(int i, g8::Unit& u) const {
        const int Q = 16 * npm;
        int q, pn, sub = 0, pieces = 1;
        if (gridDim.x == 256 && (Q & 15) == 0) {
            const int xcd = blockIdx.x & 7, j = blockIdx.x >> 3, R = Q / 64;
            if (i < R) { q = i * 64 + xcd * 8 + (j >> 2); pn = j & 3; }
            else if (i == R && Q - R * 64 == 16) { q = R * 64 + xcd * 2 + (j >> 4); pn = (j >> 2) & 3; sub = j & 3; pieces = 4; }
            else return false;
        } else {
            int L; if (!g8::tail_split(i, Q * 4, 4, L, sub, pieces)) return false;
            q = L >> 2; pn = L & 3;
        }
        const int e = q / npm;
        u.e = e; u.pm = q - e * npm; u.pn = pn;
        u.half = pieces == 4 ? 3 : pieces == 2 ? 1 : 0; u.nh = sub & 1; u.mh = pieces == 4 ? (sub >> 1) : 0;
        u.a0 = HID + ((size_t)e * SL + u.pm * 256 + u.mh * 128) * 1024 * 2; u.a1 = (u.half & 2) ? u.a0 : u.a0 + (size_t)128 * 1024 * 2;
        u.b0 = W2 + ((size_t)e * 1024 + u.pn * 256 + u.nh * 128) * 1024 * 2; u.b1 = (u.half & 1) ? u.b0 : u.b0 + (size_t)128 * 1024 * 2;
        return true;
    }
    __device__ __forceinline__ unsigned aoff(const g8::Unit&, int, int, int) const { return 0u; }
    __device__ __forceinline__ int araw(const g8::Unit&, int, int) const { return 0; }
    __device__ __forceinline__ unsigned afrom(int, int) const { return 0u; }
};
struct EpiMoe2 {
    static constexpr bool PERM = true;
    bf16_t* YE; const float* GATE; int SL;
    __device__ __forceinline__ void operator()(const f32x4 (&acc)[2][2][4][2], const g8::Unit& u, int wr, int wc, int fr, int fq) const {
#pragma unroll
        for (int ai = 0; ai < 2; ++ai)
#pragma unroll
            for (int m = 0; m < 4; ++m) {
                const int row = u.e * SL + u.pm * 256 + (ai + u.mh) * 128 + wr * 64 + m * 16 + fr;
                if (ai == 1 && (u.half & 2)) continue;
                const float g = GATE[row];
#pragma unroll
                for (int bj = 0; bj < 2; ++bj) {
                    const int col = u.pn * 256 + (bj + u.nh) * 128 + wc * 32 + 8 * fq;
                    if (bj == 1 && (u.half & 1)) continue;
                    const uint2 t0 = pk4(acc[ai][bj][m][0] * g), t1 = pk4(acc[ai][bj][m][1] * g);
                    *(uint4*)(YE + (size_t)row * 1024 + col) = make_uint4(t0.x, t0.y, t1.x, t1.y);
                }
            }
    }
};
__device__ __forceinline__ void phase_moe2(const Params& p, int layer, char* lds) {
    const int SL = layer == 0 ? 2304 : 2048;
    SchedMoe2 S{p.ws + M_HID, p.ws + M_W + 32ull * 1024 * 1024 * 2, SL, SL / 256};
    EpiMoe2 E{(bf16_t*)(p.ws + M_YE), (const float*)(p.ws + M_GATE), SL};
    g8::gemm_phase<false>((LAS unsigned char*)lds, 1024, S, E);
}

__device__ __forceinline__ void phase_combine(const Params& p, int layer, char* lds) {
    const int lane = threadIdx.x & 63, wg = blockIdx.x * 8 + (threadIdx.x >> 6), nw = gridDim.x * 8;
    const int* SEL = (const int*)(p.ws + M_SEL);
    const bf16_t* YE = (const bf16_t*)(p.ws + M_YE);
    bf16_t* H = (bf16_t*)(p.ws + OFF_H);
    const int SL = layer == 0 ? 2304 : 2048;
    const int nrow = layer == 0 ? NTOK : NB * SEQ;
    auto rowof = [&](int q) { return layer == 0 ? q : (q / SEQ) * TT + LC + (q % SEQ); };
    f32x4 xn[4]; int seln = -1;
    if (wg < nrow) { const int R0 = rowof(wg); load_row(xs_row(p, R0), lane, xn); seln = SEL[(size_t)R0 * 16 + (lane & 15)]; }
    for (int q = wg; q < nrow; q += nw) {
        const int R = rowof(q);
        float* xr = xs_row(p, R);
        f32x4 x[4], sum[4];
#pragma unroll
        for (int i = 0; i < 4; ++i) { x[i] = xn[i]; sum[i] = (f32x4){0.f, 0.f, 0.f, 0.f}; }
        const int selv = seln;
        if (q + nw < nrow) { const int Rn = rowof(q + nw); load_row(xs_row(p, Rn), lane, xn); seln = SEL[(size_t)Rn * 16 + (lane & 15)]; }
        unsigned mask = (unsigned)(__ballot(selv >= 0) & 0xFFFFull);
        while (mask) {
            const bf16_t* yr[4]; float wgt[4];
#pragma unroll
            for (int j = 0; j < 4; ++j) {
                const bool on = mask != 0u;
                const int e = on ? __builtin_ctz(mask) : 0;
                const int sl = __builtin_amdgcn_readlane(selv, e);
                mask = on ? (mask & (mask - 1u)) : 0u;
                yr[j] = YE + ((size_t)(on ? e : 0) * SL + (on ? sl : 0)) * 1024;
                wgt[j] = on ? 1.f : 0.f;
            }
            f32x4 v[4][4];
#pragma unroll
            for (int j = 0; j < 4; ++j)
#pragma unroll
                for (int i = 0; i < 4; ++i) v[j][i] = ld_bf4(yr[j] + 4 * lane + 256 * i);
#pragma unroll
            for (int j = 0; j < 4; ++j)
#pragma unroll
                for (int i = 0; i < 4; ++i) sum[i] += v[j][i] * wgt[j];
        }
        const int mr = mod_row(R);
        const float* g5 = mod_ptr(p, layer, mr, 5);
#pragma unroll
        for (int i = 0; i < 4; ++i) x[i] += *(const f32x4*)(g5 + 4 * lane + 256 * i) * sum[i];
        if (layer == 0) {
#pragma unroll
            for (int i = 0; i < 4; ++i) *(f32x4*)(xr + 4 * lane + 256 * i) = x[i];
            f32x4 h[4];
            norm_mod(x, p.in[6] + 1024, mod_ptr(p, 1, mr, 0), mod_ptr(p, 1, mr, 1), lane, h);
            store_h(H + (size_t)R * DM, lane, h);
        } else {
            const float rs = row_rs(x);
#pragma unroll
            for (int i = 0; i < 4; ++i) *(f32x4*)(xr + 4 * lane + 256 * i) = x[i] * rs * *(const f32x4*)(p.in[32] + 4 * lane + 256 * i);
        }
    }
}

struct SchedIn1 {
    const char* H; const char* W;
    __device__ __forceinline__ bool next(int i, g8::Unit& u) const {
        const long L = (long)i * gridDim.x + blockIdx.x; if (L >= 400) return false;
        int pm, pn;
        if (L < 384) { const int pl = (int)L / 6; pn = (int)L % 6; pm = (pl >> 3) * 9 + 1 + (pl & 7); }
        else { const int v = (int)L - 384; pm = (v >> 1) * 9; pn = 4 + (v & 1); }
        u.pm = pm; u.pn = pn; u.e = 0; u.half = 0; u.mh = 0; u.nh = 0;
        u.a0 = H + (size_t)pm * 256 * DM * 2; u.a1 = u.a0 + (size_t)128 * DM * 2;
        u.b0 = W + (size_t)pn * 256 * DM * 2; u.b1 = u.b0 + (size_t)128 * DM * 2;
        return true;
    }
    __device__ __forceinline__ unsigned aoff(const g8::Unit&, int, int, int) const { return 0u; }
    __device__ __forceinline__ int araw(const g8::Unit&, int, int) const { return 0; }
    __device__ __forceinline__ unsigned afrom(int, int) const { return 0u; }
};
struct EpiIn1 {
    static constexpr bool PERM = false;
    bf16_t* QB; bf16_t* KB; bf16_t* VT; const float* rope;
    __device__ __forceinline__ void operator()(const f32x4 (&acc)[2][2][4][2], const g8::Unit& u, int wr, int wc, int fr, int fq) const {
        const int bidx = u.pm / 9;
        const bool islat = (u.pm % 9) != 0;
        const bool dorope = islat && u.pn < 5;
        const float qs = u.pn < 4 ? 0.125f * 1.4426950408889634f : 1.f;
#pragma unroll
        for (int ai = 0; ai < 2; ++ai)
#pragma unroll
            for (int m = 0; m < 4; ++m) {
                const int row = u.pm * 256 + ai * 128 + wr * 64 + m * 16 + fr;
                const int sidx = row - bidx * TT, tl = sidx - LC;
                const int pos = (wc & 1) == 0 ? (tl >> 6) : (tl & 63);
                f32x4 cs = (f32x4){1.f, 1.f, 1.f, 1.f}, sn = (f32x4){0.f, 0.f, 0.f, 0.f};
                if (dorope) { cs = *(const f32x4*)(rope + pos * 16 + 4 * fq); sn = *(const f32x4*)(rope + 1024 + pos * 16 + 4 * fq); }
#pragma unroll
                for (int bj = 0; bj < 2; ++bj) {
                    const f32x4 p1 = acc[ai][bj][m][0], p2 = acc[ai][bj][m][1];
                    const f32x4 o1 = (p1 * cs - p2 * sn) * qs, o2 = (p2 * cs + p1 * sn) * qs;
                    const int col = u.pn * 256 + bj * 128 + wc * 32 + 4 * fq;
                    if (u.pn < 4) {
                        st_bf4(QB + (size_t)row * 1024 + col, o1); st_bf4(QB + (size_t)row * 1024 + col + 16, o2);
                    } else if (u.pn == 4) {
                        st_bf4(KB + (size_t)row * 256 + (col - 1024), o1); st_bf4(KB + (size_t)row * 256 + (col - 1024) + 16, o2);
                    } else {
                        const int hd = col - 1280;
                        bf16_t* vp = VT + ((size_t)(bidx * 256 + hd)) * TT + sidx;
                        vp[0] = f2bf(o1[0]); vp[TT] = f2bf(o1[1]); vp[2 * TT] = f2bf(o1[2]); vp[3 * TT] = f2bf(o1[3]);
                        vp[16 * TT] = f2bf(o2[0]); vp[17 * TT] = f2bf(o2[1]); vp[18 * TT] = f2bf(o2[2]); vp[19 * TT] = f2bf(o2[3]);
                    }
                }
            }
    }
};
__device__ __forceinline__ void phase_inproj1(const Params& p, char* lds) {
    SchedIn1 S{p.ws + OFF_H, p.ws + OFF_WIN1};
    EpiIn1 E{(bf16_t*)(p.ws + L_QB), (bf16_t*)(p.ws + L_KB), (bf16_t*)(p.ws + L_VT), (const float*)(p.ws + OFF_ROPE)};
    g8::gemm_phase<false>((LAS unsigned char*)lds, DM, S, E);
    { const int nb = (int)gridDim.x; if (nb > 200) convert_moe(p, 1, lds, 144, nb - 144); else convert_moe(p, 1, lds, 0, nb); }
}

typedef unsigned u32x2_t __attribute__((ext_vector_type(2)));
__device__ __forceinline__ float max_x16_x32(float v) {
    u32x2_t r = __builtin_amdgcn_permlane16_swap(__float_as_uint(v), __float_as_uint(v), false, false);
    v = fmaxf(__uint_as_float(r[0]), __uint_as_float(r[1]));
    r = __builtin_amdgcn_permlane32_swap(__float_as_uint(v), __float_as_uint(v), false, false);
    return fmaxf(__uint_as_float(r[0]), __uint_as_float(r[1]));
}
__device__ __forceinline__ float sum_x16_x32(float v) {
    u32x2_t r = __builtin_amdgcn_permlane16_swap(__float_as_uint(v), __float_as_uint(v), false, false);
    v = __uint_as_float(r[0]) + __uint_as_float(r[1]);
    r = __builtin_amdgcn_permlane32_swap(__float_as_uint(v), __float_as_uint(v), false, false);
    return __uint_as_float(r[0]) + __uint_as_float(r[1]);
}
__device__ __forceinline__ void phase_attn(const Params& p, char* lds) {
    const bf16_t* QB = (const bf16_t*)(p.ws + L_QB); const bf16_t* KB = (const bf16_t*)(p.ws + L_KB); const bf16_t* VT = (const bf16_t*)(p.ws + L_VT);
    bf16_t* AO = (bf16_t*)(p.ws + L_AO);
    constexpr int VROW = 136, STG = 8192 + 64 * VROW;
    const int t = threadIdx.x, lane = t & 63, w = t >> 6, fr = lane & 15, fq = lane >> 4;
    const int g = w & 3, qh = w >> 2;
    const int srow = t >> 3, sc16 = t & 7;
    for (int u = blockIdx.x; u < 512; u += gridDim.x) {
        const int qt = u & 15, hkv = (u >> 4) & 3, b = u >> 6;
        const int hq = hkv * 4 + g;
        const int q0 = qt * 128, qa = q0 + qh * 64;
        char* Qs = lds + 2 * STG + w * 8192;
        {
            const bf16_t* qsrc = QB + (size_t)(b * TT + LC + qa) * 1024 + hq * 64;
#pragma unroll
            for (int it = 0; it < 8; ++it) {
                const int row = it * 8 + (lane >> 3), ch = lane & 7;
                *(uint4*)(Qs + swz(row, ch)) = *(const uint4*)(qsrc + (size_t)row * 1024 + ch * 8);
            }
        }
        f32x4 O[4][4];
        float mrow[4], lrow[4];
#pragma unroll
        for (int mi = 0; mi < 4; ++mi) {
            mrow[mi] = -1e30f; lrow[mi] = 0.f;
#pragma unroll
            for (int dt = 0; dt < 4; ++dt) O[mi][dt] = (f32x4){0.f, 0.f, 0.f, 0.f};
        }
        const int c_lo = (q0 == 0) ? 2 : 0, c_hi = (q0 + 256 > SEQ) ? 4 : 6;
        const int nch = (c_hi - c_lo) + 4;
        const int nloc = c_hi - c_lo;
        const bf16_t* kbase = KB + (size_t)(b * TT) * 256 + hkv * 64 + sc16 * 8;
        const bf16_t* vbase = VT + ((size_t)((b * 4 + hkv) * 64 + srow)) * TT + sc16 * 8;
        uint4 kreg, vreg;
        {
            const int s0 = (0 < nloc) ? LC + q0 - 128 + 64 * c_lo : 0;
            kreg = *(const uint4*)(kbase + (size_t)(s0 + srow) * 256);
            vreg = *(const uint4*)(vbase + s0);
            char* Ks = lds; char* Vs = lds + 8192;
            *(uint4*)(Ks + swz(srow, sc16)) = kreg;
            *(uint2*)(Vs + srow * VROW + sc16 * 16) = make_uint2(vreg.x, vreg.y);
            *(uint2*)(Vs + srow * VROW + sc16 * 16 + 8) = make_uint2(vreg.z, vreg.w);
        }
        __syncthreads();
        for (int i = 0; i < nch; ++i) {
            const bool more = (i + 1 < nch);
            if (more) {
                const int i1 = i + 1;
                const int s1 = (i1 < nloc) ? LC + q0 - 128 + 64 * (c_lo + i1) : 64 * (i1 - nloc);
                kreg = *(const uint4*)(kbase + (size_t)(s1 + srow) * 256);
                vreg = *(const uint4*)(vbase + s1);
            }
            const bool isloc = i < nloc;
            const int kc = q0 - 128 + 64 * (c_lo + i);
            const bool relevant = !isloc || (kc + 63 >= qa - 128 && kc <= qa + 63 + 128);
            const bool needmask = isloc && !(kc >= qa + 63 - 128 && kc + 63 <= qa + 128);
            if (relevant) {
                const char* Ks = lds + (i & 1) * STG;
                const char* Vs = Ks + 8192;
#pragma unroll
                for (int mh = 0; mh < 2; ++mh) {
                    bf16x8 qf[2][2];
                    int qrow = mh * 32 + fr;
                    asm volatile("" : "+v"(qrow));
#pragma unroll
                    for (int m2 = 0; m2 < 2; ++m2)
#pragma unroll
                        for (int kk = 0; kk < 2; ++kk) qf[m2][kk] = *(const bf16x8*)(Qs + swz(qrow + 16 * m2, kk * 4 + fq));
                    f32x4 S[2][4];
#pragma unroll
                    for (int m2 = 0; m2 < 2; ++m2)
#pragma unroll
                        for (int ni = 0; ni < 4; ++ni) S[m2][ni] = (f32x4){0.f, 0.f, 0.f, 0.f};
#pragma unroll
                    for (int kk = 0; kk < 2; ++kk) {
                        bf16x8 kf[4];
#pragma unroll
                        for (int ni = 0; ni < 4; ++ni) kf[ni] = *(const bf16x8*)(Ks + swz(16 * ni + fr, kk * 4 + fq));
#pragma unroll
                        for (int m2 = 0; m2 < 2; ++m2)
#pragma unroll
                            for (int ni = 0; ni < 4; ++ni) S[m2][ni] = __builtin_amdgcn_mfma_f32_16x16x32_bf16(kf[ni], qf[m2][kk], S[m2][ni], 0, 0, 0);
                    }
                    bf16x8 pf[2][2];
#pragma unroll
                    for (int m2 = 0; m2 < 2; ++m2) {
                        const int mi = mh * 2 + m2;
                        if (needmask) {
                            const int qpos = qa + 16 * mi + fr;
#pragma unroll
                            for (int ni = 0; ni < 4; ++ni)
#pragma unroll
                                for (int r = 0; r < 4; ++r) {
                                    const int dist = qpos - (kc + 16 * ni + 4 * fq + r);
                                    S[m2][ni][r] = (dist <= 128 && dist >= -128) ? S[m2][ni][r] : -1e30f;
                                }
                        }
                        float mx = -1e30f;
#pragma unroll
                        for (int ni = 0; ni < 4; ++ni) mx = fmaxf(fmaxf(mx, fmaxf(S[m2][ni][0], S[m2][ni][1])), fmaxf(S[m2][ni][2], S[m2][ni][3]));
                        mx = max_x16_x32(mx);
                        const float mn = fmaxf(mrow[mi], mx);
                        const float scale = __builtin_amdgcn_exp2f(mrow[mi] - mn);
                        mrow[mi] = mn;
                        float ls = 0.f;
                        if (needmask) {
#pragma unroll
                            for (int ni = 0; ni < 4; ++ni)
#pragma unroll
                                for (int r = 0; r < 4; ++r) {
                                    const float pv = S[m2][ni][r] > -1e29f ? __builtin_amdgcn_exp2f(S[m2][ni][r] - mn) : 0.f;
                                    S[m2][ni][r] = pv; ls += pv;
                                }
                        } else {
#pragma unroll
                            for (int ni = 0; ni < 4; ++ni)
#pragma unroll
                                for (int r = 0; r < 4; ++r) {
                                    const float pv = __builtin_amdgcn_exp2f(S[m2][ni][r] - mn);
                                    S[m2][ni][r] = pv; ls += pv;
                                }
                        }
                        lrow[mi] = lrow[mi] * scale + ls;
#pragma unroll
                        for (int dt = 0; dt < 4; ++dt) O[mi][dt] *= scale;
#pragma unroll
                        for (int kk = 0; kk < 2; ++kk) {
                            union { bf16x8 v; unsigned u[4]; } pk;
                            pk.u[0] = pack2(S[m2][2 * kk][0], S[m2][2 * kk][1]); pk.u[1] = pack2(S[m2][2 * kk][2], S[m2][2 * kk][3]);
                            pk.u[2] = pack2(S[m2][2 * kk + 1][0], S[m2][2 * kk + 1][1]); pk.u[3] = pack2(S[m2][2 * kk + 1][2], S[m2][2 * kk + 1][3]);
                            pf[m2][kk] = pk.v;
                        }
                    }
#pragma unroll
                    for (int dt = 0; dt < 4; ++dt)
#pragma unroll
                        for (int kk = 0; kk < 2; ++kk) {
                            union { bf16x8 v; uint2 h[2]; } vf;
                            const char* vp = Vs + (16 * dt + fr) * VROW + (32 * kk + 4 * fq) * 2;
                            vf.h[0] = *(const uint2*)vp;
                            vf.h[1] = *(const uint2*)(vp + 32);
#pragma unroll
                            for (int m2 = 0; m2 < 2; ++m2) O[mh * 2 + m2][dt] = __builtin_amdgcn_mfma_f32_16x16x32_bf16(vf.v, pf[m2][kk], O[mh * 2 + m2][dt], 0, 0, 0);
                        }
                }
            }
            if (more) {
                char* Ks = lds + ((i + 1) & 1) * STG; char* Vs = Ks + 8192;
                *(uint4*)(Ks + swz(srow, sc16)) = kreg;
                *(uint2*)(Vs + srow * VROW + sc16 * 16) = make_uint2(vreg.x, vreg.y);
                *(uint2*)(Vs + srow * VROW + sc16 * 16 + 8) = make_uint2(vreg.z, vreg.w);
            }
            __syncthreads();
        }
        const float sk = p.in[27][hq] * 1.4426950408889634f;
#pragma unroll
        for (int mi = 0; mi < 4; ++mi) {
            const float mf = fmaxf(mrow[mi], sk);
            const float scale = __builtin_amdgcn_exp2f(mrow[mi] - mf);
            const float l = sum_x16_x32(lrow[mi]) * scale + __builtin_amdgcn_exp2f(sk - mf);
            const float inv = scale / l;
            bf16_t* op = AO + (size_t)(b * SEQ + qa + 16 * mi + fr) * DM + hq * 64 + 4 * fq;
#pragma unroll
            for (int dt = 0; dt < 4; ++dt) {
                uint2 o;
                o.x = pack2(O[mi][dt][0] * inv, O[mi][dt][1] * inv);
                o.y = pack2(O[mi][dt][2] * inv, O[mi][dt][3] * inv);
                *(uint2*)(op + 16 * dt) = o;
            }
        }
    }
}

constexpr int NPHASE = 20;
__global__ void __launch_bounds__(NTHR) mega(Params p) {
    extern __shared__ __attribute__((aligned(16))) char lds[];
    cg::grid_group grid = cg::this_grid();
    volatile LAS unsigned* xbst = (volatile LAS unsigned*)(lds + LDS_MAIN);
    if (threadIdx.x == 0) { xbst[0] = 0u; xbst[1] = 0u; xbst[2] = 0u; xbst[3] = 0u; }
    __syncthreads();
    const XcdBarrier xb = xcd_barrier_post((unsigned*)(p.ws + OFF_BAR), xbst);
    if (p.ph_lo < 0) grid.sync();
#ifndef PH_MASK
#define PH_MASK 0xFFFFF
#endif
#ifndef REP_MASK
#define REP_MASK 0
#endif
#define RUN(n, call) if (((PH_MASK >> n) & 1) && p.ph_lo <= n && n < p.ph_hi) { call; if ((REP_MASK >> n) & 1) { xcd_barrier(xb); call; } if (n + 1 < p.ph_hi) xcd_barrier(xb); }
    RUN(0, phase0(p, lds))
    RUN(1, phase1(p))
    RUN(2, phase2(p, lds))
    RUN(3, phase3(p, lds, xb))
    RUN(4, phase4(p, lds, xb))
    RUN(5, phase5(p, lds))
    RUN(6, phase_outproj(p, 0, lds))
    RUN(7, phase_ffn_norm(p, 0, lds))
    RUN(8, phase_topk(p, 0, lds))
    RUN(9, phase_moe1(p, 0, lds))
    RUN(10, phase_moe2(p, 0, lds))
    RUN(11, phase_combine(p, 0, lds))
    RUN(12, phase_inproj1(p, lds))
    RUN(13, phase_attn(p, lds))
    RUN(14, phase_outproj(p, 1, lds))
    RUN(15, phase_ffn_norm(p, 1, lds))
    RUN(16, phase_topk(p, 1, lds))
    RUN(17, phase_moe1(p, 1, lds))
    RUN(18, phase_moe2(p, 1, lds))
    RUN(19, phase_combine(p, 1, lds))
#undef RUN
}

extern "C" void kernel_launch(void* const* d_in, const int* in_sizes, int n_in, void* d_out, int out_size, void* d_ws, size_t ws_size, hipStream_t stream) {
    static int grid_blocks = 0;
    if (grid_blocks == 0) {
        if (n_in != 33 || ws_size < WS_NEED) { fprintf(stderr, "kernel_launch: unexpected n_in %d or ws_size %zu (need %zu)\n", n_in, ws_size, (size_t)WS_NEED); grid_blocks = -1; return; }
        int dev = 0, cus = 0, per_cu = 0;
        (void)hipGetDevice(&dev);
        (void)hipDeviceGetAttribute(&cus, hipDeviceAttributeMultiprocessorCount, dev);
        (void)hipFuncSetAttribute((const void*)mega, hipFuncAttributeMaxDynamicSharedMemorySize, LDS_BYTES);
        (void)hipOccupancyMaxActiveBlocksPerMultiprocessor(&per_cu, (const void*)mega, NTHR, LDS_BYTES);
        if (per_cu < 1) { fprintf(stderr, "kernel_launch: occupancy query says %d blocks per CU\n", per_cu); per_cu = 1; }
        if (per_cu > 1) per_cu = 1;
        grid_blocks = cus * per_cu;
        (void)hipGetLastError();
    }
    if (grid_blocks < 0) return;
    if (hipMemsetAsync((char*)d_ws + OFF_BAR, 0, SZ_BAR, stream) != hipSuccess) { fprintf(stderr, "kernel_launch: memset failed\n"); return; }
    Params p{};
    for (int i = 0; i < 33; ++i) p.in[i] = (const float*)d_in[i];
    p.out = (float*)d_out;
    p.ws = (char*)d_ws;
    p.ph_lo = 0; p.ph_hi = NPHASE;
    void* args[] = {&p};
    hipError_t e = hipLaunchCooperativeKernel((const void*)mega, dim3(grid_blocks), dim3(NTHR), args, LDS_BYTES, stream);
    if (e != hipSuccess) fprintf(stderr, "cooperative launch failed: %s (grid %d)\n", hipGetErrorString(e), grid_blocks);
}
```

```cpp
#include <hip/hip_runtime.h>
#include <hip/hip_cooperative_groups.h>
#include <cstdio>
#include <cstdint>
namespace cg = cooperative_groups;

typedef unsigned short bf16_t;
typedef short bf16x8 __attribute__((ext_vector_type(8)));
typedef float f32x4 __attribute__((ext_vector_type(4)));
typedef unsigned u32x4 __attribute__((ext_vector_type(4)));

constexpr int NB = 8, SEQ = 2048, LC = 256, TT = 2304, DM = 1024, NTOK = NB * TT;
constexpr int EIN = 3984;
constexpr int NTHR = 512;
constexpr int LDS_MAIN = 155648;
constexpr int LDS_BYTES = LDS_MAIN + 16;

constexpr size_t SZ_MOD = 2ull * 9 * 6144 * 4;
constexpr size_t OFF_BAR = 0;
constexpr size_t SZ_BAR = 16384;
constexpr size_t OFF_MOD = OFF_BAR + SZ_BAR;
constexpr size_t OFF_ROPE = OFF_MOD + SZ_MOD;
constexpr size_t OFF_WIN0 = OFF_ROPE + 8192;
constexpr size_t OFF_WOUT0 = OFF_WIN0 + 4096ull * 1024 * 2;
constexpr size_t OFF_WIN1 = OFF_WOUT0 + 1024ull * 1024 * 2;
constexpr size_t OFF_WOUT1 = OFF_WIN1 + 1536ull * 1024 * 2;
constexpr size_t OFF_LORA = OFF_WOUT1 + 1024ull * 1024 * 2;
constexpr size_t OFF_XCTX = OFF_LORA + 196608ull * 2;
constexpr size_t OFF_H = OFF_XCTX + (size_t)NB * LC * DM * 4;
constexpr size_t OFF_BIG = OFF_H + (size_t)NTOK * DM * 2;
constexpr size_t SZ_T512 = (size_t)NTOK * 512 * 2;
constexpr size_t B_EW = OFF_BIG;
constexpr size_t B_KD = B_EW + 2 * SZ_T512;
constexpr size_t B_BD = B_KD + 2 * SZ_T512;
constexpr size_t B_RR = B_BD + 2 * SZ_T512;
constexpr size_t B_KK = B_RR + SZ_T512;
constexpr size_t B_GQ = B_KK + SZ_T512;
constexpr size_t B_GK = B_GQ + SZ_T512;
constexpr size_t B_GV = B_GK + SZ_T512;
constexpr size_t B_VV = B_GV + SZ_T512;
constexpr size_t B_GG = B_VV + SZ_T512;
constexpr size_t B_BC = B_GG + SZ_T512;
constexpr size_t B_GDG = B_BC + (size_t)NTOK * 8 * 4;
constexpr size_t B_GDB = B_GDG + (size_t)NTOK * 8 * 4;
constexpr size_t B_P = B_GDB + (size_t)NTOK * 8 * 4;
constexpr size_t B_YF = B_P + (size_t)NTOK * EIN * 2;
constexpr size_t B_YB = B_YF + SZ_T512;
constexpr size_t B_OF = B_YB + SZ_T512;
constexpr size_t B_OB = B_OF + SZ_T512;
constexpr size_t B_ZZ = B_OB + SZ_T512;
constexpr size_t B_END = B_ZZ + SZ_T512;
constexpr size_t C_GMW = B_P;
constexpr size_t C_GMU = C_GMW + 2304ull * 4096 * 2;
constexpr size_t C_RM = C_GMU + 2304ull * 4096 * 2;
static_assert(C_RM + 4608ull * 4096 * 2 <= B_YF, "chunk inverses must fit inside P");
constexpr size_t M_W = OFF_BIG;
constexpr size_t M_AFF = M_W + 3ull * 16 * 1024 * 1024 * 2;
constexpr size_t M_SEL = M_AFF + (size_t)NTOK * 16 * 4;
constexpr size_t M_IDX = M_SEL + (size_t)NTOK * 16 * 4;
constexpr size_t M_GATE = M_IDX + 16ull * 2304 * 4;
constexpr size_t M_HID = M_GATE + 16ull * 2304 * 4;
constexpr size_t M_YE = M_HID + 16ull * 2304 * 1024 * 2;
constexpr size_t M_END = M_YE + 16ull * 2304 * 1024 * 4;
constexpr size_t L_QB = M_HID;
constexpr size_t L_KB = L_QB + (size_t)NTOK * 1024 * 2;
constexpr size_t L_VT = L_KB + (size_t)NTOK * 256 * 2;
constexpr size_t L_AO = L_VT + (size_t)NTOK * 256 * 2;
constexpr size_t L_END = L_AO + (size_t)NB * SEQ * DM * 2;
constexpr size_t OFF_XLAT = M_END;
constexpr size_t X_END = OFF_XLAT + (size_t)NB * SEQ * DM * 2;
constexpr size_t WS_NEED = B_END > X_END ? B_END : X_END;
static_assert(L_END <= M_END, "layer-1 buffers must fit below the MoE buffers' end");
constexpr size_t C_END = C_RM + 4608ull * 4096 * 2;
constexpr size_t M_WE_A = X_END, M_WE_B = C_END;
static_assert(M_WE_A + 14ull * 2097152 <= B_YF && M_WE_B + 2ull * 2097152 <= M_END && M_WE_B >= M_YE && M_WE_A >= C_END, "early w1 copies must sit in memory that is free from phase 4 to phase 9");
__device__ __forceinline__ size_t moe_w_off(int layer, int mat) {
    if (layer == 0 && mat < 16) return mat < 14 ? M_WE_A + (size_t)mat * 2097152ull : M_WE_B + (size_t)(mat - 14) * 2097152ull;
    return M_W + (size_t)mat * 2097152ull;
}
static_assert(M_AFF <= B_VV, "MoE weights must only alias buffers dead after the scans");
static_assert(WS_NEED <= 560000000ull, "workspace too large");

struct Params {
    const float* in[33];
    float* out;
    char* ws;
    int ph_lo, ph_hi;
};

__device__ __forceinline__ float bf2f(bf16_t v) { return __uint_as_float(((unsigned)v) << 16); }
typedef __bf16 bf16x2_t __attribute__((ext_vector_type(2)));
typedef float f32x2 __attribute__((ext_vector_type(2)));
__device__ __forceinline__ bf16_t f2bf(float f) { return __builtin_bit_cast(bf16_t, (__bf16)f); }
__device__ __forceinline__ unsigned pack2(float a, float b) { const bf16x2_t v = __builtin_convertvector((f32x2){a, b}, bf16x2_t); return __builtin_bit_cast(unsigned, v); }
__device__ __forceinline__ uint2 pk4(f32x4 v) { uint2 o; o.x = pack2(v[0], v[1]); o.y = pack2(v[2], v[3]); return o; }
__device__ __forceinline__ float sigm(float x) { return __builtin_amdgcn_rcpf(1.f + __expf(-x)); }
__device__ __forceinline__ float siluf(float x) { return x * __builtin_amdgcn_rcpf(1.f + __expf(-x)); }
__device__ __forceinline__ float softplusf(float x) { return x > 20.f ? x : log1pf(expf(x)); }
__device__ __forceinline__ float red16(float x);
__device__ __forceinline__ float wave_sum(float v) {
    v = red16(v);
    v += __builtin_bit_cast(float, __builtin_amdgcn_update_dpp(0, __builtin_bit_cast(int, v), 0x142, 0xa, 0xf, false));
    v += __builtin_bit_cast(float, __builtin_amdgcn_update_dpp(0, __builtin_bit_cast(int, v), 0x143, 0xc, 0xf, false));
    return __builtin_bit_cast(float, __builtin_amdgcn_readlane(__builtin_bit_cast(int, v), 63));
}
__device__ __forceinline__ float red16(float x) {
    x += __builtin_bit_cast(float, __builtin_amdgcn_update_dpp(0, __builtin_bit_cast(int, x), 0xB1, 0xf, 0xf, false));
    x += __builtin_bit_cast(float, __builtin_amdgcn_update_dpp(0, __builtin_bit_cast(int, x), 0x4E, 0xf, 0xf, false));
    x += __builtin_bit_cast(float, __builtin_amdgcn_update_dpp(0, __builtin_bit_cast(int, x), 0x124, 0xf, 0xf, false));
    x += __builtin_bit_cast(float, __builtin_amdgcn_update_dpp(0, __builtin_bit_cast(int, x), 0x128, 0xf, 0xf, false));
    return x;
}
__device__ __forceinline__ const float* xin_row(const Params& p, int R) {
    int b = R / TT, s = R - b * TT;
    const float* ctx = p.in[2]; const float* lat = p.in[0];
    asm volatile("" : "+s"(ctx), "+s"(lat));
    return s < LC ? ctx + (size_t)(b * LC + s) * DM : lat + (size_t)(b * SEQ + s - LC) * DM;
}
__device__ __forceinline__ bf16_t* xs_row(const Params& p, int R) {
    int b = R / TT, s = R - b * TT;
    return (bf16_t*)(p.ws + (s < LC ? OFF_XCTX + (size_t)(b * LC + s) * DM * 2 : OFF_XLAT + (size_t)(b * SEQ + s - LC) * DM * 2));
}
__device__ __forceinline__ int mod_row(int R) {
    int b = R / TT, s = R - b * TT;
    return s < LC ? 8 : b;
}
__device__ __forceinline__ const float* mod_ptr(const Params& p, int layer, int mrow, int j) {
    return (const float*)(p.ws + OFF_MOD) + ((size_t)(layer * 9 + mrow) * 6 + j) * 1024;
}


#define XB_TMO      128
#define XB_XCNT(j)  (256  + 64 * (j))
#define XB_XSUB(j)  (1280 + 64 * (j))
#define XB_XGEN(j)  (2304 + 64 * (j))
#define XB_TOP      3328
#define XB_TOPGEN   3392
#define XCD_BAR_WORDS 3456
#define XB_SPIN_CAP (1u << 22)
#define LAS __attribute__((address_space(3)))
__device__ __forceinline__ unsigned xb_ld(unsigned* p)              { return __hip_atomic_load(p, __ATOMIC_RELAXED, __HIP_MEMORY_SCOPE_AGENT); }
__device__ __forceinline__ unsigned xb_add(unsigned* p, unsigned v) { return __hip_atomic_fetch_add(p, v, __ATOMIC_RELAXED, __HIP_MEMORY_SCOPE_AGENT); }
__device__ __forceinline__ unsigned xb_xcc_id() { return (unsigned)__builtin_amdgcn_s_getreg((3 << 11) | 20) & 0xFu; }
#define XB_SPIN(cond, bar) do { unsigned _sp = 0; while (cond) { __builtin_amdgcn_s_sleep(1); \
    if ((++_sp & 255u) == 0u) { if (xb_ld(&(bar)[XB_TMO])) break; if (_sp > XB_SPIN_CAP) { atomicAdd(&(bar)[XB_TMO], 1u); break; } } } } while (0)
struct XcdBarrier { unsigned* bar; unsigned x; volatile LAS unsigned* st; };
__device__ __forceinline__ XcdBarrier xcd_barrier_post(unsigned* bar, volatile LAS unsigned* st) {
    XcdBarrier b; b.bar = bar; b.x = xb_xcc_id(); b.st = st;
    if (threadIdx.x == 0) (void)xb_add(&bar[XB_XCNT(b.x)], 1u);
    return b;
}
__device__ __forceinline__ void xcd_barrier_complete(unsigned* bar, unsigned x, unsigned& nloc, unsigned& nx) {
    const unsigned G = gridDim.x * gridDim.y * gridDim.z;
    unsigned sum, cnt, mine, sp = 0u;
    for (;;) {
        sum = 0u; cnt = 0u; mine = 0u;
#pragma unroll
        for (unsigned j = 0; j < 16; ++j) { const unsigned c = xb_ld(&bar[XB_XCNT(j)]); sum += c; cnt += (c > 0u) ? 1u : 0u; mine = (j == x) ? c : mine; }
        if (sum == G) break;
        __builtin_amdgcn_s_sleep(1);
        if ((++sp & 255u) == 0u) { if (xb_ld(&bar[XB_TMO])) break; if (sp > XB_SPIN_CAP) { atomicAdd(&bar[XB_TMO], 1u); break; } }
    }
    nloc = mine > 0u ? mine : 1u; nx = cnt > 0u ? cnt : 1u;
}
__device__ __forceinline__ void xcd_barrier(const XcdBarrier& b) {
    asm volatile("s_waitcnt vmcnt(0)" ::: "memory");
    __syncthreads();
    if (threadIdx.x == 0) {
        unsigned* bar = b.bar;
        __builtin_amdgcn_s_waitcnt(0);
        unsigned nloc = b.st[0], nx = b.st[1];
        if (nloc == 0u) { xcd_barrier_complete(bar, b.x, nloc, nx); b.st[0] = nloc; b.st[1] = nx; }
        const unsigned old = xb_add(&bar[XB_XSUB(b.x)], 1u);
        const unsigned gen = old / nloc;
        if (old + 1u == (gen + 1u) * nloc) {
            __builtin_amdgcn_fence(__ATOMIC_RELEASE, "agent");
            asm volatile("s_waitcnt vmcnt(0)" ::: "memory");
            const unsigned og = xb_add(&bar[XB_TOP], 1u);
            const unsigned tg = og / nx;
            if (og + 1u == (tg + 1u) * nx) xb_add(&bar[XB_TOPGEN], 1u);
            else XB_SPIN(xb_ld(&bar[XB_TOPGEN]) == tg, bar);
            __builtin_amdgcn_fence(__ATOMIC_ACQUIRE, "agent");
            xb_add(&bar[XB_XGEN(b.x)], 1u);
            asm volatile("s_waitcnt vmcnt(0)" ::: "memory");
        } else {
            XB_SPIN(xb_ld(&bar[XB_XGEN(b.x)]) == gen, bar);
            __builtin_amdgcn_fence(__ATOMIC_ACQUIRE, "agent");
            asm volatile("s_waitcnt vmcnt(0)" ::: "memory");
        }
    }
    __syncthreads();
}

__device__ __forceinline__ int swz(int row, int chunk) { return row * 128 + ((chunk ^ ((row >> 1) & 7)) << 4); }

namespace g8 {
constexpr int BM = 256, BK = 64, HALF = 128, HTB = HALF * BK * 2, STAGE_BYTES = 8 * HTB, NXCD = 8, WGM = 8;
__device__ __forceinline__ int lds_byte(int r, int c) { const int st = (r >> 4) * 2 + (c >> 5), rr = r & 15, cc = c & 31, ob = rr * 64 + cc * 2; return st * 1024 + (ob ^ (((ob >> 9) & 1) << 5)); }
__device__ __forceinline__ void stage_rc(int b, int& R, int& C) { const int st = b / 1024, sb = b % 1024, swz = sb ^ (((sb >> 9) & 1) << 5); R = (st >> 1) * 16 + swz / 64; C = (st & 1) * 32 + (swz % 64) / 2; }
__device__ __forceinline__ int perm32(int rho) { const int n = rho >> 4, i = rho & 15; return 8 * (i >> 2) + 4 * n + (i & 3); }
struct Unit { const char* a0; const char* a1; const char* b0; const char* b1; int pm, pn, e, half, mh, nh; };
__device__ __forceinline__ bool tail_split(int i, int U, int maxp, int& L, int& sub, int& pieces) {
    const int G = (int)gridDim.x, c = (int)blockIdx.x, R = U / G, T = U - R * G;
    pieces = 1; sub = 0;
    if (i < R) { L = i * G + c; return true; }
    if (i > R || T == 0) return false;
    pieces = (maxp >= 4 && 4 * T <= G) ? 4 : (maxp >= 2 && 2 * T <= G) ? 2 : 1;
    if (c >= pieces * T) return false;
    L = R * G + c / pieces; sub = c % pieces; return true;
}
__device__ __forceinline__ void grid_order_L(int L, int nM, int nN, int& pm, int& pn) {
    const int nwg = nM * nN;
    int wgid = L; { const int q = nwg / NXCD, r = nwg % NXCD, xcd = wgid % NXCD, off = wgid / NXCD; wgid = (xcd < r ? xcd * (q + 1) : r * (q + 1) + (xcd - r) * q) + off; }
    const int nig = WGM * nN, gid = wgid / nig, fm = gid * WGM, gsz = (nM - fm) < WGM ? (nM - fm) : WGM;
    pm = fm + ((wgid % nig) % gsz); pn = (wgid % nig) / gsz;
}
__device__ __forceinline__ bool grid_order(int i, int nM, int nN, int& pm, int& pn) {
    const long L = (long)i * gridDim.x + blockIdx.x; if (L >= nM * nN) return false;
    grid_order_L((int)L, nM, nN, pm, pn); return true;
}

template <bool GATHER, class Epi, class Sched>
__device__ __forceinline__ void gemm_phase(LAS unsigned char* lds, const int K, const Sched& S, const Epi& E) {
    const int tid = threadIdx.x, wid = __builtin_amdgcn_readfirstlane(tid >> 6), lane = tid & 63, wr = wid >> 2, wc = wid & 3, fr = lane & 15, fq = lane >> 4;
    const int nt = K / BK;
    int sR[2], sC[2];
    unsigned voffB[2], voffA0[2], voffA1[2], nvoffA0[2], nvoffA1[2];
#pragma unroll
    for (int i = 0; i < 2; ++i) {
        stage_rc(tid * 16 + i * 8192, sR[i], sC[i]);
        const unsigned va = (unsigned)(sR[i] * K + sC[i]) * 2u;
        const int Rb = Epi::PERM ? ((sR[i] & ~31) + perm32(sR[i] & 31)) : sR[i];
        voffB[i] = (unsigned)(Rb * K + sC[i]) * 2u; voffA0[i] = va; voffA1[i] = va; nvoffA0[i] = va; nvoffA1[i] = va;
    }
    const size_t kstep = (size_t)(BK * 2);
    const unsigned ldsw = (unsigned)wid * 1024u;
    const int aoff = lds_byte(wr * 64 + fr, fq * 8), boff = lds_byte(wc * 32 + fr, fq * 8);
#define G8_SA(b, h) (((b) * 2 + (h)) * HTB)
#define G8_SB(b, h) ((4 + (b) * 2 + (h)) * HTB)
#define G8_STAGE(bufoff, gbase, voff) do { _Pragma("unroll") for (int _i = 0; _i < 2; ++_i) \
        __builtin_amdgcn_global_load_lds((const unsigned*)((const char*)(gbase) + (voff)[_i]), (LAS unsigned*)(lds + (bufoff) + ldsw + _i * 8192), 16, 0, 0); } while (0)
#define G8_LDA(dst, b, h) do { _Pragma("unroll") for (int m = 0; m < 4; ++m) _Pragma("unroll") for (int k = 0; k < 2; ++k) dst[m][k] = *(const LAS bf16x8*)(lds + G8_SA(b, h) + aoff + m * 2048 + k * 1024); } while (0)
#define G8_LDB(dst, b, h) do { _Pragma("unroll") for (int n = 0; n < 2; ++n) _Pragma("unroll") for (int k = 0; k < 2; ++k) dst[n][k] = *(const LAS bf16x8*)(lds + G8_SB(b, h) + boff + n * 2048 + k * 1024); } while (0)
#define G8_MMA(ai, bj, At, Bt) do { __builtin_amdgcn_s_setprio(1); _Pragma("unroll") for (int m = 0; m < 4; ++m) _Pragma("unroll") for (int n = 0; n < 2; ++n) _Pragma("unroll") for (int k = 0; k < 2; ++k) \
        acc[ai][bj][m][n] = __builtin_amdgcn_mfma_f32_16x16x32_bf16(Bt[n][k], At[m][k], acc[ai][bj][m][n], 0, 0, 0); __builtin_amdgcn_s_setprio(0); } while (0)
#define G8_WAIT_V(n) asm volatile("s_waitcnt vmcnt(" #n ")" ::: "memory")
#define G8_WAIT_L(n) asm volatile("s_waitcnt lgkmcnt(" #n ")" ::: "memory")
#define G8_BAR __builtin_amdgcn_s_barrier()
#define G8_SCHED __builtin_amdgcn_sched_barrier(0)
    Unit cur, nxt; int ui = 0;
    if (!S.next(0, cur)) return;
    if (GATHER) {
#pragma unroll
        for (int i = 0; i < 2; ++i) { voffA0[i] = S.aoff(cur, 0, sR[i], sC[i]); voffA1[i] = (cur.half & 2) ? 0u : S.aoff(cur, 1, sR[i], sC[i]); }
    } else {
#pragma unroll
        for (int i = 0; i < 2; ++i) voffA1[i] = (cur.half & 2) ? 0u : voffA0[i];
    }
    unsigned cB1[2], nB1[2];
#pragma unroll
    for (int i = 0; i < 2; ++i) { cB1[i] = (cur.half & 1) ? 0u : voffB[i]; nB1[i] = cB1[i]; }
    int raw0[2] = {0, 0}, raw1[2] = {0, 0};
    if (GATHER) {
        Unit u1;
        if (S.next(1, u1)) {
#pragma unroll
            for (int i = 0; i < 2; ++i) { raw0[i] = S.araw(u1, 0, sR[i]); raw1[i] = (u1.half & 2) ? 0 : S.araw(u1, 1, sR[i]); }
        }
    }
    f32x4 acc[2][2][4][2];
#pragma unroll
    for (int a = 0; a < 2; ++a)
#pragma unroll
        for (int b = 0; b < 2; ++b)
#pragma unroll
            for (int m = 0; m < 4; ++m)
#pragma unroll
                for (int n = 0; n < 2; ++n) acc[a][b][m][n] = (f32x4){0.f, 0.f, 0.f, 0.f};
    bf16x8 At[4][2], B0[2][2], B1[2][2];
    G8_STAGE(G8_SB(0, 0), cur.b0, voffB); G8_STAGE(G8_SA(0, 0), cur.a0, voffA0); G8_STAGE(G8_SB(0, 1), cur.b1, cB1); G8_STAGE(G8_SA(0, 1), cur.a1, voffA1);
    if (wr == 1) G8_BAR;
    G8_WAIT_V(4); G8_BAR;
    G8_STAGE(G8_SB(1, 0), cur.b0 + kstep, voffB); G8_STAGE(G8_SA(1, 0), cur.a0 + kstep, voffA0); G8_STAGE(G8_SB(1, 1), cur.b1 + kstep, cB1);
    G8_WAIT_V(6); G8_BAR;
    for (;;) {
        const bool has_next = S.next(ui + 1, nxt);
        if (!has_next) nxt = cur;
        if (GATHER) {
#pragma unroll
            for (int i = 0; i < 2; ++i) { nvoffA0[i] = has_next ? S.afrom(raw0[i], sC[i]) : voffA0[i]; nvoffA1[i] = has_next ? ((nxt.half & 2) ? 0u : S.afrom(raw1[i], sC[i])) : voffA1[i]; }
            Unit u2;
            if (S.next(ui + 2, u2)) {
#pragma unroll
                for (int i = 0; i < 2; ++i) { raw0[i] = S.araw(u2, 0, sR[i]); raw1[i] = (u2.half & 2) ? 0 : S.araw(u2, 1, sR[i]); }
            }
        } else {
#pragma unroll
            for (int i = 0; i < 2; ++i) nvoffA1[i] = (nxt.half & 2) ? 0u : voffA0[i];
        }
#pragma unroll
        for (int i = 0; i < 2; ++i) nB1[i] = (nxt.half & 1) ? 0u : voffB[i];
        const bool liveB = !(cur.half & 1), liveA = !(cur.half & 2), liveAB = cur.half == 0;
        for (int t = 0; t < nt; t += 2) {
            const bool last = (t == nt - 2);
            const char* a1h1 = cur.a1 + (size_t)(t + 1) * kstep;
            const char* a2h0 = last ? nxt.a0 : cur.a0 + (size_t)(t + 2) * kstep; const char* a2h1 = last ? nxt.a1 : cur.a1 + (size_t)(t + 2) * kstep;
            const char* b2h0 = last ? nxt.b0 : cur.b0 + (size_t)(t + 2) * kstep; const char* b2h1 = last ? nxt.b1 : cur.b1 + (size_t)(t + 2) * kstep;
            const char* a3h0 = a2h0 + kstep; const char* b3h0 = b2h0 + kstep; const char* b3h1 = b2h1 + kstep;
            unsigned v2a0[2], v2a1[2], v2b1[2];
#pragma unroll
            for (int i = 0; i < 2; ++i) { v2a0[i] = (GATHER && last) ? nvoffA0[i] : voffA0[i]; v2a1[i] = last ? nvoffA1[i] : voffA1[i]; v2b1[i] = last ? nB1[i] : cB1[i]; }
            G8_LDB(B0, 0, 0); G8_SCHED; G8_LDA(At, 0, 0); G8_STAGE(G8_SA(1, 1), a1h1, voffA1);
            G8_WAIT_L(8); G8_BAR; G8_WAIT_L(0); G8_MMA(0, 0, At, B0); G8_BAR; G8_SCHED;
            G8_LDB(B1, 0, 1); G8_STAGE(G8_SB(0, 0), b2h0, voffB);
            G8_BAR; G8_WAIT_L(0); if (liveB) G8_MMA(0, 1, At, B1); G8_BAR;
            G8_LDA(At, 0, 1); G8_STAGE(G8_SA(0, 0), a2h0, v2a0);
            G8_BAR; G8_WAIT_L(0); if (liveA) G8_MMA(1, 0, At, B0); G8_BAR; G8_SCHED;
            G8_STAGE(G8_SB(0, 1), b2h1, v2b1);
            G8_WAIT_V(6); G8_BAR; if (liveAB) G8_MMA(1, 1, At, B1); G8_BAR;
            G8_LDB(B0, 1, 0); G8_SCHED; G8_LDA(At, 1, 0); G8_STAGE(G8_SA(0, 1), a2h1, v2a1);
            G8_WAIT_L(8); G8_BAR; G8_WAIT_L(0); G8_MMA(0, 0, At, B0); G8_BAR; G8_SCHED;
            G8_LDB(B1, 1, 1); G8_STAGE(G8_SB(1, 0), b3h0, voffB);
            G8_BAR; G8_WAIT_L(0); if (liveB) G8_MMA(0, 1, At, B1); G8_BAR;
            G8_LDA(At, 1, 1); G8_STAGE(G8_SA(1, 0), a3h0, v2a0);
            G8_BAR; G8_WAIT_L(0); if (liveA) G8_MMA(1, 0, At, B0); G8_BAR; G8_SCHED;
            G8_STAGE(G8_SB(1, 1), b3h1, v2b1);
            G8_WAIT_V(6); G8_BAR; if (liveAB) G8_MMA(1, 1, At, B1); G8_BAR;
        }
        E(acc, cur, wr, wc, fr, fq);
        if (!has_next) break;
#pragma unroll
        for (int a = 0; a < 2; ++a)
#pragma unroll
            for (int b = 0; b < 2; ++b)
#pragma unroll
                for (int m = 0; m < 4; ++m)
#pragma unroll
                    for (int n = 0; n < 2; ++n) acc[a][b][m][n] = (f32x4){0.f, 0.f, 0.f, 0.f};
        cur = nxt; ++ui;
#pragma unroll
        for (int i = 0; i < 2; ++i) { if (GATHER) voffA0[i] = nvoffA0[i]; voffA1[i] = nvoffA1[i]; cB1[i] = nB1[i]; }
    }
    G8_WAIT_V(0);
    if (wr == 0) G8_BAR;
    G8_BAR;
#undef G8_SA
#undef G8_SB
#undef G8_STAGE
#undef G8_LDA
#undef G8_LDB
#undef G8_MMA
#undef G8_WAIT_V
#undef G8_WAIT_L
#undef G8_BAR
#undef G8_SCHED
}
}

__device__ __forceinline__ void transpose_tile(const float* __restrict__ src, bf16_t* __restrict__ dst, int K, int N, int kt, int nt, float* tile) {
    const int t = threadIdx.x;
    {
        const int k = t >> 3, n4 = (t & 7) * 4;
        const int n = nt * 64 + n4;
        f32x4 v0 = (f32x4){0.f, 0.f, 0.f, 0.f}, v1 = v0;
        const float* sp = src + (size_t)(kt * 64 + k) * N + n;
        if (n < N) v0 = *(const f32x4*)sp;
        if (n + 32 < N) v1 = *(const f32x4*)(sp + 32);
        float* tp = tile + k * 65 + n4;
        tp[0] = v0[0]; tp[1] = v0[1]; tp[2] = v0[2]; tp[3] = v0[3];
        tp[32] = v1[0]; tp[33] = v1[1]; tp[34] = v1[2]; tp[35] = v1[3];
    }
    __syncthreads();
    {
        const int n = t >> 3, k8 = (t & 7) * 8;
        if (nt * 64 + n < N) {
            uint4 o;
            o.x = pack2(tile[(k8 + 0) * 65 + n], tile[(k8 + 1) * 65 + n]);
            o.y = pack2(tile[(k8 + 2) * 65 + n], tile[(k8 + 3) * 65 + n]);
            o.z = pack2(tile[(k8 + 4) * 65 + n], tile[(k8 + 5) * 65 + n]);
            o.w = pack2(tile[(k8 + 6) * 65 + n], tile[(k8 + 7) * 65 + n]);
            *(uint4*)(dst + (size_t)(nt * 64 + n) * K + kt * 64 + k8) = o;
        }
    }
    __syncthreads();
}

__device__ __forceinline__ void adaln_unit(const Params& p, int u, float* lds) {
    float* sc = lds;
    float* red = lds + 9216;
    const int t = threadIdx.x;
    for (int i = t; i < 9216; i += NTHR) {
        const int r = i >> 10, k = i & 1023;
        const float v = (r < 8) ? p.in[1][r * 1024 + k] : p.in[3][k];
        sc[i] = siluf(v);
    }
    __syncthreads();
    const int w = t >> 6, lane = t & 63;
    const int l = u / 96, nc = u % 96;
    const float* W = p.in[4] + (size_t)l * 1024 * 6144 + nc * 64 + lane;
    float acc[9];
#pragma unroll
    for (int r = 0; r < 9; ++r) acc[r] = 0.f;
#pragma unroll 8
    for (int k = w * 128; k < w * 128 + 128; ++k) {
        const float wv = W[(size_t)k * 6144];
#pragma unroll
        for (int r = 0; r < 9; ++r) acc[r] += sc[r * 1024 + k] * wv;
    }
#pragma unroll
    for (int r = 0; r < 9; ++r) red[(w * 9 + r) * 64 + lane] = acc[r];
    __syncthreads();
    float* mod = (float*)(p.ws + OFF_MOD);
    for (int i = t; i < 576; i += NTHR) {
        const int r = i >> 6, ln = i & 63;
        float s = 0.f;
#pragma unroll
        for (int w2 = 0; w2 < 8; ++w2) s += red[(w2 * 9 + r) * 64 + ln];
        const int n = nc * 64 + ln;
        mod[(size_t)(l * 9 + r) * 6144 + n] = s + p.in[5][l * 6144 + n];
    }
    __syncthreads();
}

__device__ __forceinline__ void deferred_transposes(const Params& p, char* lds, int first, int nb) {
    for (int v = (int)blockIdx.x - first; v < 896; v += nb) {
        if (v < 256) transpose_tile(p.in[9], (bf16_t*)(p.ws + OFF_WOUT0), 1024, 1024, v >> 4, v & 15, (float*)lds);
        else if (v < 640) transpose_tile(p.in[25], (bf16_t*)(p.ws + OFF_WIN1), 1024, 1536, (v - 256) / 24, (v - 256) % 24, (float*)lds);
        else transpose_tile(p.in[26], (bf16_t*)(p.ws + OFF_WOUT1), 1024, 1024, (v - 640) >> 4, (v - 640) & 15, (float*)lds);
    }
}
__device__ __forceinline__ void phase0_tile(const Params& p, int v, char* lds) {
    if (v < 1008) transpose_tile(p.in[8], (bf16_t*)(p.ws + OFF_WIN0), 1024, EIN, v / 63, v % 63, (float*)lds);
    else if (v < 1056) {
        const int q = v - 1008;
        bf16_t* LW = (bf16_t*)(p.ws + OFF_LORA);
        if (q < 16) transpose_tile(p.in[12] + (q >> 3) * 64 * 512, LW + (q >> 3) * 32768, 64, 512, 0, q & 7, (float*)lds);
        else if (q < 32) transpose_tile(p.in[14] + ((q - 16) >> 3) * 64 * 512, LW + 65536 + ((q - 16) >> 3) * 32768, 64, 512, 0, q & 7, (float*)lds);
        else transpose_tile(p.in[15], LW + 131072, 128, 512, (q - 32) >> 3, q & 7, (float*)lds);
    } else {
        uint4* z = (uint4*)(p.ws + OFF_WIN0 + (size_t)EIN * 1024 * 2);
        for (int i = threadIdx.x; i < (4096 - EIN) * 1024 * 2 / 16; i += NTHR) z[i] = make_uint4(0u, 0u, 0u, 0u);
    }
}
__device__ __forceinline__ void phase0(const Params& p, char* lds) {
    const int bI = (int)blockIdx.x, G = (int)gridDim.x;
    for (int u = bI; u < 96; u += G) adaln_unit(p, u, (float*)lds);
    if (bI == G - 1) {
        float* rope = (float*)(p.ws + OFF_ROPE);
        for (int idx = threadIdx.x; idx < 1024; idx += NTHR) {
            const int pos = idx >> 4, i = idx & 15;
            const float inv = exp2f(-(float)i * (13.287712379549449f / 16.0f));
            const float ang = (float)pos * inv;
            rope[idx] = cosf(ang);
            rope[1024 + idx] = sinf(ang);
        }
    }
    if (G == 256) {
        if (bI < 96) { for (int v = bI; v < 1057; v += 576) phase0_tile(p, v, lds); }
        else {
            for (int k = 0; 96 + 3 * (bI - 96) + 576 * k < 1057; ++k)
#pragma unroll 1
                for (int j = 0; j < 3; ++j) { const int v = 96 + 3 * (bI - 96) + j + 576 * k; if (v < 1057) phase0_tile(p, v, lds); }
        }
    } else {
        for (int v = bI; v < 1057; v += G) phase0_tile(p, v, lds);
    }
}

#define XB_QHEAD(l) (3584 + 64 * (l))
__device__ __forceinline__ void ticket_draw(unsigned* head, unsigned& tk) {
#if defined(__HIP_DEVICE_COMPILE__)
    unsigned long long sv;
    unsigned one = 1u;
    asm volatile("s_mov_b64 %1, exec\n\ts_mov_b64 exec, 1\n\tglobal_atomic_add %0, %2, %3, off sc0\n\ts_mov_b64 exec, %1"
                 : "=&v"(tk), "=&s"(sv) : "v"(head), "v"(one) : "memory");
#else
    (void)head; (void)tk;
#endif
}
template <int N> __device__ __forceinline__ void ticket_wait(unsigned& tk) {
#if defined(__HIP_DEVICE_COMPILE__)
    asm volatile("s_waitcnt vmcnt(%1)" : "+v"(tk) : "n"(N) : "memory");
#else
    (void)tk;
#endif
}
template <int QH, int LO, int NP>
__device__ __forceinline__ void convert_moe(const Params& p, int layer, char* lds) {
    unsigned* head = (unsigned*)(p.ws + OFF_BAR) + XB_QHEAD(QH);
    float* tile = (float*)lds;
    volatile LAS int* qs = (volatile LAS int*)((LAS char*)lds + 4 * 4160 * 4);
    const int t = threadIdx.x;
    const int k = t >> 3, n4 = (t & 7) * 4;
    f32x4 a0[4], a1[4], b0[4], b1[4];
    auto fetch = [&](int pass, f32x4 (&v0)[4], f32x4 (&v1)[4]) {
#pragma unroll
        for (int q = 0; q < 4; ++q) {
            const int u = pass * 4 + q, mat = u >> 8, tl = u & 255;
            const int m3 = mat >> 4;
            const float* wb = m3 == 0 ? p.in[29] : (m3 == 1 ? p.in[30] : p.in[31]);
            const float* src = wb + (size_t)(layer * 16 + (mat & 15)) * 1024 * 1024;
            const float* sp = src + (size_t)((tl >> 4) * 64 + k) * 1024 + (tl & 15) * 64 + n4;
            v0[q] = *(const f32x4*)sp; v1[q] = *(const f32x4*)(sp + 32);
        }
    };
    auto to_lds = [&](const f32x4 (&v0)[4], const f32x4 (&v1)[4]) {
#pragma unroll
        for (int q = 0; q < 4; ++q) {
            float* tp = tile + q * 4160 + k * 65 + n4;
            tp[0] = v0[q][0]; tp[1] = v0[q][1]; tp[2] = v0[q][2]; tp[3] = v0[q][3];
            tp[32] = v1[q][0]; tp[33] = v1[q][1]; tp[34] = v1[q][2]; tp[35] = v1[q][3];
        }
    };
    auto store = [&](int pass) {
        const int n = t >> 3, k8 = (t & 7) * 8;
#pragma unroll
        for (int q = 0; q < 4; ++q) {
            const int u = pass * 4 + q, mat = u >> 8, tl = u & 255;
            const float* tq = tile + q * 4160;
            uint4 o;
            o.x = pack2(tq[(k8 + 0) * 65 + n], tq[(k8 + 1) * 65 + n]);
            o.y = pack2(tq[(k8 + 2) * 65 + n], tq[(k8 + 3) * 65 + n]);
            o.z = pack2(tq[(k8 + 4) * 65 + n], tq[(k8 + 5) * 65 + n]);
            o.w = pack2(tq[(k8 + 6) * 65 + n], tq[(k8 + 7) * 65 + n]);
            *(uint4*)((bf16_t*)(p.ws + moe_w_off(layer, mat)) + (size_t)((tl & 15) * 64 + n) * 1024 + (tl >> 4) * 64 + k8) = o;
        }
    };
    __syncthreads();
    if (t == 0) { const unsigned g = xb_add(head, 3u); qs[0] = LO + (int)g; qs[1] = LO + (int)g + 1; qs[2] = LO + (int)g + 2; }
    __syncthreads();
    int q0 = __builtin_amdgcn_readfirstlane(qs[0]), q1 = __builtin_amdgcn_readfirstlane(qs[1]), q2 = __builtin_amdgcn_readfirstlane(qs[2]);
    if (q0 < NP) fetch(q0, a0, a1);
    if (q1 < NP) fetch(q1, b0, b1);
    const bool w0 = __builtin_amdgcn_readfirstlane(t >> 6) == 0;
    while (q0 < NP) {
        unsigned g = 0u;
        to_lds(a0, a1);
        if (w0) ticket_draw(head, g);
        if (q2 < NP) fetch(q2, a0, a1);
        __syncthreads();
        store(q0);
        if (w0) { if (q2 < NP) ticket_wait<12>(g); else ticket_wait<0>(g); if (t == 0) qs[3] = LO + (int)g; }
        __syncthreads();
        const int q3 = __builtin_amdgcn_readfirstlane(qs[3]);
        if (q1 >= NP) break;
        to_lds(b0, b1);
        if (w0) ticket_draw(head, g);
        if (q3 < NP) fetch(q3, b0, b1);
        __syncthreads();
        store(q1);
        if (w0) { if (q3 < NP) ticket_wait<12>(g); else ticket_wait<0>(g); if (t == 0) qs[3] = LO + (int)g; }
        __syncthreads();
        const int q4 = __builtin_amdgcn_readfirstlane(qs[3]);
        q0 = q2; q1 = q3; q2 = q4;
    }
    __syncthreads();
}

__device__ __forceinline__ int rcol(int lane, int i) { return 8 * lane + 512 * (i >> 1) + 4 * (i & 1); }
__device__ __forceinline__ f32x4 bfq_lo(const uint4 v) { return (f32x4){__uint_as_float(v.x << 16), __uint_as_float(v.x & 0xffff0000u), __uint_as_float(v.y << 16), __uint_as_float(v.y & 0xffff0000u)}; }
__device__ __forceinline__ f32x4 bfq_hi(const uint4 v) { return (f32x4){__uint_as_float(v.z << 16), __uint_as_float(v.z & 0xffff0000u), __uint_as_float(v.w << 16), __uint_as_float(v.w & 0xffff0000u)}; }
__device__ __forceinline__ void load_row(const float* src, int lane, f32x4 (&x)[4]) {
#pragma unroll
    for (int i = 0; i < 4; ++i) x[i] = *(const f32x4*)(src + rcol(lane, i));
}
__device__ __forceinline__ float row_rs(const f32x4 (&x)[4]) {
    float ss = 0.f;
#pragma unroll
    for (int i = 0; i < 4; ++i) ss += x[i][0] * x[i][0] + x[i][1] * x[i][1] + x[i][2] * x[i][2] + x[i][3] * x[i][3];
    ss = wave_sum(ss);
    return rsqrtf(ss * (1.f / 1024.f) + 1e-6f);
}
__device__ __forceinline__ void norm_mod(const f32x4 (&x)[4], const float* gain, const float* shift, const float* scale, int lane, f32x4 (&h)[4]) {
    const float rs = row_rs(x);
#pragma unroll
    for (int i = 0; i < 4; ++i) {
        const int c = rcol(lane, i);
        const f32x4 g = *(const f32x4*)(gain + c), sh = *(const f32x4*)(shift + c), sc = *(const f32x4*)(scale + c);
        h[i] = x[i] * rs * g * (1.f + sc) + sh;
    }
}
struct ModP { f32x4 g[4], sh[4], sc[4]; };
__device__ __forceinline__ void load_modp(const float* gain, const float* shift, const float* scale, int lane, ModP& m) {
#pragma unroll
    for (int i = 0; i < 4; ++i) { const int c = rcol(lane, i); m.g[i] = *(const f32x4*)(gain + c); m.sh[i] = *(const f32x4*)(shift + c); m.sc[i] = *(const f32x4*)(scale + c); }
}
__device__ __forceinline__ void apply_modp(const f32x4 (&x)[4], const ModP& m, f32x4 (&h)[4]) {
    const float rs = row_rs(x);
#pragma unroll
    for (int i = 0; i < 4; ++i) h[i] = x[i] * rs * m.g[i] * (1.f + m.sc[i]) + m.sh[i];
}
__device__ __forceinline__ void store_h(bf16_t* dst, int lane, const f32x4 (&h)[4]) {
#pragma unroll
    for (int k = 0; k < 2; ++k) {
        uint4 o;
        o.x = pack2(h[2 * k][0], h[2 * k][1]); o.y = pack2(h[2 * k][2], h[2 * k][3]);
        o.z = pack2(h[2 * k + 1][0], h[2 * k + 1][1]); o.w = pack2(h[2 * k + 1][2], h[2 * k + 1][3]);
        *(uint4*)(dst + 8 * lane + 512 * k) = o;
    }
}
typedef unsigned rt_u2 __attribute__((ext_vector_type(2)));
__device__ __forceinline__ void router_row(const f32x4 (&h)[4], const float* rt, int lane, float* aff) {
    float v[16];
#pragma unroll
    for (int e = 0; e < 16; ++e) {
        f32x4 a = (f32x4){0.f, 0.f, 0.f, 0.f};
#pragma unroll
        for (int i = 0; i < 4; ++i) a += h[i] * *(const f32x4*)(rt + e * 1024 + 4 * lane + 256 * i);
        v[e] = (a[0] + a[1]) + (a[2] + a[3]);
        if ((e & 3) == 3) __builtin_amdgcn_sched_barrier(0);
    }
#pragma unroll
    for (int j = 0; j < 8; ++j) {
        const rt_u2 r = __builtin_amdgcn_permlane32_swap(__float_as_uint(v[j]), __float_as_uint(v[j + 8]), false, false);
        v[j] = __uint_as_float(r[0]) + __uint_as_float(r[1]);
    }
#pragma unroll
    for (int j = 0; j < 4; ++j) {
        const rt_u2 r = __builtin_amdgcn_permlane16_swap(__float_as_uint(v[j]), __float_as_uint(v[j + 4]), false, false);
        v[j] = __uint_as_float(r[0]) + __uint_as_float(r[1]);
    }
    auto dpp_ror8 = [](float x) { return __builtin_bit_cast(float, __builtin_amdgcn_update_dpp(0, __builtin_bit_cast(int, x), 0x128, 0xf, 0xf, false)); };
    auto dpp_x2 = [](float x) { return __builtin_bit_cast(float, __builtin_amdgcn_update_dpp(0, __builtin_bit_cast(int, x), 0x4E, 0xf, 0xf, false)); };
    auto dpp_x1 = [](float x) { return __builtin_bit_cast(float, __builtin_amdgcn_update_dpp(0, __builtin_bit_cast(int, x), 0xB1, 0xf, 0xf, false)); };
    {
        const bool hi = (lane & 8) != 0;
#pragma unroll
        for (int j = 0; j < 2; ++j) { const float keep = hi ? v[j + 2] : v[j], send = hi ? v[j] : v[j + 2]; v[j] = keep + dpp_ror8(send); }
    }
    float mylog;
    {
        const bool hi = (lane & 2) != 0;
        const float keep = hi ? v[1] : v[0], send = hi ? v[0] : v[1];
        mylog = keep + dpp_x2(send);
    }
    mylog += dpp_x1(mylog);
    mylog += __shfl_xor(mylog, 4);
    float mx = fmaxf(mylog, dpp_x2(mylog));
    mx = fmaxf(mx, dpp_ror8(mx));
    { rt_u2 r = __builtin_amdgcn_permlane16_swap(__float_as_uint(mx), __float_as_uint(mx), false, false); mx = fmaxf(__uint_as_float(r[0]), __uint_as_float(r[1]));
      r = __builtin_amdgcn_permlane32_swap(__float_as_uint(mx), __float_as_uint(mx), false, false); mx = fmaxf(__uint_as_float(r[0]), __uint_as_float(r[1])); }
    const float ex = __expf(mylog - mx);
    float sum = ex + dpp_x2(ex);
    sum += dpp_ror8(sum);
    { rt_u2 r = __builtin_amdgcn_permlane16_swap(__float_as_uint(sum), __float_as_uint(sum), false, false); sum = __uint_as_float(r[0]) + __uint_as_float(r[1]);
      r = __builtin_amdgcn_permlane32_swap(__float_as_uint(sum), __float_as_uint(sum), false, false); sum = __uint_as_float(r[0]) + __uint_as_float(r[1]); }
    const int e = ((lane >> 5) & 1) * 8 + ((lane >> 4) & 1) * 4 + ((lane >> 3) & 1) * 2 + ((lane >> 1) & 1);
    if ((lane & 5) == 0) aff[e] = ex * __builtin_amdgcn_rcpf(sum);
}

__device__ __forceinline__ void phase1(const Params& p) {
    const int lane = threadIdx.x & 63, wg = blockIdx.x * 8 + (threadIdx.x >> 6), nw = gridDim.x * 8;
    bf16_t* H = (bf16_t*)(p.ws + OFF_H);
    f32x4 xa[4], xb[4];
#pragma unroll
    for (int i = 0; i < 4; ++i) { xa[i] = (f32x4){0.f, 0.f, 0.f, 0.f}; xb[i] = xa[i]; }
    auto body = [&](const f32x4 (&x)[4], f32x4 (&xnext)[4], int R) {
        f32x4 h[4];
        const int mr = mod_row(R);
        ModP mp; load_modp(p.in[6], mod_ptr(p, 0, mr, 0), mod_ptr(p, 0, mr, 1), lane, mp);
        { const int Rn = R + nw; load_row(xin_row(p, Rn < NTOK ? Rn : R), lane, xnext); }
        apply_modp(x, mp, h);
        store_h(H + (size_t)R * DM, lane, h);
    };
    if (wg < NTOK) load_row(xin_row(p, wg), lane, xa);
    for (int R = wg; R < NTOK; R += 2 * nw) {
        body(xa, xb, R);
        if (R + nw >= NTOK) break;
        body(xb, xa, R + nw);
    }
}

__device__ __forceinline__ f32x4 ld_bf4(const bf16_t* q) {
    const uint2 v = *(const uint2*)q;
    return (f32x4){bf2f((bf16_t)(v.x & 0xffff)), bf2f((bf16_t)(v.x >> 16)), bf2f((bf16_t)(v.y & 0xffff)), bf2f((bf16_t)(v.y >> 16))};
}
__device__ __forceinline__ void st_bf4(bf16_t* q, f32x4 v) {
    uint2 o; o.x = pack2(v[0], v[1]); o.y = pack2(v[2], v[3]);
    *(uint2*)q = o;
}
__device__ __forceinline__ void load_row16(const bf16_t* src, int lane, f32x4 (&x)[4]) {
#pragma unroll
    for (int k = 0; k < 2; ++k) { const uint4 r = *(const uint4*)(src + 8 * lane + 512 * k); x[2 * k] = bfq_lo(r); x[2 * k + 1] = bfq_hi(r); }
}
struct Sched2 {
    const char* H; const char* W;
    __device__ __forceinline__ bool next(int i, g8::Unit& u) const {
        int L, sub, pieces; if (!g8::tail_split(i, 72 * 16, 2, L, sub, pieces)) return false;
        int pm, pn; g8::grid_order_L(L, 72, 16, pm, pn);
        u.pm = pm; u.pn = pn; u.e = 0; u.mh = 0; u.nh = sub; u.half = pieces == 2 ? 1 : 0;
        u.a0 = H + (size_t)pm * 256 * DM * 2; u.a1 = u.a0 + (size_t)128 * DM * 2;
        u.b0 = W + (size_t)(pn * 256 + sub * 128) * DM * 2; u.b1 = u.half ? u.b0 : u.b0 + (size_t)128 * DM * 2;
        return true;
    }
    __device__ __forceinline__ unsigned aoff(const g8::Unit&, int, int, int) const { return 0u; }
    __device__ __forceinline__ int araw(const g8::Unit&, int, int) const { return 0; }
    __device__ __forceinline__ unsigned afrom(int, int) const { return 0u; }
};
struct Epi2 {
    static constexpr bool PERM = true;
    bf16_t* P; bf16_t* ZZ;
    __device__ __forceinline__ void operator()(const f32x4 (&acc)[2][2][4][2], const g8::Unit& u, int wr, int wc, int fr, int fq) const {
#pragma unroll
        for (int ai = 0; ai < 2; ++ai)
#pragma unroll
            for (int m = 0; m < 4; ++m) {
                const int row = u.pm * 256 + ai * 128 + wr * 64 + m * 16 + fr;
#pragma unroll
                for (int bj = 0; bj < 2; ++bj) {
                    const int col = u.pn * 256 + (bj + u.nh) * 128 + wc * 32 + 8 * fq;
                    if (col < EIN && !(bj == 1 && (u.half & 1))) {
                        const uint2 t0 = pk4(acc[ai][bj][m][0]), t1 = pk4(acc[ai][bj][m][1]);
                        bf16_t* dst = col >= 3472 ? ZZ + (size_t)row * 512 + (col - 3472) : P + (size_t)row * EIN + col;
                        *(uint4*)dst = make_uint4(t0.x, t0.y, t1.x, t1.y);
                    }
                }
            }
    }
};
__device__ __forceinline__ void phase2(const Params& p, char* lds) {
    Sched2 S{p.ws + OFF_H, p.ws + OFF_WIN0};
    Epi2 E{(bf16_t*)(p.ws + B_P), (bf16_t*)(p.ws + B_ZZ)};
    g8::gemm_phase<false>((LAS unsigned char*)lds, DM, S, E);
}

__device__ __forceinline__ f32x4 sigm4(f32x4 x) { return (f32x4){sigm(x[0]), sigm(x[1]), sigm(x[2]), sigm(x[3])}; }
__device__ __forceinline__ f32x4 shifted4(const bf16_t* P, int R, int s, int lo, int hi, int c, const float* mu) {
    const f32x4 pc = ld_bf4(P + (size_t)R * EIN + c);
    f32x4 pm = (f32x4){0.f, 0.f, 0.f, 0.f}, pp = pm;
    if (s - 1 >= lo) pm = ld_bf4(P + (size_t)(R - 1) * EIN + c);
    if (s + 1 < hi) pp = ld_bf4(P + (size_t)(R + 1) * EIN + c);
    return pc + *(const f32x4*)(mu + c) * (0.5f * (pm + pp) - pc);
}
__device__ __forceinline__ void unpack8(const uint4 v, float (&f)[8]) {
    f[0] = bf2f((bf16_t)(v.x & 0xffff)); f[1] = bf2f((bf16_t)(v.x >> 16)); f[2] = bf2f((bf16_t)(v.y & 0xffff)); f[3] = bf2f((bf16_t)(v.y >> 16));
    f[4] = bf2f((bf16_t)(v.z & 0xffff)); f[5] = bf2f((bf16_t)(v.z >> 16)); f[6] = bf2f((bf16_t)(v.w & 0xffff)); f[7] = bf2f((bf16_t)(v.w >> 16));
}

__device__ __forceinline__ void phase3a(const Params& p, char* lds) {
    const bf16_t* P = (const bf16_t*)(p.ws + B_P);
    bf16_t* EW = (bf16_t*)(p.ws + B_EW); bf16_t* KD = (bf16_t*)(p.ws + B_KD); bf16_t* BD = (bf16_t*)(p.ws + B_BD);
    bf16_t* RR = (bf16_t*)(p.ws + B_RR); bf16_t* KK = (bf16_t*)(p.ws + B_KK); bf16_t* VV = (bf16_t*)(p.ws + B_VV); bf16_t* GG = (bf16_t*)(p.ws + B_GG);
    bf16_t* GQ = (bf16_t*)(p.ws + B_GQ); bf16_t* GK = (bf16_t*)(p.ws + B_GK); bf16_t* GV = (bf16_t*)(p.ws + B_GV);
    float* BC = (float*)(p.ws + B_BC); float* GDG = (float*)(p.ws + B_GDG); float* GDB = (float*)(p.ws + B_GDB);
    bf16_t* LIN = (bf16_t*)(p.ws + OFF_H);
    constexpr int PT = 16, LROW = 784;
    const int t = threadIdx.x, lane = t & 63, w = t >> 6, fr = lane & 15, fq = lane >> 4;
    const float* mu = p.in[10];
    for (int u = blockIdx.x; u < NB * (TT / PT); u += gridDim.x) {
        const int b = u / (TT / PT), s0 = (u % (TT / PT)) * PT;
        const int lo = (s0 < LC) ? 0 : LC, hi = (s0 < LC) ? LC : TT;
        const int R0 = b * TT + s0;
        for (int gi = t; gi < PT * 48; gi += NTHR) {
            const int tok = gi / 48, c8 = (gi % 48) * 8;
            const int col = 1536 + c8, R = R0 + tok, s = s0 + tok;
            float pc[8], pm[8], pp[8];
            const bool hm = s - 1 >= lo, hp = s + 1 < hi;
            const bf16_t* pb = P + (size_t)R * EIN + col;
            const uint4 qc = *(const uint4*)pb, qm = *(const uint4*)(pb - (hm ? EIN : 0)), qp = *(const uint4*)(pb + (hp ? EIN : 0));
            const f32x4 mu0 = *(const f32x4*)(mu + col), mu1 = *(const f32x4*)(mu + col + 4);
            const float muv[8] = {mu0[0], mu0[1], mu0[2], mu0[3], mu1[0], mu1[1], mu1[2], mu1[3]};
            const float fm = hm ? 0.5f : 0.f, fp = hp ? 0.5f : 0.f;
            unpack8(qc, pc); unpack8(qm, pm); unpack8(qp, pp);
            float v[8];
#pragma unroll
            for (int j = 0; j < 8; ++j) {
                float x = pc[j] + muv[j] * ((fm * pm[j] + fp * pp[j]) - pc[j]);
                if (c8 < 128) x = tanhf(x);
                else if (c8 >= 256) x = sigm(x);
                v[j] = x;
            }
            uint4 o; o.x = pack2(v[0], v[1]); o.y = pack2(v[2], v[3]); o.z = pack2(v[4], v[5]); o.w = pack2(v[6], v[7]);
            *(uint4*)(LIN + (size_t)R * 384 + c8) = o;
        }
        if (t < 384) {
            const int cg = t % 192, seg = t / 192;
            const int ch = cg * 8;
            const float* cw = p.in[21];
            float wj[5][8];
#pragma unroll
            for (int j = 0; j < 5; ++j) {
                const f32x4 w0 = *(const f32x4*)(cw + j * 1536 + ch), w1 = *(const f32x4*)(cw + j * 1536 + ch + 4);
                wj[j][0] = w0[0]; wj[j][1] = w0[1]; wj[j][2] = w0[2]; wj[j][3] = w0[3]; wj[j][4] = w1[0]; wj[j][5] = w1[1]; wj[j][6] = w1[2]; wj[j][7] = w1[3];
            }
            const int typ = cg >> 6;
            const int sb = s0 + seg * 8 - 2;
            const bf16_t* Pc = P + (size_t)(b * TT) * EIN + 1920 + ch;
            auto ldrow = [&](int sr) {
                const bool ok = sr >= lo && sr < hi;
                const u32x4 v = *(const u32x4*)(Pc + (size_t)(ok ? sr : lo) * EIN);
                const unsigned m = ok ? 0xffffffffu : 0u;
                return make_uint4(v[0] & m, v[1] & m, v[2] & m, v[3] & m);
            };
            uint4 r0 = ldrow(sb + 0), r1 = ldrow(sb + 1), r2 = ldrow(sb + 2), r3 = ldrow(sb + 3), r4 = ldrow(sb + 4);
#pragma unroll 1
            for (int k = 0; k < 8; ++k) {
                const int sn = sb + k + 5;
                const uint4 nxt = ldrow(sn);
                float a[8], x[8];
                unpack8(r0, x);
#pragma unroll
                for (int i = 0; i < 8; ++i) a[i] = x[i] * wj[0][i];
                unpack8(r1, x);
#pragma unroll
                for (int i = 0; i < 8; ++i) a[i] += x[i] * wj[1][i];
                unpack8(r2, x);
#pragma unroll
                for (int i = 0; i < 8; ++i) a[i] += x[i] * wj[2][i];
                unpack8(r3, x);
#pragma unroll
                for (int i = 0; i < 8; ++i) a[i] += x[i] * wj[3][i];
                unpack8(r4, x);
#pragma unroll
                for (int i = 0; i < 8; ++i) a[i] += x[i] * wj[4][i];
                float ssq = 0.f;
#pragma unroll
                for (int i = 0; i < 8; ++i) { a[i] = siluf(a[i]); ssq += a[i] * a[i]; }
                ssq = red16(ssq);
                float sc = 1.f;
                if (typ == 0) sc = rsqrtf(ssq + 1e-6f) * 0.08838834764831845f;
                else if (typ == 1) sc = rsqrtf(ssq + 1e-6f);
                uint4 o; o.x = pack2(a[0] * sc, a[1] * sc); o.y = pack2(a[2] * sc, a[3] * sc); o.z = pack2(a[4] * sc, a[5] * sc); o.w = pack2(a[6] * sc, a[7] * sc);
                bf16_t* dst = (typ == 0 ? GQ : (typ == 1 ? GK : GV)) + (size_t)(R0 + seg * 8 + k) * 512 + (ch & 511);
                *(uint4*)dst = o;
                r0 = r1; r1 = r2; r2 = r3; r3 = r4; r4 = nxt;
            }
        } else {
            const int tt = t - 384;
#pragma unroll
            for (int q = 0; q < 2; ++q) {
                const int idx = tt * 2 + q, k = idx >> 4, j = idx & 15;
                const int R = R0 + k;
                if (j < 8) {
                    const float al = bf2f(P[(size_t)R * EIN + 3456 + j]);
                    GDG[(size_t)R * 8 + j] = -expf(p.in[22][j]) * softplusf(al + p.in[23][j]);
                } else {
                    const float be = bf2f(P[(size_t)R * EIN + 3464 + (j - 8)]);
                    GDB[(size_t)R * 8 + (j - 8)] = sigm(be);
                }
            }
        }
    }
}


__device__ __forceinline__ void phase3b(const Params& p, char* lds) {
    const bf16_t* P = (const bf16_t*)(p.ws + B_P);
    bf16_t* EW = (bf16_t*)(p.ws + B_EW); bf16_t* KD = (bf16_t*)(p.ws + B_KD); bf16_t* BD = (bf16_t*)(p.ws + B_BD);
    bf16_t* RR = (bf16_t*)(p.ws + B_RR); bf16_t* KK = (bf16_t*)(p.ws + B_KK); bf16_t* VV = (bf16_t*)(p.ws + B_VV); bf16_t* GG = (bf16_t*)(p.ws + B_GG);
    float* BC = (float*)(p.ws + B_BC);
    const bf16_t* LW = (const bf16_t*)(p.ws + OFF_LORA);
    const bf16_t* LIN = (const bf16_t*)(p.ws + OFF_H);
    const int t = threadIdx.x, lane = t & 63, w = t >> 6, fr = lane & 15, fq = lane >> 4;
    const float* mu = p.in[10];
    const int hd = blockIdx.x & 7, grp = blockIdx.x >> 3, ngrp = gridDim.x >> 3;
    for (int i = t; i < 4 * 64 * 8; i += NTHR) {
        const int mtx = i >> 9, row = (i >> 3) & 63, c16 = i & 7;
        *(uint4*)(lds + mtx * 64 * 144 + row * 144 + c16 * 16) = *(const uint4*)(LW + (size_t)mtx * 32768 + (size_t)(64 * hd + row) * 64 + c16 * 8);
    }
    for (int i = t; i < 64 * 16; i += NTHR) {
        const int row = i >> 4, c16 = i & 15;
        *(uint4*)(lds + 4 * 64 * 144 + row * 272 + c16 * 16) = *(const uint4*)(LW + 131072 + (size_t)(64 * hd + row) * 128 + c16 * 8);
    }
    constexpr int PRM = 4 * 64 * 144 + 64 * 272;
    for (int i = t; i < 10 * 64; i += NTHR) {
        const int k = i >> 6, c = 64 * hd + (i & 63);
        float v;
        if (k < 3) v = mu[k * 512 + c];
        else if (k == 3) v = p.in[16][c];
        else if (k == 4) v = p.in[17][c];
        else if (k == 5) v = p.in[18][c];
        else if (k < 8) v = p.in[13][(k - 6) * 512 + c];
        else v = p.in[11][(k - 8) * 512 + c];
        ((float*)(lds + PRM))[i] = v;
    }
    __syncthreads();
    const LAS float* PR = (const LAS float*)((LAS char*)lds + PRM) + 16 * fq;
    if (grp < ngrp) {
        for (int tile = grp * 8 + w; tile < NB * (TT / 16); tile += ngrp * 8) {
            const int b = tile / (TT / 16), s0 = (tile % (TT / 16)) * 16;
            const int lo = (s0 < LC) ? 0 : LC, hi = (s0 < LC) ? LC : TT;
            const int R0 = b * TT + s0;
        {
            const int cb = 64 * hd;
            const int R = R0 + fr, s = s0 + fr;
            const int c0 = cb + 16 * fq;
            const char* Wl = lds + (16 * (fr >> 2) + (fr & 3)) * 144 + fq * 16;
            const char* Wg = lds + 4 * 64 * 144 + (16 * (fr >> 2) + (fr & 3)) * 272 + fq * 16;
            const bf16_t* Lrow = LIN + (size_t)R * 384 + 8 * fq;
            f32x4 rq[4], kq[4], kkn[4];
            bf16x8 linA[2][2], linW[2][2], linG[4];
            float ss = 0.f;
            {
                auto shift16 = [&](int which, f32x4 (&o)[4]) {
                    const bf16_t* pc = P + (size_t)R * EIN + which * 512 + c0;
#pragma unroll
                    for (int hh = 0; hh < 2; ++hh) {
                        float xc[8], xm[8], xp[8];
                        const bool hm = s - 1 >= lo, hp = s + 1 < hi;
                        const uint4 qc = *(const uint4*)(pc + 8 * hh), qm = *(const uint4*)(pc - (hm ? EIN : 0) + 8 * hh), qp = *(const uint4*)(pc + (hp ? EIN : 0) + 8 * hh);
                        const f32x4 m0 = *(const LAS f32x4*)(PR + which * 64 + 8 * hh), m1 = *(const LAS f32x4*)(PR + which * 64 + 8 * hh + 4);
                        const float fm = hm ? 0.5f : 0.f, fp = hp ? 0.5f : 0.f;
                        unpack8(qc, xc); unpack8(qm, xm); unpack8(qp, xp);
#pragma unroll
                        for (int j = 0; j < 4; ++j) {
                            o[2 * hh][j] = xc[j] + m0[j] * ((fm * xm[j] + fp * xp[j]) - xc[j]);
                            o[2 * hh + 1][j] = xc[4 + j] + m1[j] * ((fm * xm[4 + j] + fp * xp[4 + j]) - xc[4 + j]);
                        }
                    }
                };
                auto store16 = [&](bf16_t* dst, const f32x4 (&o)[4]) {
                    const uint2 t0 = pk4(o[0]), t1 = pk4(o[1]), t2 = pk4(o[2]), t3 = pk4(o[3]);
                    *(uint4*)dst = make_uint4(t0.x, t0.y, t1.x, t1.y); *(uint4*)(dst + 8) = make_uint4(t2.x, t2.y, t3.x, t3.y);
                };
                f32x4 vq[4];
                shift16(2, vq); shift16(0, rq); shift16(1, kq);
#pragma unroll
                for (int d = 0; d < 2; ++d)
#pragma unroll
                    for (int kk = 0; kk < 2; ++kk) { linA[d][kk] = *(const bf16x8*)(Lrow + 128 + 64 * d + 32 * kk); linW[d][kk] = *(const bf16x8*)(Lrow + 64 * d + 32 * kk); }
#pragma unroll
                for (int kk = 0; kk < 4; ++kk) linG[kk] = *(const bf16x8*)(Lrow + 256 + 32 * kk);
                store16(VV + (size_t)R * 512 + c0, vq);
                store16(RR + (size_t)R * 512 + c0, rq);
#pragma unroll
                for (int ni = 0; ni < 4; ++ni) {
                    kkn[ni] = kq[ni] * *(const LAS f32x4*)(PR + 3 * 64 + 4 * ni);
                    ss += kkn[ni][0] * kkn[ni][0] + kkn[ni][1] * kkn[ni][1] + kkn[ni][2] * kkn[ni][2] + kkn[ni][3] * kkn[ni][3];
                }
            }
            ss += __shfl_xor(ss, 16); ss += __shfl_xor(ss, 32);
            const float rn = rsqrtf(ss + 1e-6f);
#pragma unroll
            for (int ni = 0; ni < 4; ++ni) kkn[ni] *= rn;
            { uint4 o0, o1; uint2 t0 = pk4(kkn[0]), t1 = pk4(kkn[1]), t2 = pk4(kkn[2]), t3 = pk4(kkn[3]);
              o0 = make_uint4(t0.x, t0.y, t1.x, t1.y); o1 = make_uint4(t2.x, t2.y, t3.x, t3.y);
              *(uint4*)(KK + (size_t)R * 512 + c0) = o0; *(uint4*)(KK + (size_t)R * 512 + c0 + 8) = o1; }
            float bon = 0.f;
#pragma unroll
            for (int d = 0; d < 2; ++d) {
                f32x4 acc[4];
#pragma unroll
                for (int ni = 0; ni < 4; ++ni) acc[ni] = (f32x4){0.f, 0.f, 0.f, 0.f};
#pragma unroll
                for (int kk = 0; kk < 2; ++kk) {
                    const bf16x8 af = linA[d][kk];
#pragma unroll
                    for (int ni = 0; ni < 4; ++ni) {
                        const bf16x8 bfr = *(const bf16x8*)(Wl + (2 + d) * 64 * 144 + ni * 4 * 144 + kk * 64);
                        acc[ni] = __builtin_amdgcn_mfma_f32_16x16x32_bf16(bfr, af, acc[ni], 0, 0, 0);
                    }
                }
                f32x4 kdv[4], bdv[4];
#pragma unroll
                for (int ni = 0; ni < 4; ++ni) {
                    const int c = c0 + 4 * ni;
                    const f32x4 a = sigm4(acc[ni] + *(const LAS f32x4*)(PR + (6 + d) * 64 + 4 * ni));
                    kdv[ni] = kq[ni] * (1.f + (a - 1.f) * *(const LAS f32x4*)(PR + 4 * 64 + 4 * ni));
                    bdv[ni] = kkn[ni] * a;
                    const f32x4 bt = rq[ni] * kdv[ni] * *(const LAS f32x4*)(PR + 5 * 64 + 4 * ni);
                    bon += (bt[0] + bt[1]) + (bt[2] + bt[3]);
                }
                { uint2 t0 = pk4(kdv[0]), t1 = pk4(kdv[1]), t2 = pk4(kdv[2]), t3 = pk4(kdv[3]);
                  bf16_t* dst = KD + (size_t)d * NTOK * 512 + (size_t)R * 512 + c0;
                  *(uint4*)dst = make_uint4(t0.x, t0.y, t1.x, t1.y); *(uint4*)(dst + 8) = make_uint4(t2.x, t2.y, t3.x, t3.y); }
                { uint2 t0 = pk4(bdv[0]), t1 = pk4(bdv[1]), t2 = pk4(bdv[2]), t3 = pk4(bdv[3]);
                  bf16_t* dst = BD + (size_t)d * NTOK * 512 + (size_t)R * 512 + c0;
                  *(uint4*)dst = make_uint4(t0.x, t0.y, t1.x, t1.y); *(uint4*)(dst + 8) = make_uint4(t2.x, t2.y, t3.x, t3.y); }
            }
            bon += __shfl_xor(bon, 16); bon += __shfl_xor(bon, 32);
            if (fq == 0) BC[(size_t)R * 8 + hd] = bon;
#pragma unroll
            for (int d = 0; d < 2; ++d) {
                f32x4 acc[4];
#pragma unroll
                for (int ni = 0; ni < 4; ++ni) acc[ni] = (f32x4){0.f, 0.f, 0.f, 0.f};
#pragma unroll
                for (int kk = 0; kk < 2; ++kk) {
                    const bf16x8 af = linW[d][kk];
#pragma unroll
                    for (int ni = 0; ni < 4; ++ni) {
                        const bf16x8 bfr = *(const bf16x8*)(Wl + d * 64 * 144 + ni * 4 * 144 + kk * 64);
                        acc[ni] = __builtin_amdgcn_mfma_f32_16x16x32_bf16(bfr, af, acc[ni], 0, 0, 0);
                    }
                }
                uint2 tq[4];
#pragma unroll
                for (int ni = 0; ni < 4; ++ni) tq[ni] = pk4(0.60653066f * sigm4(acc[ni] + *(const LAS f32x4*)(PR + (8 + d) * 64 + 4 * ni)));
                bf16_t* dst = EW + (size_t)d * NTOK * 512 + (size_t)R * 512 + c0;
                *(uint4*)dst = make_uint4(tq[0].x, tq[0].y, tq[1].x, tq[1].y); *(uint4*)(dst + 8) = make_uint4(tq[2].x, tq[2].y, tq[3].x, tq[3].y);
            }
            {
                f32x4 acc[4];
#pragma unroll
                for (int ni = 0; ni < 4; ++ni) acc[ni] = (f32x4){0.f, 0.f, 0.f, 0.f};
#pragma unroll
                for (int kk = 0; kk < 4; ++kk) {
                    const bf16x8 af = linG[kk];
#pragma unroll
                    for (int ni = 0; ni < 4; ++ni) {
                        const bf16x8 bfr = *(const bf16x8*)(Wg + ni * 4 * 272 + kk * 64);
                        acc[ni] = __builtin_amdgcn_mfma_f32_16x16x32_bf16(bfr, af, acc[ni], 0, 0, 0);
                    }
                }
                uint2 tq[4];
#pragma unroll
                for (int ni = 0; ni < 4; ++ni) tq[ni] = pk4(acc[ni]);
                bf16_t* dst = GG + (size_t)R * 512 + c0;
                *(uint4*)dst = make_uint4(tq[0].x, tq[0].y, tq[1].x, tq[1].y); *(uint4*)(dst + 8) = make_uint4(tq[2].x, tq[2].y, tq[3].x, tq[3].y);
            }
        }
        }
    }
}

__device__ __forceinline__ void phase3(const Params& p, char* lds, const XcdBarrier& xb) {
    phase3a(p, lds);
    xcd_barrier(xb);
    phase3b(p, lds);
}

__device__ __forceinline__ int scan_token(int dir, int j) { return dir == 0 ? j : (j < LC ? (LC - 1 - j) : (TT + LC - 1 - j)); }

__device__ __forceinline__ f32x4 bf4_lo(const uint4 v) { return (f32x4){bf2f((bf16_t)(v.x & 0xffff)), bf2f((bf16_t)(v.x >> 16)), bf2f((bf16_t)(v.y & 0xffff)), bf2f((bf16_t)(v.y >> 16))}; }
__device__ __forceinline__ f32x4 bf4_hi(const uint4 v) { return (f32x4){bf2f((bf16_t)(v.z & 0xffff)), bf2f((bf16_t)(v.z >> 16)), bf2f((bf16_t)(v.w & 0xffff)), bf2f((bf16_t)(v.w >> 16))}; }
__device__ __forceinline__ f32x4 exp4n(f32x4 x) { return (f32x4){expf(-x[0]), expf(-x[1]), expf(-x[2]), expf(-x[3])}; }

__device__ __forceinline__ void dot2r_4(float& d0, float& d1, float a0_0, float a0_1, float a0_2, float a0_3, float a1_0, float a1_1, float a1_2, float a1_3, float x0, float x1, float x2, float x3) {
    asm("v_mul_f32 %0, %2, %10\n\t"
        "v_mul_f32 %1, %6, %10\n\t"
        "v_fma_f32 %0, %3, %11, %0\n\t"
        "v_fma_f32 %1, %7, %11, %1\n\t"
        "v_fma_f32 %0, %4, %12, %0\n\t"
        "v_fma_f32 %1, %8, %12, %1\n\t"
        "v_fma_f32 %0, %5, %13, %0\n\t"
        "v_fma_f32 %1, %9, %13, %1\n\t"
        "s_nop 0\n\t"
        "v_add_f32_dpp %0, %0, %0 quad_perm:[1,0,3,2] row_mask:0xf bank_mask:0xf bound_ctrl:1\n\t"
        "v_add_f32_dpp %1, %1, %1 quad_perm:[1,0,3,2] row_mask:0xf bank_mask:0xf bound_ctrl:1\n\t"
        "s_nop 0\n\t"
        "v_add_f32_dpp %0, %0, %0 quad_perm:[2,3,0,1] row_mask:0xf bank_mask:0xf bound_ctrl:1\n\t"
        "v_add_f32_dpp %1, %1, %1 quad_perm:[2,3,0,1] row_mask:0xf bank_mask:0xf bound_ctrl:1\n\t"
        "s_nop 0\n\t"
        "v_add_f32_dpp %0, %0, %0 row_ror:4 row_mask:0xf bank_mask:0xf bound_ctrl:1\n\t"
        "v_add_f32_dpp %1, %1, %1 row_ror:4 row_mask:0xf bank_mask:0xf bound_ctrl:1\n\t"
        "s_nop 0\n\t"
        "v_add_f32_dpp %0, %0, %0 row_ror:8 row_mask:0xf bank_mask:0xf bound_ctrl:1\n\t"
        "v_add_f32_dpp %1, %1, %1 row_ror:8 row_mask:0xf bank_mask:0xf bound_ctrl:1\n\t"
        "s_nop 1\n\t"
        : "=&v"(d0), "=&v"(d1)
        : "v"(a0_0), "v"(a0_1), "v"(a0_2), "v"(a0_3), "v"(a1_0), "v"(a1_1), "v"(a1_2), "v"(a1_3), "v"(x0), "v"(x1), "v"(x2), "v"(x3));
}

__device__ __forceinline__ void dot2r_8(float& d0, float& d1, float a0_0, float a0_1, float a0_2, float a0_3, float a0_4, float a0_5, float a0_6, float a0_7, float a1_0, float a1_1, float a1_2, float a1_3, float a1_4, float a1_5, float a1_6, float a1_7, float x0, float x1, float x2, float x3, float x4, float x5, float x6, float x7) {
    asm("v_mul_f32 %0, %2, %18\n\t"
        "v_mul_f32 %1, %10, %18\n\t"
        "v_fma_f32 %0, %3, %19, %0\n\t"
        "v_fma_f32 %1, %11, %19, %1\n\t"
        "v_fma_f32 %0, %4, %20, %0\n\t"
        "v_fma_f32 %1, %12, %20, %1\n\t"
        "v_fma_f32 %0, %5, %21, %0\n\t"
        "v_fma_f32 %1, %13, %21, %1\n\t"
        "v_fma_f32 %0, %6, %22, %0\n\t"
        "v_fma_f32 %1, %14, %22, %1\n\t"
        "v_fma_f32 %0, %7, %23, %0\n\t"
        "v_fma_f32 %1, %15, %23, %1\n\t"
        "v_fma_f32 %0, %8, %24, %0\n\t"
        "v_fma_f32 %1, %16, %24, %1\n\t"
        "v_fma_f32 %0, %9, %25, %0\n\t"
        "v_fma_f32 %1, %17, %25, %1\n\t"
        "s_nop 0\n\t"
        "v_add_f32_dpp %0, %0, %0 quad_perm:[1,0,3,2] row_mask:0xf bank_mask:0xf bound_ctrl:1\n\t"
        "v_add_f32_dpp %1, %1, %1 quad_perm:[1,0,3,2] row_mask:0xf bank_mask:0xf bound_ctrl:1\n\t"
        "s_nop 0\n\t"
        "v_add_f32_dpp %0, %0, %0 quad_perm:[2,3,0,1] row_mask:0xf bank_mask:0xf bound_ctrl:1\n\t"
        "v_add_f32_dpp %1, %1, %1 quad_perm:[2,3,0,1] row_mask:0xf bank_mask:0xf bound_ctrl:1\n\t"
        "s_nop 0\n\t"
        "v_add_f32_dpp %0, %0, %0 row_ror:4 row_mask:0xf bank_mask:0xf bound_ctrl:1\n\t"
        "v_add_f32_dpp %1, %1, %1 row_ror:4 row_mask:0xf bank_mask:0xf bound_ctrl:1\n\t"
        "s_nop 0\n\t"
        "v_add_f32_dpp %0, %0, %0 row_ror:8 row_mask:0xf bank_mask:0xf bound_ctrl:1\n\t"
        "v_add_f32_dpp %1, %1, %1 row_ror:8 row_mask:0xf bank_mask:0xf bound_ctrl:1\n\t"
        "s_nop 1\n\t"
        : "=&v"(d0), "=&v"(d1)
        : "v"(a0_0), "v"(a0_1), "v"(a0_2), "v"(a0_3), "v"(a0_4), "v"(a0_5), "v"(a0_6), "v"(a0_7), "v"(a1_0), "v"(a1_1), "v"(a1_2), "v"(a1_3), "v"(a1_4), "v"(a1_5), "v"(a1_6), "v"(a1_7), "v"(x0), "v"(x1), "v"(x2), "v"(x3), "v"(x4), "v"(x5), "v"(x6), "v"(x7));
}

__device__ __forceinline__ void rwkv_upd2(float (&s0)[4], float (&s1)[4], f32x4 w, f32x4 kd, f32x4 bb, float v0, float v1, float sa0, float sa1) {
    float t0, t1;
    asm("v_mul_f32 %8, %22, %14\n\t"
        "v_mul_f32 %9, %23, %14\n\t"
        "v_fma_f32 %8, -%24, %18, %8\n\t"
        "v_fma_f32 %9, -%25, %18, %9\n\t"
        "v_fma_f32 %0, %0, %10, %8\n\t"
        "v_fma_f32 %4, %4, %10, %9\n\t"
        "v_mul_f32 %8, %22, %15\n\t"
        "v_mul_f32 %9, %23, %15\n\t"
        "v_fma_f32 %8, -%24, %19, %8\n\t"
        "v_fma_f32 %9, -%25, %19, %9\n\t"
        "v_fma_f32 %1, %1, %11, %8\n\t"
        "v_fma_f32 %5, %5, %11, %9\n\t"
        "v_mul_f32 %8, %22, %16\n\t"
        "v_mul_f32 %9, %23, %16\n\t"
        "v_fma_f32 %8, -%24, %20, %8\n\t"
        "v_fma_f32 %9, -%25, %20, %9\n\t"
        "v_fma_f32 %2, %2, %12, %8\n\t"
        "v_fma_f32 %6, %6, %12, %9\n\t"
        "v_mul_f32 %8, %22, %17\n\t"
        "v_mul_f32 %9, %23, %17\n\t"
        "v_fma_f32 %8, -%24, %21, %8\n\t"
        "v_fma_f32 %9, -%25, %21, %9\n\t"
        "v_fma_f32 %3, %3, %13, %8\n\t"
        "v_fma_f32 %7, %7, %13, %9\n\t"
        : "+v"(s0[0]), "+v"(s0[1]), "+v"(s0[2]), "+v"(s0[3]), "+v"(s1[0]), "+v"(s1[1]), "+v"(s1[2]), "+v"(s1[3]), "=&v"(t0), "=&v"(t1)
        : "v"(w[0]), "v"(w[1]), "v"(w[2]), "v"(w[3]), "v"(kd[0]), "v"(kd[1]), "v"(kd[2]), "v"(kd[3]), "v"(bb[0]), "v"(bb[1]), "v"(bb[2]), "v"(bb[3]), "v"(v0), "v"(v1), "v"(sa0), "v"(sa1));
}

__device__ __forceinline__ void gdn_upd2(float (&s0)[8], float (&s1)[8], f32x4 ka, f32x4 kb, float eg, float d0, float d1) {
    float t0, t1;
    asm("v_mul_f32 %16, %18, %27\n\t"
        "v_mul_f32 %17, %18, %28\n\t"
        "v_fma_f32 %0, %26, %0, %16\n\t"
        "v_fma_f32 %8, %26, %8, %17\n\t"
        "v_mul_f32 %16, %19, %27\n\t"
        "v_mul_f32 %17, %19, %28\n\t"
        "v_fma_f32 %1, %26, %1, %16\n\t"
        "v_fma_f32 %9, %26, %9, %17\n\t"
        "v_mul_f32 %16, %20, %27\n\t"
        "v_mul_f32 %17, %20, %28\n\t"
        "v_fma_f32 %2, %26, %2, %16\n\t"
        "v_fma_f32 %10, %26, %10, %17\n\t"
        "v_mul_f32 %16, %21, %27\n\t"
        "v_mul_f32 %17, %21, %28\n\t"
        "v_fma_f32 %3, %26, %3, %16\n\t"
        "v_fma_f32 %11, %26, %11, %17\n\t"
        "v_mul_f32 %16, %22, %27\n\t"
        "v_mul_f32 %17, %22, %28\n\t"
        "v_fma_f32 %4, %26, %4, %16\n\t"
        "v_fma_f32 %12, %26, %12, %17\n\t"
        "v_mul_f32 %16, %23, %27\n\t"
        "v_mul_f32 %17, %23, %28\n\t"
        "v_fma_f32 %5, %26, %5, %16\n\t"
        "v_fma_f32 %13, %26, %13, %17\n\t"
        "v_mul_f32 %16, %24, %27\n\t"
        "v_mul_f32 %17, %24, %28\n\t"
        "v_fma_f32 %6, %26, %6, %16\n\t"
        "v_fma_f32 %14, %26, %14, %17\n\t"
        "v_mul_f32 %16, %25, %27\n\t"
        "v_mul_f32 %17, %25, %28\n\t"
        "v_fma_f32 %7, %26, %7, %16\n\t"
        "v_fma_f32 %15, %26, %15, %17\n\t"
        : "+v"(s0[0]), "+v"(s0[1]), "+v"(s0[2]), "+v"(s0[3]), "+v"(s0[4]), "+v"(s0[5]), "+v"(s0[6]), "+v"(s0[7]), "+v"(s1[0]), "+v"(s1[1]), "+v"(s1[2]), "+v"(s1[3]), "+v"(s1[4]), "+v"(s1[5]), "+v"(s1[6]), "+v"(s1[7]), "=&v"(t0), "=&v"(t1)
        : "v"(ka[0]), "v"(ka[1]), "v"(ka[2]), "v"(ka[3]), "v"(kb[0]), "v"(kb[1]), "v"(kb[2]), "v"(kb[3]), "v"(eg), "v"(d0), "v"(d1));
}

template <bool DO_R, bool DO_G>
__device__ __forceinline__ void phase4_seq(const Params& p, char* lds) {
    float* Ws = (float*)lds;
    float* Ks = Ws + 2048;
    float* Bs = Ks + 2048;
    float* Ds = Bs + 2048;
    float* Rs = Ds + 2048;
    float* Vs = Rs + 2048;
    float* Yo = Vs + 1024;
    float* Kc = Yo + 1024;
    float* Qc = Kc + 4096;
    float* Vc = Qc + 4096;
    float* Oo = Vc + 1024;
    float* Gc = Oo + 1024;
    float* Bc = Gc + 32;
    const int t = threadIdx.x;
    const bool isR = t < 256;
    const bool act = isR ? DO_R : DO_G;
    const int tl = t & 255;
    const int grp = tl >> 4, sub = tl & 15;
    const int sstep = tl >> 3, sq = tl & 7;
    for (int u = blockIdx.x; u < 256; u += gridDim.x) {
        const int rscan = u >> 1, rhalf = u & 1;
        const int rb = rscan >> 4, rh = (rscan >> 1) & 7, rdir = rscan & 1;
        const int gscan = u >> 2, gquart = u & 3;
        const int gb = gscan >> 3, gh = (gscan >> 1) & 3, gdir = gscan & 1;
        const bf16_t* EW = (const bf16_t*)(p.ws + B_EW) + (size_t)rdir * NTOK * 512;
        const bf16_t* KD = (const bf16_t*)(p.ws + B_KD) + (size_t)rdir * NTOK * 512;
        const bf16_t* BD = (const bf16_t*)(p.ws + B_BD) + (size_t)rdir * NTOK * 512;
        const bf16_t* RR = (const bf16_t*)(p.ws + B_RR); const bf16_t* KK = (const bf16_t*)(p.ws + B_KK); const bf16_t* VV = (const bf16_t*)(p.ws + B_VV);
        bf16_t* Y = (bf16_t*)(p.ws + (rdir == 0 ? B_YF : B_YB));
        const bf16_t* GQ = (const bf16_t*)(p.ws + B_GQ); const bf16_t* GK = (const bf16_t*)(p.ws + B_GK); const bf16_t* GV = (const bf16_t*)(p.ws + B_GV);
        const float* GDG = (const float*)(p.ws + B_GDG); const float* GDB = (const float*)(p.ws + B_GDB);
        bf16_t* O = (bf16_t*)(p.ws + (gdir == 0 ? B_OF : B_OB));
        float SR[2][4], SG[2][8];
#pragma unroll
        for (int i = 0; i < 4; ++i) { SR[0][i] = 0.f; SR[1][i] = 0.f; }
#pragma unroll
        for (int i = 0; i < 8; ++i) { SG[0][i] = 0.f; SG[1][i] = 0.f; }
        for (int chunk = 0; chunk < TT / 32; ++chunk) {
            if (!act) {
            } else if (isR) {
                const int s = scan_token(rdir, chunk * 32 + sstep);
                const size_t o = (size_t)(rb * TT + s) * 512 + rh * 64 + sq * 8;
                const uint4 e = *(const uint4*)(EW + o), kk = *(const uint4*)(KK + o), bb = *(const uint4*)(BD + o), kd = *(const uint4*)(KD + o), rr = *(const uint4*)(RR + o);
                const int li = sstep * 64 + sq * 8;
                *(f32x4*)(Ws + li) = exp4n(bf4_lo(e)); *(f32x4*)(Ws + li + 4) = exp4n(bf4_hi(e));
                *(f32x4*)(Ks + li) = bf4_lo(kk); *(f32x4*)(Ks + li + 4) = bf4_hi(kk);
                *(f32x4*)(Bs + li) = bf4_lo(bb); *(f32x4*)(Bs + li + 4) = bf4_hi(bb);
                *(f32x4*)(Ds + li) = bf4_lo(kd); *(f32x4*)(Ds + li + 4) = bf4_hi(kd);
                *(f32x4*)(Rs + li) = bf4_lo(rr); *(f32x4*)(Rs + li + 4) = bf4_hi(rr);
                *(f32x4*)(Vs + sstep * 32 + sq * 4) = ld_bf4(VV + (size_t)(rb * TT + s) * 512 + rh * 64 + rhalf * 32 + sq * 4);
            } else {
                const int s = scan_token(gdir, chunk * 32 + sstep);
                const size_t R = (size_t)(gb * TT + s);
                const uint4 k0 = *(const uint4*)(GK + R * 512 + gh * 128 + sq * 16), k1 = *(const uint4*)(GK + R * 512 + gh * 128 + sq * 16 + 8);
                const uint4 q0 = *(const uint4*)(GQ + R * 512 + gh * 128 + sq * 16), q1 = *(const uint4*)(GQ + R * 512 + gh * 128 + sq * 16 + 8);
                float* kd = Kc + sstep * 128 + sq * 16; float* qd = Qc + sstep * 128 + sq * 16;
                *(f32x4*)(kd) = bf4_lo(k0); *(f32x4*)(kd + 4) = bf4_hi(k0); *(f32x4*)(kd + 8) = bf4_lo(k1); *(f32x4*)(kd + 12) = bf4_hi(k1);
                *(f32x4*)(qd) = bf4_lo(q0); *(f32x4*)(qd + 4) = bf4_hi(q0); *(f32x4*)(qd + 8) = bf4_lo(q1); *(f32x4*)(qd + 12) = bf4_hi(q1);
                *(f32x4*)(Vc + sstep * 32 + sq * 4) = ld_bf4(GV + R * 512 + gh * 128 + gquart * 32 + sq * 4);
                if (tl < 32) {
                    const int s2 = scan_token(gdir, chunk * 32 + tl);
                    const size_t R2 = (size_t)(gb * TT + s2);
                    Gc[tl] = expf(GDG[R2 * 8 + gdir * 4 + gh]);
                    Bc[tl] = GDB[R2 * 8 + gdir * 4 + gh];
                }
            }
            __syncthreads();
            if (!act) {
            } else if (isR) {
                const int c4 = sub * 4;
                f32x4 kk = *(const f32x4*)(Ks + c4), wv = *(const f32x4*)(Ws + c4), bb = *(const f32x4*)(Bs + c4), kd = *(const f32x4*)(Ds + c4), rv = *(const f32x4*)(Rs + c4);
                float v0 = Vs[grp], v1 = Vs[16 + grp];
#pragma unroll 2
                for (int step = 0; step < 32; ++step) {
                    const int nx = (step + 1 < 32 ? step + 1 : step) * 64 + c4;
                    const f32x4 kkn = *(const f32x4*)(Ks + nx), wvn = *(const f32x4*)(Ws + nx), bbn = *(const f32x4*)(Bs + nx), kdn = *(const f32x4*)(Ds + nx), rvn = *(const f32x4*)(Rs + nx);
                    const int nv = (step + 1 < 32 ? step + 1 : step) * 32;
                    const float v0n = Vs[nv + grp], v1n = Vs[nv + 16 + grp];
                    float sa0, sa1, y0, y1;
                    dot2r_4(sa0, sa1, SR[0][0], SR[0][1], SR[0][2], SR[0][3], SR[1][0], SR[1][1], SR[1][2], SR[1][3], kk[0], kk[1], kk[2], kk[3]);
                    rwkv_upd2(SR[0], SR[1], wv, kd, bb, v0, v1, sa0, sa1);
                    dot2r_4(y0, y1, SR[0][0], SR[0][1], SR[0][2], SR[0][3], SR[1][0], SR[1][1], SR[1][2], SR[1][3], rv[0], rv[1], rv[2], rv[3]);
                    if (sub == 0) { Yo[step * 32 + grp] = y0; Yo[step * 32 + 16 + grp] = y1; }
                    kk = kkn; wv = wvn; bb = bbn; kd = kdn; rv = rvn; v0 = v0n; v1 = v1n;
                }
            } else {
                const int k8 = sub * 8;
                f32x4 ka = *(const f32x4*)(Kc + k8), kb = *(const f32x4*)(Kc + k8 + 4), qa = *(const f32x4*)(Qc + k8), qb = *(const f32x4*)(Qc + k8 + 4);
                float v0 = Vc[grp], v1 = Vc[16 + grp], eg = Gc[0], be = Bc[0];
#pragma unroll 2
                for (int step = 0; step < 32; ++step) {
                    const int ns = (step + 1 < 32 ? step + 1 : step);
                    const f32x4 kan = *(const f32x4*)(Kc + ns * 128 + k8), kbn = *(const f32x4*)(Kc + ns * 128 + k8 + 4), qan = *(const f32x4*)(Qc + ns * 128 + k8), qbn = *(const f32x4*)(Qc + ns * 128 + k8 + 4);
                    const float v0n = Vc[ns * 32 + grp], v1n = Vc[ns * 32 + 16 + grp], egn = Gc[ns], ben = Bc[ns];
                    float ks0, ks1, o0, o1;
                    dot2r_8(ks0, ks1, SG[0][0], SG[0][1], SG[0][2], SG[0][3], SG[0][4], SG[0][5], SG[0][6], SG[0][7], SG[1][0], SG[1][1], SG[1][2], SG[1][3], SG[1][4], SG[1][5], SG[1][6], SG[1][7],
                            ka[0], ka[1], ka[2], ka[3], kb[0], kb[1], kb[2], kb[3]);
                    const float d0 = be * (v0 - eg * ks0), d1 = be * (v1 - eg * ks1);
                    gdn_upd2(SG[0], SG[1], ka, kb, eg, d0, d1);
                    dot2r_8(o0, o1, SG[0][0], SG[0][1], SG[0][2], SG[0][3], SG[0][4], SG[0][5], SG[0][6], SG[0][7], SG[1][0], SG[1][1], SG[1][2], SG[1][3], SG[1][4], SG[1][5], SG[1][6], SG[1][7],
                            qa[0], qa[1], qa[2], qa[3], qb[0], qb[1], qb[2], qb[3]);
                    if (sub == 0) { Oo[step * 32 + grp] = o0; Oo[step * 32 + 16 + grp] = o1; }
                    ka = kan; kb = kbn; qa = qan; qb = qbn; v0 = v0n; v1 = v1n; eg = egn; be = ben;
                }
            }
            __syncthreads();
            if (!act) {
            } else if (isR) {
                const int s = scan_token(rdir, chunk * 32 + sstep);
                st_bf4(Y + (size_t)(rb * TT + s) * 512 + rh * 64 + rhalf * 32 + sq * 4, *(const f32x4*)(Yo + sstep * 32 + sq * 4));
            } else {
                const int s = scan_token(gdir, chunk * 32 + sstep);
                st_bf4(O + (size_t)(gb * TT + s) * 512 + gh * 128 + gquart * 32 + sq * 4, *(const f32x4*)(Oo + sstep * 32 + sq * 4));
            }
        }
        __syncthreads();
    }
}


template <int I> __device__ __forceinline__ void fs_load_row(const LAS char* L, f32x4 (&l)[16]) {
#pragma unroll
    for (int j4 = 0; j4 < (I + 3) / 4; ++j4) l[j4] = *(const LAS f32x4*)(L + I * 256 + j4 * 16);
}
template <int I> __device__ __forceinline__ void fs_do_row(const f32x4 (&l)[16], float (&m)[64], int lane) {
    float a0 = (I == lane) ? 1.f : 0.f, a1 = 0.f, a2 = 0.f, a3 = 0.f;
#pragma unroll
    for (int j4 = 0; j4 < (I + 3) / 4; ++j4) {
        if (4 * j4 + 0 < I) a0 -= l[j4][0] * m[4 * j4 + 0];
        if (4 * j4 + 1 < I) a1 -= l[j4][1] * m[4 * j4 + 1];
        if (4 * j4 + 2 < I) a2 -= l[j4][2] * m[4 * j4 + 2];
        if (4 * j4 + 3 < I) a3 -= l[j4][3] * m[4 * j4 + 3];
    }
    m[I] = (a0 + a1) + (a2 + a3);
}
template <int I> struct FsRows {
    static __device__ __forceinline__ void run(const LAS char* L, float (&m)[64], int lane) {
        f32x4 ra[16];
        fs_load_row<I>(L, ra);
        fs_do_row<I>(ra, m, lane);
        __builtin_amdgcn_sched_barrier(0);
        if constexpr (I + 1 < 64) FsRows<I + 1>::run(L, m, lane);
    }
};
__device__ __forceinline__ void fs_solve(const LAS char* L, float (&m)[64], int lane) { FsRows<0>::run(L, m, lane); }

__device__ __forceinline__ float wave_incl_scan(float x, int lane) {
    (void)lane;
    x += __builtin_bit_cast(float, __builtin_amdgcn_update_dpp(0, __builtin_bit_cast(int, x), 0x111, 0xf, 0xf, true));
    x += __builtin_bit_cast(float, __builtin_amdgcn_update_dpp(0, __builtin_bit_cast(int, x), 0x112, 0xf, 0xf, true));
    x += __builtin_bit_cast(float, __builtin_amdgcn_update_dpp(0, __builtin_bit_cast(int, x), 0x114, 0xf, 0xf, true));
    x += __builtin_bit_cast(float, __builtin_amdgcn_update_dpp(0, __builtin_bit_cast(int, x), 0x118, 0xf, 0xf, true));
    x += __builtin_bit_cast(float, __builtin_amdgcn_update_dpp(0, __builtin_bit_cast(int, x), 0x142, 0xa, 0xf, false));
    x += __builtin_bit_cast(float, __builtin_amdgcn_update_dpp(0, __builtin_bit_cast(int, x), 0x143, 0xc, 0xf, false));
    return x;
}
__device__ __forceinline__ float lane63(float x) { return __builtin_bit_cast(float, __builtin_amdgcn_readlane(__builtin_bit_cast(int, x), 63)); }

__device__ __forceinline__ void phase4a(const Params& p, char* lds) {
    const int t = threadIdx.x, lane = t & 63, w = t >> 6, fr = lane & 15, fq = lane >> 4;
    unsigned lb = (unsigned)(w * 16384);
    asm volatile("" : "+v"(lb));
    LAS char* Lw = (LAS char*)lds + lb;
    LAS float* GCw = (LAS float*)((LAS char*)lds + 131072 + w * 512);
    const bf16_t* GK = (const bf16_t*)(p.ws + B_GK);
    const float* GDG = (const float*)(p.ws + B_GDG); const float* GDB = (const float*)(p.ws + B_GDB);
    const bf16_t* KK = (const bf16_t*)(p.ws + B_KK);
    bf16_t* GMW = (bf16_t*)(p.ws + C_GMW); bf16_t* GMU = (bf16_t*)(p.ws + C_GMU); bf16_t* RM = (bf16_t*)(p.ws + C_RM);
    const int nwave = gridDim.x * 8;
    for (int q = blockIdx.x * 8 + w; q < 6912; q += nwave) {
        float m[64];
        float gcl = 0.f, bel = 0.f;
        if (q >= 4608) {
            const int qq = q - 4608, sg = qq / 36, n = qq % 36;
            const int b = sg >> 3, h = (sg >> 1) & 3, dir = sg & 1;
            {
                const size_t R = (size_t)(b * TT + scan_token(dir, 64 * n + lane));
                gcl = wave_incl_scan(GDG[R * 8 + dir * 4 + h], lane);
                bel = GDB[R * 8 + dir * 4 + h];
                GCw[lane] = gcl; GCw[64 + lane] = bel;
            }
            bf16x8 kf[4][4];
#pragma unroll
            for (int tt = 0; tt < 4; ++tt) {
                const size_t R = (size_t)(b * TT + scan_token(dir, 64 * n + 16 * tt + fr));
#pragma unroll
                for (int kk = 0; kk < 4; ++kk) kf[tt][kk] = *(const bf16x8*)(GK + R * 512 + h * 128 + 32 * kk + 8 * fq);
            }
#pragma unroll
            for (int ti = 0; ti < 4; ++ti)
#pragma unroll
                for (int tj = 0; tj <= ti; ++tj) {
                    f32x4 acc = (f32x4){0.f, 0.f, 0.f, 0.f};
#pragma unroll
                    for (int kk = 0; kk < 4; ++kk) acc = __builtin_amdgcn_mfma_f32_16x16x32_bf16(kf[ti][kk], kf[tj][kk], acc, 0, 0, 0);
                    const int j = 16 * tj + fr;
                    const float gcj = GCw[j];
#pragma unroll
                    for (int r = 0; r < 4; ++r) {
                        const int i = 16 * ti + 4 * fq + r;
                        const float v = (i > j) ? GCw[64 + i] * acc[r] * expf(fminf(GCw[i] - gcj, 0.f)) : 0.f;
                        *(LAS float*)(Lw + i * 256 + j * 4) = v;
                    }
                }
        } else {
            const int sr = q / 36, n = q % 36;
            const int b = sr >> 4, h = (sr >> 1) & 7, dir = sr & 1;
            const bf16_t* EW = (const bf16_t*)(p.ws + B_EW) + (size_t)dir * NTOK * 512;
            const bf16_t* BD = (const bf16_t*)(p.ws + B_BD) + (size_t)dir * NTOK * 512;
            {
                const size_t o = (size_t)(b * TT + scan_token(dir, 64 * n + lane)) * 512 + h * 64;
                uint4 ewq[8], kkq[8], bdq[8];
#pragma unroll
                for (int part = 0; part < 8; ++part) { ewq[part] = *(const uint4*)(EW + o + part * 8); kkq[part] = *(const uint4*)(KK + o + part * 8); bdq[part] = *(const uint4*)(BD + o + part * 8); }
#pragma unroll
                for (int part = 0; part < 8; ++part) {
                    float ew[8], kkv[8], bv[8], okt[8], obh[8];
                    unpack8(ewq[part], ew); unpack8(kkq[part], kkv); unpack8(bdq[part], bv);
#pragma unroll
                    for (int e = 0; e < 8; ++e) {
                        const float lam = -wave_incl_scan(ew[e], lane);
                        const float el = __expf(lam);
                        okt[e] = kkv[e] * (el * __expf(ew[e]));
                        obh[e] = bv[e] * __builtin_amdgcn_rcpf(el);
                    }
                    const u32x4 q1 = (u32x4){pack2(okt[0], okt[1]), pack2(okt[2], okt[3]), pack2(okt[4], okt[5]), pack2(okt[6], okt[7])};
                    const u32x4 q2 = (u32x4){pack2(obh[0], obh[1]), pack2(obh[2], obh[3]), pack2(obh[4], obh[5]), pack2(obh[6], obh[7])};
                    *(LAS u32x4*)(Lw + lane * 128 + part * 16) = q1;
                    *(LAS u32x4*)(Lw + 8192 + lane * 128 + part * 16) = q2;
                }
            }
            f32x4 acc[10];
            {
                int tix = 0;
#pragma unroll
                for (int ti = 0; ti < 4; ++ti)
#pragma unroll
                    for (int tj = 0; tj <= ti; ++tj) {
                        f32x4 a = (f32x4){0.f, 0.f, 0.f, 0.f};
#pragma unroll
                        for (int kk = 0; kk < 2; ++kk) {
                            const bf16x8 xf = *(const LAS bf16x8*)(Lw + (16 * ti + fr) * 128 + (32 * kk + 8 * fq) * 2);
                            const bf16x8 yf = *(const LAS bf16x8*)(Lw + 8192 + (16 * tj + fr) * 128 + (32 * kk + 8 * fq) * 2);
                            a = __builtin_amdgcn_mfma_f32_16x16x32_bf16(xf, yf, a, 0, 0, 0);
                        }
                        acc[tix++] = a;
                    }
            }
            asm volatile("s_waitcnt lgkmcnt(0)" ::: "memory");
            {
                int tix = 0;
#pragma unroll
                for (int ti = 0; ti < 4; ++ti)
#pragma unroll
                    for (int tj = 0; tj <= ti; ++tj) {
                        const f32x4 a = acc[tix++];
                        const int j = 16 * tj + fr;
#pragma unroll
                        for (int r = 0; r < 4; ++r) {
                            const int i = 16 * ti + 4 * fq + r;
                            *(LAS float*)(Lw + i * 256 + j * 4) = (i > j) ? a[r] : 0.f;
                        }
                    }
            }
        }
        asm volatile("s_waitcnt lgkmcnt(0)" ::: "memory");
        fs_solve(Lw, m, lane);
        if (q >= 4608) {
            const float su = bel, sw = bel * expf(gcl);
            bf16_t* dw = GMW + (size_t)(q - 4608) * 4096 + lane; bf16_t* du = GMU + (size_t)(q - 4608) * 4096 + lane;
#pragma unroll
            for (int i = 0; i < 64; ++i) { dw[i * 64] = f2bf(m[i] * sw); du[i * 64] = f2bf(m[i] * su); }
        } else {
            bf16_t* dm = RM + (size_t)q * 4096 + lane;
#pragma unroll
            for (int i = 0; i < 64; ++i) dm[i * 64] = f2bf(m[i]);
        }
        asm volatile("s_waitcnt lgkmcnt(0)" ::: "memory");
    }
}

#define PIN4(q) asm volatile("" : "+v"((q).x), "+v"((q).y), "+v"((q).z), "+v"((q).w))
constexpr int S144 = 144, S272 = 272;
constexpr int G_KROW = 0;
constexpr int G_QROW = G_KROW + 64 * S272;
constexpr int G_W = G_QROW + 64 * S272;
constexpr int G_ST = G_W + 64 * S272;
constexpr int G_KT = G_ST + 64 * S272;
constexpr int G_VT = G_KT + 128 * S144;
constexpr int G_MW = G_VT + 64 * S144;
constexpr int G_MU = G_MW + 64 * S144;
constexpr int G_AQK = G_MU + 64 * S144;
constexpr int G_UT = G_AQK + 64 * S144;
constexpr int G_VNT = G_UT + 64 * S144;
constexpr int G_VST = G_VNT + 64 * S144;
constexpr int G_GC = G_VST + 64 * S144;
constexpr int G_END = G_GC + 256;
static_assert(G_END <= LDS_MAIN, "DeltaNet chunk LDS map too large");

template <int K>
__device__ __forceinline__ void mm_nt(f32x4& acc, const char* xrow, const char* yrow) {
#pragma unroll
    for (int kk = 0; kk < K / 32; ++kk) {
        const bf16x8 xf = *(const bf16x8*)(xrow + kk * 64), yf = *(const bf16x8*)(yrow + kk * 64);
        acc = __builtin_amdgcn_mfma_f32_16x16x32_bf16(xf, yf, acc, 0, 0, 0);
    }
}

__device__ __forceinline__ void gdn_chunk_unit(const Params& p, int u, char* lds) {
    const int scan = u >> 1, hf = u & 1;
    const int b = scan >> 3, h = (scan >> 1) & 3, dir = scan & 1;
    const bf16_t* GQ = (const bf16_t*)(p.ws + B_GQ); const bf16_t* GK = (const bf16_t*)(p.ws + B_GK); const bf16_t* GV = (const bf16_t*)(p.ws + B_GV);
    const float* GDG = (const float*)(p.ws + B_GDG);
    const bf16_t* GMW = (const bf16_t*)(p.ws + C_GMW) + (size_t)scan * 36 * 4096; const bf16_t* GMU = (const bf16_t*)(p.ws + C_GMU) + (size_t)scan * 36 * 4096;
    bf16_t* O = (bf16_t*)(p.ws + (dir == 0 ? B_OF : B_OB));
    float* GC = (float*)(lds + G_GC);
    const int t = threadIdx.x, lane = t & 63, w = t >> 6, fr = lane & 15, fq = lane >> 4;
    for (int i = t; i < 64 * S272 / 16; i += NTHR) ((uint4*)(lds + G_ST))[i] = make_uint4(0u, 0u, 0u, 0u);
    f32x4 Sreg[4];
#pragma unroll
    for (int tc = 0; tc < 4; ++tc) Sreg[tc] = (f32x4){0.f, 0.f, 0.f, 0.f};
    uint4 pk0, pk1, pq0, pq1, pv0, pmw, pmu; float pg;
    {
        const size_t R0 = (size_t)(b * TT + scan_token(dir, lane));
        pk0 = *(const uint4*)(GK + R0 * 512 + h * 128 + w * 16); pk1 = *(const uint4*)(GK + R0 * 512 + h * 128 + w * 16 + 8);
        pq0 = *(const uint4*)(GQ + R0 * 512 + h * 128 + w * 16); pq1 = *(const uint4*)(GQ + R0 * 512 + h * 128 + w * 16 + 8);
        pv0 = *(const uint4*)(GV + R0 * 512 + h * 128 + 64 * hf + w * 8);
        pmw = *(const uint4*)(GMW + t * 8); pmu = *(const uint4*)(GMU + t * 8);
        pg = GDG[R0 * 8 + dir * 4 + h];
    }
    __syncthreads();
    for (int n = 0; n < TT / 64; ++n) {
        {
            const int i = lane, part = w;
            PIN4(pk0); PIN4(pk1); PIN4(pq0); PIN4(pq1); PIN4(pv0); PIN4(pmw); PIN4(pmu); asm volatile("" : "+v"(pg));
            const uint4 k0 = pk0, k1 = pk1, q0 = pq0, q1 = pq1, v0 = pv0, mw = pmw, mu = pmu;
            const float gcur = pg;
            if (n + 1 < TT / 64) {
                const size_t Rn = (size_t)(b * TT + scan_token(dir, 64 * (n + 1) + i));
                pk0 = *(const uint4*)(GK + Rn * 512 + h * 128 + part * 16); pk1 = *(const uint4*)(GK + Rn * 512 + h * 128 + part * 16 + 8);
                pq0 = *(const uint4*)(GQ + Rn * 512 + h * 128 + part * 16); pq1 = *(const uint4*)(GQ + Rn * 512 + h * 128 + part * 16 + 8);
                pv0 = *(const uint4*)(GV + Rn * 512 + h * 128 + 64 * hf + part * 8);
                pmw = *(const uint4*)(GMW + (size_t)(n + 1) * 4096 + t * 8); pmu = *(const uint4*)(GMU + (size_t)(n + 1) * 4096 + t * 8);
                pg = GDG[Rn * 8 + dir * 4 + h];
            }
            *(uint4*)(lds + G_KROW + i * S272 + part * 32) = k0; *(uint4*)(lds + G_KROW + i * S272 + part * 32 + 16) = k1;
            *(uint4*)(lds + G_QROW + i * S272 + part * 32) = q0; *(uint4*)(lds + G_QROW + i * S272 + part * 32 + 16) = q1;
            *(uint4*)(lds + G_MW + (t >> 3) * S144 + (t & 7) * 16) = mw; *(uint4*)(lds + G_MU + (t >> 3) * S144 + (t & 7) * 16) = mu;
            const unsigned kw[8] = {k0.x, k0.y, k0.z, k0.w, k1.x, k1.y, k1.z, k1.w};
#pragma unroll
            for (int e = 0; e < 8; ++e) {
                *(bf16_t*)(lds + G_KT + (part * 16 + 2 * e) * S144 + i * 2) = (bf16_t)(kw[e] & 0xffff);
                *(bf16_t*)(lds + G_KT + (part * 16 + 2 * e + 1) * S144 + i * 2) = (bf16_t)(kw[e] >> 16);
            }
            const unsigned vw[4] = {v0.x, v0.y, v0.z, v0.w};
#pragma unroll
            for (int e = 0; e < 4; ++e) {
                *(bf16_t*)(lds + G_VT + (part * 8 + 2 * e) * S144 + i * 2) = (bf16_t)(vw[e] & 0xffff);
                *(bf16_t*)(lds + G_VT + (part * 8 + 2 * e + 1) * S144 + i * 2) = (bf16_t)(vw[e] >> 16);
            }
            if (w == 0) GC[lane] = wave_incl_scan(gcur, lane);
        }
        __syncthreads();
        {
            const int ti = w >> 1;
#pragma unroll
            for (int tjj = 0; tjj < 2; ++tjj) {
                const int tj = 2 * (w & 1) + tjj;
                f32x4 aqk = (f32x4){0.f, 0.f, 0.f, 0.f};
                if (tj <= ti) mm_nt<128>(aqk, lds + G_QROW + (16 * ti + fr) * S272 + fq * 16, lds + G_KROW + (16 * tj + fr) * S272 + fq * 16);
                const int j = 16 * tj + fr;
                const float gcj = GC[j];
#pragma unroll
                for (int r = 0; r < 4; ++r) {
                    const int i = 16 * ti + 4 * fq + r;
                    *(bf16_t*)(lds + G_AQK + i * S144 + j * 2) = f2bf((i >= j) ? aqk[r] * expf(fminf(GC[i] - gcj, 0.f)) : 0.f);
                }
            }
#pragma unroll
            for (int ti2 = 0; ti2 < 4; ++ti2) {
                f32x4 acc = (f32x4){0.f, 0.f, 0.f, 0.f};
                mm_nt<64>(acc, lds + G_KT + (16 * w + fr) * S144 + fq * 16, lds + G_MW + (16 * ti2 + fr) * S144 + fq * 16);
                *(uint2*)(lds + G_W + (16 * ti2 + fr) * S272 + (16 * w + 4 * fq) * 2) = pk4(acc);
            }
#pragma unroll
            for (int tcc = 0; tcc < 2; ++tcc) {
                const int tc = 2 * (w & 1) + tcc;
                f32x4 acc = (f32x4){0.f, 0.f, 0.f, 0.f};
                mm_nt<64>(acc, lds + G_MU + (16 * ti + fr) * S144 + fq * 16, lds + G_VT + (16 * tc + fr) * S144 + fq * 16);
                *(uint2*)(lds + G_UT + (16 * tc + fr) * S144 + (16 * ti + 4 * fq) * 2) = pk4(acc);
            }
        }
        __syncthreads();
        const float gL = GC[63];
        {
            const int ti = w >> 1;
#pragma unroll
            for (int tcc = 0; tcc < 2; ++tcc) {
                const int tc = 2 * (w & 1) + tcc;
                f32x4 acc = (f32x4){0.f, 0.f, 0.f, 0.f};
                mm_nt<128>(acc, lds + G_W + (16 * ti + fr) * S272 + fq * 16, lds + G_ST + (16 * tc + fr) * S272 + fq * 16);
                const int i0 = 16 * ti + 4 * fq, col = 16 * tc + fr;
                const f32x4 vn = ld_bf4((const bf16_t*)(lds + G_UT + col * S144 + i0 * 2)) - acc;
                *(uint2*)(lds + G_VNT + col * S144 + i0 * 2) = pk4(vn);
                const f32x4 sc = (f32x4){expf(gL - GC[i0]), expf(gL - GC[i0 + 1]), expf(gL - GC[i0 + 2]), expf(gL - GC[i0 + 3])};
                *(uint2*)(lds + G_VST + col * S144 + i0 * 2) = pk4(vn * sc);
            }
        }
        __syncthreads();
        {
            const int ti = w >> 1;
#pragma unroll
            for (int tcc = 0; tcc < 2; ++tcc) {
                const int tc = 2 * (w & 1) + tcc;
                f32x4 a1 = (f32x4){0.f, 0.f, 0.f, 0.f}, a2 = a1;
                mm_nt<128>(a1, lds + G_QROW + (16 * ti + fr) * S272 + fq * 16, lds + G_ST + (16 * tc + fr) * S272 + fq * 16);
                mm_nt<64>(a2, lds + G_AQK + (16 * ti + fr) * S144 + fq * 16, lds + G_VNT + (16 * tc + fr) * S144 + fq * 16);
                const int i0 = 16 * ti + 4 * fq, col = 16 * tc + fr;
#pragma unroll
                for (int r = 0; r < 4; ++r) *(bf16_t*)(lds + G_UT + (i0 + r) * S144 + col * 2) = f2bf(expf(GC[i0 + r]) * a1[r] + a2[r]);
            }
            const float egL = expf(gL);
#pragma unroll
            for (int tc = 0; tc < 4; ++tc) {
                f32x4 acc = (f32x4){0.f, 0.f, 0.f, 0.f};
                mm_nt<64>(acc, lds + G_KT + (16 * w + fr) * S144 + fq * 16, lds + G_VST + (16 * tc + fr) * S144 + fq * 16);
                Sreg[tc] = Sreg[tc] * egL + acc;
            }
        }
        __syncthreads();
#pragma unroll
        for (int tc = 0; tc < 4; ++tc) *(uint2*)(lds + G_ST + (16 * tc + fr) * S272 + (16 * w + 4 * fq) * 2) = pk4(Sreg[tc]);
        {
            const int i = t >> 3, part = t & 7;
            const size_t R = (size_t)(b * TT + scan_token(dir, 64 * n + i));
            *(uint4*)(O + R * 512 + h * 128 + 64 * hf + part * 8) = *(const uint4*)(lds + G_UT + i * S144 + part * 16);
        }
    }
    __syncthreads();
}


constexpr int R_KKT = 0;
constexpr int R_KHAT = R_KKT + 64 * S144;
constexpr int R_BHAT = R_KHAT + 64 * S144;
constexpr int R_RT = R_BHAT + 64 * S144;
constexpr int R_KBT = R_RT + 64 * S144;
constexpr int R_BBT = R_KBT + 64 * S144;
constexpr int R_VT = R_BBT + 64 * S144;
constexpr int R_AKK = R_VT + 64 * S144;
constexpr int R_ARK = R_AKK + 64 * S144;
constexpr int R_ARB = R_ARK + 64 * S144;
constexpr int R_M = R_ARB + 64 * S144;
constexpr int R_TT = R_M + 64 * S144;
constexpr int R_RHS = R_TT + 64 * S144;
constexpr int R_PT = R_RHS + 64 * S144;
constexpr int R_OT = R_RHS;
constexpr int R_RT2 = R_PT + 64 * S144;
constexpr int R_BBT2 = R_RT2 + 64 * S144;
constexpr int R_LAML = R_BBT2 + 64 * S144;
constexpr int R_END = R_LAML + 512;
static_assert(R_END <= LDS_MAIN, "RWKV chunk LDS map too large");

__device__ __forceinline__ void unpack8f(const uint4 v, float (&f)[8]) { unpack8(v, f); }

__device__ __forceinline__ void rwkv_chunk_unit(const Params& p, int sr, char* lds) {
    const int b = sr >> 4, h = (sr >> 1) & 7, dir = sr & 1;
    const bf16_t* EW = (const bf16_t*)(p.ws + B_EW) + (size_t)dir * NTOK * 512;
    const bf16_t* KD = (const bf16_t*)(p.ws + B_KD) + (size_t)dir * NTOK * 512;
    const bf16_t* BD = (const bf16_t*)(p.ws + B_BD) + (size_t)dir * NTOK * 512;
    const bf16_t* RR = (const bf16_t*)(p.ws + B_RR); const bf16_t* KK = (const bf16_t*)(p.ws + B_KK); const bf16_t* VV = (const bf16_t*)(p.ws + B_VV);
    const bf16_t* RM = (const bf16_t*)(p.ws + C_RM) + (size_t)sr * 36 * 4096;
    bf16_t* Y = (bf16_t*)(p.ws + (dir == 0 ? B_YF : B_YB));
    float* LAML = (float*)(lds + R_LAML);
    const int t = threadIdx.x, lane = t & 63, w = t >> 6, fr = lane & 15, fq = lane >> 4;
    for (int i = t; i < 3 * 64 * S144 / 16; i += NTHR) ((uint4*)(lds + R_AKK))[i] = make_uint4(0u, 0u, 0u, 0u);
    for (int i = t; i < 64 * S144 / 16; i += NTHR) ((uint4*)(lds + R_TT))[i] = make_uint4(0u, 0u, 0u, 0u);
    f32x4 Treg[2];
    Treg[0] = (f32x4){0.f, 0.f, 0.f, 0.f}; Treg[1] = Treg[0];
    const int ti = w >> 1;
    uint4 prr, pew, pkd, pvv, pkk, pbd, pmq;
    {
        const size_t o = (size_t)(b * TT + scan_token(dir, lane)) * 512 + h * 64 + w * 8;
        prr = *(const uint4*)(RR + o); pew = *(const uint4*)(EW + o); pkd = *(const uint4*)(KD + o);
        pvv = *(const uint4*)(VV + o); pkk = *(const uint4*)(KK + o); pbd = *(const uint4*)(BD + o);
        pmq = *(const uint4*)(RM + t * 8);
    }
    __syncthreads();
    auto stage_r1 = [&](const int n) {
        const int oRT = (n & 1) ? R_RT2 : R_RT, oBBT = (n & 1) ? R_BBT2 : R_BBT;
        float* LAMLn = LAML + 64 * (n & 1);
            const int i = lane, part = w;
            float rr[8], ew[8], kd[8], vv[8], kk[8], bd[8];
            PIN4(prr); PIN4(pew); PIN4(pkd); PIN4(pvv); PIN4(pkk); PIN4(pbd); PIN4(pmq);
            unpack8(prr, rr); unpack8(pew, ew); unpack8(pkd, kd); unpack8(pvv, vv); unpack8(pkk, kk); unpack8(pbd, bd);
            const uint4 mq = pmq;
            if (n + 1 < TT / 64) {
                const size_t o = (size_t)(b * TT + scan_token(dir, 64 * (n + 1) + i)) * 512 + h * 64 + part * 8;
                prr = *(const uint4*)(RR + o); pew = *(const uint4*)(EW + o); pkd = *(const uint4*)(KD + o);
                pvv = *(const uint4*)(VV + o); pkk = *(const uint4*)(KK + o); pbd = *(const uint4*)(BD + o);
                pmq = *(const uint4*)(RM + (size_t)(n + 1) * 4096 + t * 8);
            }
            *(uint4*)(lds + R_M + (t >> 3) * S144 + (t & 7) * 16) = mq;
            float o_kkt[8], o_khat[8], o_bhat[8], o_rt[8];
#pragma unroll
            for (int e = 0; e < 8; ++e) {
                const float lam = -wave_incl_scan(ew[e], lane);
                const float el = __expf(lam), eml = __builtin_amdgcn_rcpf(el);
                const float lamL = lane63(lam), edl = lane63(el) * eml;
                o_kkt[e] = kk[e] * (el * __expf(ew[e]));
                o_khat[e] = kd[e] * eml; o_bhat[e] = bd[e] * eml; o_rt[e] = rr[e] * el;
                const int c = part * 8 + e;
                *(bf16_t*)(lds + R_KBT + c * S144 + i * 2) = f2bf(kd[e] * edl);
                *(bf16_t*)(lds + oBBT + c * S144 + i * 2) = f2bf(-(bd[e] * edl));
                *(bf16_t*)(lds + R_VT + c * S144 + i * 2) = f2bf(vv[e]);
                if (lane == 0) LAMLn[c] = lamL;
            }
            uint4 q;
            q.x = pack2(o_kkt[0], o_kkt[1]); q.y = pack2(o_kkt[2], o_kkt[3]); q.z = pack2(o_kkt[4], o_kkt[5]); q.w = pack2(o_kkt[6], o_kkt[7]);
            *(uint4*)(lds + R_KKT + i * S144 + part * 16) = q;
            q.x = pack2(o_khat[0], o_khat[1]); q.y = pack2(o_khat[2], o_khat[3]); q.z = pack2(o_khat[4], o_khat[5]); q.w = pack2(o_khat[6], o_khat[7]);
            *(uint4*)(lds + R_KHAT + i * S144 + part * 16) = q;
            q.x = pack2(o_bhat[0], o_bhat[1]); q.y = pack2(o_bhat[2], o_bhat[3]); q.z = pack2(o_bhat[4], o_bhat[5]); q.w = pack2(o_bhat[6], o_bhat[7]);
            *(uint4*)(lds + R_BHAT + i * S144 + part * 16) = q;
            q.x = pack2(o_rt[0], o_rt[1]); q.y = pack2(o_rt[2], o_rt[3]); q.z = pack2(o_rt[4], o_rt[5]); q.w = pack2(o_rt[6], o_rt[7]);
            *(uint4*)(lds + oRT + i * S144 + part * 16) = q;
    };
    auto stage_r7 = [&](const int n) {
#pragma unroll
        for (int c = 0; c < 2; ++c) {
            const int tv = 2 * (w & 1) + c;
            *(uint2*)(lds + R_TT + (16 * tv + fr) * S144 + (16 * ti + 4 * fq) * 2) = pk4(Treg[c]);
        }
        {
            const int i = t >> 3, part = t & 7;
            const size_t R = (size_t)(b * TT + scan_token(dir, 64 * n + i));
            *(uint4*)(Y + R * 512 + h * 64 + part * 8) = *(const uint4*)(lds + R_OT + i * S144 + part * 16);
        }
    };
    stage_r1(0);
    for (int n = 0; n < TT / 64; ++n) {
        const int oRT = (n & 1) ? R_RT2 : R_RT, oBBT = (n & 1) ? R_BBT2 : R_BBT;
        const float* LAMLn = LAML + 64 * (n & 1);
        __syncthreads();
        if (n > 0) stage_r7(n - 1);
        {
            auto tile_of = [](int idx, int& ta, int& tb) { ta = idx >= 6 ? 3 : (idx >= 3 ? 2 : (idx >= 1 ? 1 : 0)); tb = idx - ta * (ta + 1) / 2; };
            auto put = [&](char* dst, const f32x4 acc, int ta, int tb, bool strict, float sgn) {
                const int j = 16 * tb + fr;
#pragma unroll
                for (int r = 0; r < 4; ++r) {
                    const int i = 16 * ta + 4 * fq + r;
                    const bool keep = strict ? (i > j) : (i >= j);
                    *(bf16_t*)(dst + i * S144 + j * 2) = f2bf(keep ? sgn * acc[r] : 0.f);
                }
            };
            int ta, tb; tile_of(w, ta, tb);
            const char* xk = lds + R_KKT + (16 * ta + fr) * S144 + fq * 16;
            const char* xr = lds + oRT + (16 * ta + fr) * S144 + fq * 16;
            const char* yk = lds + R_KHAT + (16 * tb + fr) * S144 + fq * 16;
            const char* yb = lds + R_BHAT + (16 * tb + fr) * S144 + fq * 16;
            const bf16x8 xk0 = *(const bf16x8*)xk, xk1 = *(const bf16x8*)(xk + 64), xr0 = *(const bf16x8*)xr, xr1 = *(const bf16x8*)(xr + 64);
            const bf16x8 yk0 = *(const bf16x8*)yk, yk1 = *(const bf16x8*)(yk + 64), yb0 = *(const bf16x8*)yb, yb1 = *(const bf16x8*)(yb + 64);
            const int ex = w >= 2 ? w - 2 : 0, et = 8 + ex / 3, em = w >= 2 ? ex - 3 * (ex / 3) : 0;
            int ea, eb; tile_of(w >= 2 ? et : w, ea, eb);
            const char* ex_x = lds + (em == 0 ? R_KKT : oRT) + (16 * ea + fr) * S144 + fq * 16;
            const char* ex_y = lds + (em == 2 ? R_BHAT : R_KHAT) + (16 * eb + fr) * S144 + fq * 16;
            const bf16x8 ex0 = *(const bf16x8*)ex_x, ex1 = *(const bf16x8*)(ex_x + 64), ey0 = *(const bf16x8*)ex_y, ey1 = *(const bf16x8*)(ex_y + 64);
            const f32x4 z = (f32x4){0.f, 0.f, 0.f, 0.f};
            f32x4 akk = __builtin_amdgcn_mfma_f32_16x16x32_bf16(xk0, yk0, z, 0, 0, 0);
            f32x4 ark = __builtin_amdgcn_mfma_f32_16x16x32_bf16(xr0, yk0, z, 0, 0, 0);
            f32x4 arb = __builtin_amdgcn_mfma_f32_16x16x32_bf16(xr0, yb0, z, 0, 0, 0);
            f32x4 aex = __builtin_amdgcn_mfma_f32_16x16x32_bf16(ex0, ey0, z, 0, 0, 0);
            akk = __builtin_amdgcn_mfma_f32_16x16x32_bf16(xk1, yk1, akk, 0, 0, 0);
            ark = __builtin_amdgcn_mfma_f32_16x16x32_bf16(xr1, yk1, ark, 0, 0, 0);
            arb = __builtin_amdgcn_mfma_f32_16x16x32_bf16(xr1, yb1, arb, 0, 0, 0);
            aex = __builtin_amdgcn_mfma_f32_16x16x32_bf16(ex1, ey1, aex, 0, 0, 0);
            put(lds + R_AKK, akk, ta, tb, true, 1.f);
            put(lds + R_ARK, ark, ta, tb, false, 1.f);
            put(lds + R_ARB, arb, ta, tb, false, -1.f);
            if (w >= 2) put(lds + (em == 0 ? R_AKK : (em == 1 ? R_ARK : R_ARB)), aex, ea, eb, em == 0, em == 2 ? -1.f : 1.f);
        }
        __syncthreads();
        f32x4 arkv[2], kbv[2];
        {
            const char* xb = lds + (16 * ti + fr) * S144 + fq * 16;
            const bf16x8 akk0 = *(const bf16x8*)(xb + R_AKK), akk1 = *(const bf16x8*)(xb + R_AKK + 64), ark0 = *(const bf16x8*)(xb + R_ARK), ark1 = *(const bf16x8*)(xb + R_ARK + 64);
            const bf16x8 kbt0 = *(const bf16x8*)(xb + R_KBT), kbt1 = *(const bf16x8*)(xb + R_KBT + 64), kkt0 = *(const bf16x8*)(xb + R_KKT), kkt1 = *(const bf16x8*)(xb + R_KKT + 64);
            f32x4 rhs2[2];
#pragma unroll
            for (int c = 0; c < 2; ++c) {
                const int tv = 2 * (w & 1) + c;
                const char* yv = lds + R_VT + (16 * tv + fr) * S144 + fq * 16;
                const char* yt = lds + R_TT + (16 * tv + fr) * S144 + fq * 16;
                const bf16x8 v0 = *(const bf16x8*)yv, v1 = *(const bf16x8*)(yv + 64), t0 = *(const bf16x8*)yt, t1 = *(const bf16x8*)(yt + 64);
                const f32x4 z = (f32x4){0.f, 0.f, 0.f, 0.f};
                f32x4 r = __builtin_amdgcn_mfma_f32_16x16x32_bf16(kkt0, t0, z, 0, 0, 0);
                f32x4 a = __builtin_amdgcn_mfma_f32_16x16x32_bf16(ark0, v0, z, 0, 0, 0);
                f32x4 k = __builtin_amdgcn_mfma_f32_16x16x32_bf16(kbt0, v0, z, 0, 0, 0);
                r = __builtin_amdgcn_mfma_f32_16x16x32_bf16(kkt1, t1, r, 0, 0, 0);
                a = __builtin_amdgcn_mfma_f32_16x16x32_bf16(ark1, v1, a, 0, 0, 0);
                k = __builtin_amdgcn_mfma_f32_16x16x32_bf16(kbt1, v1, k, 0, 0, 0);
                r = __builtin_amdgcn_mfma_f32_16x16x32_bf16(akk0, v0, r, 0, 0, 0);
                r = __builtin_amdgcn_mfma_f32_16x16x32_bf16(akk1, v1, r, 0, 0, 0);
                rhs2[c] = r; arkv[c] = a; kbv[c] = k;
            }
#pragma unroll
            for (int c = 0; c < 2; ++c) {
                const int tv = 2 * (w & 1) + c;
                *(uint2*)(lds + R_RHS + (16 * tv + fr) * S144 + (16 * ti + 4 * fq) * 2) = pk4(rhs2[c]);
            }
        }
        __syncthreads();
#pragma unroll
        for (int c = 0; c < 2; ++c) {
            const int tv = 2 * (w & 1) + c;
            f32x4 pacc = (f32x4){0.f, 0.f, 0.f, 0.f};
            mm_nt<64>(pacc, lds + R_M + (16 * ti + fr) * S144 + fq * 16, lds + R_RHS + (16 * tv + fr) * S144 + fq * 16);
            *(uint2*)(lds + R_PT + (16 * tv + fr) * S144 + (16 * ti + 4 * fq) * 2) = pk4(pacc);
        }
        __syncthreads();
        {
            const char* xb = lds + (16 * ti + fr) * S144 + fq * 16;
            const bf16x8 rt0 = *(const bf16x8*)(xb + oRT), rt1 = *(const bf16x8*)(xb + oRT + 64), arb0 = *(const bf16x8*)(xb + R_ARB), arb1 = *(const bf16x8*)(xb + R_ARB + 64);
            const bf16x8 bbt0 = *(const bf16x8*)(xb + oBBT), bbt1 = *(const bf16x8*)(xb + oBBT + 64);
            const int i0 = 16 * ti + 4 * fq;
            const f32x4 dl = (f32x4){expf(LAMLn[i0]), expf(LAMLn[i0 + 1]), expf(LAMLn[i0 + 2]), expf(LAMLn[i0 + 3])};
            f32x4 yacc[2];
#pragma unroll
            for (int c = 0; c < 2; ++c) {
                const int tv = 2 * (w & 1) + c;
                const char* yt = lds + R_TT + (16 * tv + fr) * S144 + fq * 16;
                const char* yp = lds + R_PT + (16 * tv + fr) * S144 + fq * 16;
                const bf16x8 t0 = *(const bf16x8*)yt, t1 = *(const bf16x8*)(yt + 64), p0 = *(const bf16x8*)yp, p1 = *(const bf16x8*)(yp + 64);
                f32x4 tacc = __builtin_amdgcn_mfma_f32_16x16x32_bf16(bbt0, p0, kbv[c], 0, 0, 0);
                f32x4 ya = __builtin_amdgcn_mfma_f32_16x16x32_bf16(rt0, t0, arkv[c], 0, 0, 0);
                tacc = __builtin_amdgcn_mfma_f32_16x16x32_bf16(bbt1, p1, tacc, 0, 0, 0);
                ya = __builtin_amdgcn_mfma_f32_16x16x32_bf16(rt1, t1, ya, 0, 0, 0);
                ya = __builtin_amdgcn_mfma_f32_16x16x32_bf16(arb0, p0, ya, 0, 0, 0);
                ya = __builtin_amdgcn_mfma_f32_16x16x32_bf16(arb1, p1, ya, 0, 0, 0);
                Treg[c] = Treg[c] * dl + tacc;
                yacc[c] = ya;
            }
#pragma unroll
            for (int c = 0; c < 2; ++c) {
                const int val = 16 * (2 * (w & 1) + c) + fr;
#pragma unroll
                for (int r = 0; r < 4; ++r) *(bf16_t*)(lds + R_OT + (i0 + r) * S144 + val * 2) = f2bf(yacc[c][r]);
            }
        }
        if (n + 1 < TT / 64) stage_r1(n + 1);
    }
    __syncthreads();
    stage_r7(TT / 64 - 1);
    __syncthreads();
}

__device__ __forceinline__ void phase4(const Params& p, char* lds, const XcdBarrier& xb) {
    phase4a(p, lds);
    {
        const int first = gridDim.x == 256 ? 96 : 0;
        if ((int)blockIdx.x >= first) { __syncthreads(); deferred_transposes(p, lds, first, (int)gridDim.x - first); }
    }
    xcd_barrier(xb);
    for (int u = blockIdx.x; u < 256; u += gridDim.x) {
        if (u < 128) gdn_chunk_unit(p, u, lds);
        else rwkv_chunk_unit(p, u - 128, lds);
    }
    for (int v = blockIdx.x; v < 96; v += gridDim.x) adaln_unit(p, 96 + v, (float*)lds);
    if (gridDim.x != 256 || blockIdx.x < 128) convert_moe<2, 0, 1024>(p, 0, lds);
}

__device__ __forceinline__ void phase5(const Params& p, char* lds) {
    const int lane = threadIdx.x & 63, wg = blockIdx.x * 8 + (threadIdx.x >> 6), nw = gridDim.x * 8;
    const bf16_t* YF = (const bf16_t*)(p.ws + B_YF); const bf16_t* YB = (const bf16_t*)(p.ws + B_YB);
    const bf16_t* OF = (const bf16_t*)(p.ws + B_OF); const bf16_t* OB = (const bf16_t*)(p.ws + B_OB);
    const bf16_t* VV = (const bf16_t*)(p.ws + B_VV); const bf16_t* GG = (const bf16_t*)(p.ws + B_GG);
    const float* BC = (const float*)(p.ws + B_BC);
    const bf16_t* ZZ = (const bf16_t*)(p.ws + B_ZZ);
    bf16_t* MO = (bf16_t*)(p.ws + OFF_H);
    uint4 nA, nB, nV, nG, nOF, nOB, nZ; float nbc = 0.f;
    auto fetch = [&](int R) {
        const int c8 = lane * 8;
        nA = *(const uint4*)(YF + (size_t)R * 512 + c8); nB = *(const uint4*)(YB + (size_t)R * 512 + c8);
        nV = *(const uint4*)(VV + (size_t)R * 512 + c8); nG = *(const uint4*)(GG + (size_t)R * 512 + c8);
        nOF = *(const uint4*)(OF + (size_t)R * 512 + c8); nOB = *(const uint4*)(OB + (size_t)R * 512 + c8);
        nZ = *(const uint4*)(ZZ + (size_t)R * 512 + c8); nbc = BC[(size_t)R * 8 + (lane >> 3)];
    };
    float lnw[8], lnb[8], onw[8];
    {
        const int c8 = lane * 8;
        const f32x4 a0 = *(const f32x4*)(p.in[19] + c8), a1 = *(const f32x4*)(p.in[19] + c8 + 4), b0 = *(const f32x4*)(p.in[20] + c8), b1 = *(const f32x4*)(p.in[20] + c8 + 4);
        const f32x4 o0 = *(const f32x4*)(p.in[24] + (c8 & 127)), o1 = *(const f32x4*)(p.in[24] + (c8 & 127) + 4);
#pragma unroll
        for (int j = 0; j < 4; ++j) { lnw[j] = a0[j]; lnw[4 + j] = a1[j]; lnb[j] = b0[j]; lnb[4 + j] = b1[j]; onw[j] = o0[j]; onw[4 + j] = o1[j]; }
    }
    if (wg < NTOK) fetch(wg);
    for (int R = wg; R < NTOK; R += nw) {
        const int c8 = lane * 8;
        const uint4 cA = nA, cB = nB, cV = nV, cG = nG, cOF = nOF, cOB = nOB, cZ = nZ; const float cbc = nbc;
        if (R + nw < NTOK) fetch(R + nw);
        {
            const uint4 a = cA, bq = cB, vq = cV, gq = cG;
            const unsigned au[4] = {a.x, a.y, a.z, a.w}, bu[4] = {bq.x, bq.y, bq.z, bq.w}, vu[4] = {vq.x, vq.y, vq.z, vq.w}, gu[4] = {gq.x, gq.y, gq.z, gq.w};
            float y[8], vv[8], gg[8];
#pragma unroll
            for (int j = 0; j < 4; ++j) {
                y[2 * j] = bf2f((bf16_t)(au[j] & 0xffff)) + bf2f((bf16_t)(bu[j] & 0xffff));
                y[2 * j + 1] = bf2f((bf16_t)(au[j] >> 16)) + bf2f((bf16_t)(bu[j] >> 16));
                vv[2 * j] = bf2f((bf16_t)(vu[j] & 0xffff)); vv[2 * j + 1] = bf2f((bf16_t)(vu[j] >> 16));
                gg[2 * j] = bf2f((bf16_t)(gu[j] & 0xffff)); gg[2 * j + 1] = bf2f((bf16_t)(gu[j] >> 16));
            }
            float sm = 0.f;
#pragma unroll
            for (int j = 0; j < 8; ++j) sm += y[j];
            sm += __shfl_xor(sm, 1); sm += __shfl_xor(sm, 2); sm += __shfl_xor(sm, 4);
            const float mean = sm * (1.f / 64.f);
            float sv = 0.f;
#pragma unroll
            for (int j = 0; j < 8; ++j) { const float d = y[j] - mean; sv += d * d; }
            sv += __shfl_xor(sv, 1); sv += __shfl_xor(sv, 2); sv += __shfl_xor(sv, 4);
            const float rstd = rsqrtf(sv * (1.f / 64.f) + 64e-5f);
            const float bc = cbc;
            float o[8];
#pragma unroll
            for (int j = 0; j < 8; ++j) {
                const float yn = (y[j] - mean) * rstd * lnw[j] + lnb[j];
                o[j] = (yn + bc * vv[j]) * gg[j];
            }
            uint4 ov; ov.x = pack2(o[0], o[1]); ov.y = pack2(o[2], o[3]); ov.z = pack2(o[4], o[5]); ov.w = pack2(o[6], o[7]);
            *(uint4*)(MO + (size_t)R * DM + c8) = ov;
        }
        {
            const uint4 a = cOF, bq = cOB;
            const uint4 zq = cZ;
            const unsigned au[4] = {a.x, a.y, a.z, a.w}, bu[4] = {bq.x, bq.y, bq.z, bq.w}, zu[4] = {zq.x, zq.y, zq.z, zq.w};
            float o[8], z[8];
#pragma unroll
            for (int j = 0; j < 4; ++j) {
                o[2 * j] = bf2f((bf16_t)(au[j] & 0xffff)) + bf2f((bf16_t)(bu[j] & 0xffff));
                o[2 * j + 1] = bf2f((bf16_t)(au[j] >> 16)) + bf2f((bf16_t)(bu[j] >> 16));
                z[2 * j] = bf2f((bf16_t)(zu[j] & 0xffff)); z[2 * j + 1] = bf2f((bf16_t)(zu[j] >> 16));
            }
            float ss = 0.f;
#pragma unroll
            for (int j = 0; j < 8; ++j) ss += o[j] * o[j];
            ss += __shfl_xor(ss, 1); ss += __shfl_xor(ss, 2); ss += __shfl_xor(ss, 4); ss += __shfl_xor(ss, 8);
            const float rs = rsqrtf(ss * (1.f / 128.f) + 1e-6f);
            float r[8];
#pragma unroll
            for (int j = 0; j < 8; ++j) r[j] = o[j] * rs * onw[j] * siluf(z[j]);
            uint4 ov; ov.x = pack2(r[0], r[1]); ov.y = pack2(r[2], r[3]); ov.z = pack2(r[4], r[5]); ov.w = pack2(r[6], r[7]);
            *(uint4*)(MO + (size_t)R * DM + 512 + c8) = ov;
        }
    }
}

struct SchedOut {
    const char* A; const char* W; int nM;
    __device__ __forceinline__ bool next(int i, g8::Unit& u) const {
        int pm, pn; if (!g8::grid_order(i, nM, 4, pm, pn)) return false;
        u.pm = pm; u.pn = pn; u.e = 0; u.half = 0; u.mh = 0; u.nh = 0;
        u.a0 = A + (size_t)pm * 256 * DM * 2; u.a1 = u.a0 + (size_t)128 * DM * 2;
        u.b0 = W + (size_t)pn * 256 * DM * 2; u.b1 = u.b0 + (size_t)128 * DM * 2;
        return true;
    }
    __device__ __forceinline__ unsigned aoff(const g8::Unit&, int, int, int) const { return 0u; }
    __device__ __forceinline__ int araw(const g8::Unit&, int, int) const { return 0; }
    __device__ __forceinline__ unsigned afrom(int, int) const { return 0u; }
};
struct EpiOut {
    static constexpr bool PERM = true;
    const Params* p; int layer;
    __device__ __forceinline__ void operator()(const f32x4 (&acc)[2][2][4][2], const g8::Unit& u, int wr, int wc, int fr, int fq) const {
        const int row0 = u.pm * 256;
        const int mr = layer == 0 ? mod_row(row0) : row0 / SEQ;
        const float* gate = mod_ptr(*p, layer, mr, 2) + u.pn * 256 + wc * 32 + 8 * fq;
        f32x4 gv[2][2];
#pragma unroll
        for (int bj = 0; bj < 2; ++bj)
#pragma unroll
            for (int n = 0; n < 2; ++n) gv[bj][n] = *(const f32x4*)(gate + bj * 128 + n * 4);
#pragma unroll
        for (int ai = 0; ai < 2; ++ai)
#pragma unroll
            for (int mh = 0; mh < 2; ++mh) {
                f32x4 xv[2][2][2];
                bf16_t* dstp[2];
#pragma unroll
                for (int m2 = 0; m2 < 2; ++m2) {
                    const int row = row0 + ai * 128 + wr * 64 + (2 * mh + m2) * 16 + fr;
                    const int cofs = u.pn * 256 + wc * 32 + 8 * fq;
                    if (layer == 0) {
                        const float* srcp = xin_row(*p, row) + cofs; dstp[m2] = xs_row(*p, row) + cofs;
#pragma unroll
                        for (int bj = 0; bj < 2; ++bj) { xv[m2][bj][0] = *(const f32x4*)(srcp + bj * 128); xv[m2][bj][1] = *(const f32x4*)(srcp + bj * 128 + 4); }
                    } else {
                        dstp[m2] = (bf16_t*)(p->ws + OFF_XLAT) + (size_t)row * DM + cofs;
#pragma unroll
                        for (int bj = 0; bj < 2; ++bj) { const uint4 r = *(const uint4*)(dstp[m2] + bj * 128); xv[m2][bj][0] = bf4_lo(r); xv[m2][bj][1] = bf4_hi(r); }
                    }
                }
#pragma unroll
                for (int m2 = 0; m2 < 2; ++m2)
#pragma unroll
                    for (int bj = 0; bj < 2; ++bj) {
                        const int m = 2 * mh + m2;
                        const uint2 t0 = pk4(xv[m2][bj][0] + gv[bj][0] * acc[ai][bj][m][0]), t1 = pk4(xv[m2][bj][1] + gv[bj][1] * acc[ai][bj][m][1]);
                        *(uint4*)(dstp[m2] + bj * 128) = make_uint4(t0.x, t0.y, t1.x, t1.y);
                    }
            }
    }
};
__device__ __forceinline__ void phase_outproj(const Params& p, int layer, char* lds) {
    SchedOut S{p.ws + (layer == 0 ? OFF_H : L_AO), p.ws + (layer == 0 ? OFF_WOUT0 : OFF_WOUT1), layer == 0 ? NTOK / 256 : NB * SEQ / 256};
    EpiOut E{&p, layer};
    g8::gemm_phase<false>((LAS unsigned char*)lds, DM, S, E);
    if (layer == 0) convert_moe<0, 1024, 3072>(p, 0, lds);
}

__device__ __forceinline__ void phase_ffn_norm(const Params& p, int layer, char* lds) {
    const int lane = threadIdx.x & 63, wg = blockIdx.x * 8 + (threadIdx.x >> 6), nw = gridDim.x * 8;
    bf16_t* H = (bf16_t*)(p.ws + OFF_H);
    float* AFF = (float*)(p.ws + M_AFF);
    const float* router = p.in[28] + (size_t)layer * 1024 * 16;
    float* rt = (float*)lds;
    for (int i = threadIdx.x; i < 16384; i += NTHR) {
        const int c = i >> 4;
        const int slot = 4 * ((c & 511) >> 3) + 256 * (2 * (c >> 9) + ((c >> 2) & 1)) + (c & 3);
        rt[(i & 15) * 1024 + slot] = router[i];
    }
    __syncthreads();
    const int nrow = layer == 0 ? NTOK : NB * SEQ;
    auto rowof = [&](int q) { return layer == 0 ? q : (q / SEQ) * TT + LC + (q % SEQ); };
    f32x4 xa[4], xb[4];
#pragma unroll
    for (int i = 0; i < 4; ++i) { xa[i] = (f32x4){0.f, 0.f, 0.f, 0.f}; xb[i] = xa[i]; }
    auto body = [&](const f32x4 (&x)[4], f32x4 (&xnext)[4], int q) {
        const int R = rowof(q);
        f32x4 h[4];
        const int mr = mod_row(R);
        ModP mp; load_modp(p.in[7] + layer * 1024, mod_ptr(p, layer, mr, 3), mod_ptr(p, layer, mr, 4), lane, mp);
        { const int qn = q + nw; load_row16(xs_row(p, rowof(qn < nrow ? qn : q)), lane, xnext); }
        apply_modp(x, mp, h);
        store_h(H + (size_t)R * DM, lane, h);
        router_row(h, rt, lane, AFF + (size_t)R * 16);
    };
    if (wg < nrow) load_row16(xs_row(p, rowof(wg)), lane, xa);
    for (int q = wg; q < nrow; q += 2 * nw) {
        body(xa, xb, q);
        if (q + nw >= nrow) break;
        body(xb, xa, q + nw);
    }
    __syncthreads();
}

__device__ __forceinline__ void phase_topk(const Params& p, int layer, char* lds) {
    const float* AFF = (const float*)(p.ws + M_AFF);
    int* SEL = (int*)(p.ws + M_SEL); int* IDX = (int*)(p.ws + M_IDX); float* GATE = (float*)(p.ws + M_GATE);
    int* hist = (int*)lds;
    int* wtot = hist + 1024;
    int* res = wtot + 16;
    const int t = threadIdx.x, lane = t & 63, w = t >> 6;
    const int nunit = layer == 0 ? 256 : 128;
    const int SLOTS = layer == 0 ? 288 : 256, SL = NB * SLOTS;
    for (int u = blockIdx.x; u < nunit; u += gridDim.x) {
        const int isctx = (u >= 128) ? 1 : 0;
        const int b = (u & 127) >> 4, e = u & 15;
        const int n = isctx ? LC : SEQ, cap = n >> 3;
        const int Rbase = b * TT + (isctx ? 0 : LC);
        const int off = (layer == 0 && !isctx) ? 32 : 0;
        unsigned key[4]; float val[4];
        const bool own = 4 * t < n;
#pragma unroll
        for (int q = 0; q < 4; ++q) { val[q] = own ? AFF[(size_t)(Rbase + 4 * t + q) * 16 + e] : 0.f; key[q] = __float_as_uint(val[q]); }
        unsigned prefix = 0u; int remaining = cap;
        __syncthreads();
        hist[t] = 0; hist[512 + t] = 0;
        __syncthreads();
#pragma unroll 1
        for (int pass = 3; pass >= 0; --pass) {
            int* hp = hist + 256 * pass;
            if (own) {
#pragma unroll
                for (int q = 0; q < 4; ++q)
                    if (pass == 3 || (key[q] >> (8 * (pass + 1))) == prefix) atomicAdd(&hp[(key[q] >> (8 * pass)) & 255u], 1);
            }
            __syncthreads();
            if (w == 0) {
                const int g = 63 - lane;
                const int h0 = hp[4 * g], h1 = hp[4 * g + 1], h2 = hp[4 * g + 2], h3 = hp[4 * g + 3];
                const int v = h0 + h1 + h2 + h3;
                const int incl = (int)wave_incl_scan((float)v, lane);
                const int excl = incl - v;
                if (excl < remaining && remaining <= incl) {
                    int above = excl, bin;
                    if (above + h3 >= remaining) bin = 4 * g + 3;
                    else { above += h3; if (above + h2 >= remaining) bin = 4 * g + 2; else { above += h2; if (above + h1 >= remaining) bin = 4 * g + 1; else { above += h1; bin = 4 * g; } } }
                    res[2 * pass] = bin; res[2 * pass + 1] = above;
                }
            }
            __syncthreads();
            prefix = (prefix << 8) | (unsigned)res[2 * pass];
            remaining -= res[2 * pass + 1];
        }
        int cg = 0, ce = 0;
#pragma unroll
        for (int q = 0; q < 4; ++q) { cg += (own && key[q] > prefix) ? 1 : 0; ce += (own && key[q] == prefix) ? 1 : 0; }
        const int ig = (int)wave_incl_scan((float)cg, lane), ie = (int)wave_incl_scan((float)ce, lane);
        if (lane == 63) { wtot[w] = ig; wtot[8 + w] = ie; }
        __syncthreads();
        int bg = ig - cg, be = ie - ce;
        for (int w2 = 0; w2 < w; ++w2) { bg += wtot[w2]; be += wtot[8 + w2]; }
        if (own) {
#pragma unroll
            for (int q = 0; q < 4; ++q) {
                const int R = Rbase + 4 * t + q;
                const bool gt = key[q] > prefix, eq = key[q] == prefix;
                const bool sel = gt || (eq && be < remaining);
                if (sel) {
                    const int slot = b * SLOTS + off + bg + (be < remaining ? be : remaining);
                    IDX[e * SL + slot] = R; GATE[e * SL + slot] = val[q]; SEL[(size_t)R * 16 + e] = slot;
                } else SEL[(size_t)R * 16 + e] = -1;
                bg += gt ? 1 : 0; be += eq ? 1 : 0;
            }
        }
        __syncthreads();
    }
}

struct SchedMoe1 {
    const char* H; const char* WS; const char* W3; const int* IDX; int SL, npm, layer;
    __device__ __forceinline__ bool next(int i, g8::Unit& u) const {
        const int Q = 16 * npm;
        int q, pn, sub = 0, pieces = 1;
        if (gridDim.x == 256 && (Q & 15) == 0) {
            const int xcd = blockIdx.x & 7, j = blockIdx.x >> 3, R = Q / 32;
            if (i < R) { q = i * 32 + xcd * 4 + (j >> 3); pn = j & 7; }
            else if (i == R && Q - R * 32 == 16) { q = R * 32 + xcd * 2 + (j >> 4); pn = (j >> 1) & 7; sub = j & 1; pieces = 2; }
            else return false;
        } else {
            int L; if (!g8::tail_split(i, Q * 8, 2, L, sub, pieces)) return false;
            q = L >> 3; pn = L & 7;
        }
        const int e = q / npm;
        u.e = e; u.pm = q - e * npm; u.pn = pn; u.mh = sub; u.nh = 0; u.half = pieces == 2 ? 2 : 0;
        u.a0 = H; u.a1 = H;
        u.b0 = WS + moe_w_off(layer, e) + (size_t)(u.pn * 128) * DM * 2; u.b1 = W3 + ((size_t)e * 1024 + u.pn * 128) * DM * 2;
        return true;
    }
    __device__ __forceinline__ unsigned aoff(const g8::Unit& u, int h, int R, int C) const {
        return (unsigned)(IDX[u.e * SL + u.pm * 256 + (h + u.mh) * 128 + R] * DM + C) * 2u;
    }
    __device__ __forceinline__ int araw(const g8::Unit& u, int h, int R) const { return IDX[u.e * SL + u.pm * 256 + (h + u.mh) * 128 + R]; }
    __device__ __forceinline__ unsigned afrom(int raw, int C) const { return (unsigned)(raw * DM + C) * 2u; }
};
struct EpiMoe1 {
    static constexpr bool PERM = true;
    bf16_t* HID; int SL;
    __device__ __forceinline__ void operator()(const f32x4 (&acc)[2][2][4][2], const g8::Unit& u, int wr, int wc, int fr, int fq) const {
#pragma unroll
        for (int ai = 0; ai < 2; ++ai)
#pragma unroll
            for (int m = 0; m < 4; ++m) {
                const int row = u.e * SL + u.pm * 256 + (ai + u.mh) * 128 + wr * 64 + m * 16 + fr;
                const int f = u.pn * 128 + wc * 32 + 8 * fq;
                if (ai == 1 && (u.half & 2)) continue;
                uint2 t[2];
#pragma unroll
                for (int n = 0; n < 2; ++n) {
                    const f32x4 a = acc[ai][0][m][n], g = acc[ai][1][m][n];
                    t[n] = pk4((f32x4){siluf(a[0]) * g[0], siluf(a[1]) * g[1], siluf(a[2]) * g[2], siluf(a[3]) * g[3]});
                }
                *(uint4*)(HID + (size_t)row * 1024 + f) = make_uint4(t[0].x, t[0].y, t[1].x, t[1].y);
            }
    }
};
__device__ __forceinline__ void phase_moe1(const Params& p, int layer, char* lds) {
    const int SL = layer == 0 ? 2304 : 2048;
    SchedMoe1 S{p.ws + OFF_H, p.ws, p.ws + M_W + 16ull * 1024 * 1024 * 2, (const int*)(p.ws + M_IDX), SL, SL / 256, layer};
    EpiMoe1 E{(bf16_t*)(p.ws + M_HID), SL};
    g8::gemm_phase<true>((LAS unsigned char*)lds, DM, S, E);
}

struct SchedMoe2 {
    const char* HID; const char* W2; int SL, npm;
    __device__ __forceinline__ bool next(int i, g8::Unit& u) const {
        const int Q = 16 * npm;
        int q, pn, sub = 0, pieces = 1;
        if (gridDim.x == 256 && (Q & 15) == 0) {
            const int xcd = blockIdx.x & 7, j = blockIdx.x >> 3, R = Q / 64;
            if (i < R) { q = i * 64 + xcd * 8 + (j >> 2); pn = j & 3; }
            else if (i == R && Q - R * 64 == 16) { q = R * 64 + xcd * 2 + (j >> 4); pn = (j >> 2) & 3; sub = j & 3; pieces = 4; }
            else return false;
        } else {
            int L; if (!g8::tail_split(i, Q * 4, 4, L, sub, pieces)) return false;
            q = L >> 2; pn = L & 3;
        }
        const int e = q / npm;
        u.e = e; u.pm = q - e * npm; u.pn = pn;
        u.half = pieces == 4 ? 3 : pieces == 2 ? 1 : 0; u.nh = sub & 1; u.mh = pieces == 4 ? (sub >> 1) : 0;
        u.a0 = HID + ((size_t)e * SL + u.pm * 256 + u.mh * 128) * 1024 * 2; u.a1 = (u.half & 2) ? u.a0 : u.a0 + (size_t)128 * 1024 * 2;
        u.b0 = W2 + ((size_t)e * 1024 + u.pn * 256 + u.nh * 128) * 1024 * 2; u.b1 = (u.half & 1) ? u.b0 : u.b0 + (size_t)128 * 1024 * 2;
        return true;
    }
    __device__ __forceinline__ unsigned aoff(const g8::Unit&, int, int, int) const { return 0u; }
    __device__ __forceinline__ int araw(const g8::Unit&, int, int) const { return 0; }
    __device__ __forceinline__ unsigned afrom(int, int) const { return 0u; }
};
struct EpiMoe2 {
    static constexpr bool PERM = true;
    bf16_t* YE; const float* GATE; int SL;
    __device__ __forceinline__ void operator()(const f32x4 (&acc)[2][2][4][2], const g8::Unit& u, int wr, int wc, int fr, int fq) const {
        float gq[2][4];
#pragma unroll
        for (int ai = 0; ai < 2; ++ai)
#pragma unroll
            for (int m = 0; m < 4; ++m) gq[ai][m] = GATE[u.e * SL + u.pm * 256 + (ai + ((ai == 1 && (u.half & 2)) ? 0 : u.mh)) * 128 + wr * 64 + m * 16 + fr];
#pragma unroll
        for (int ai = 0; ai < 2; ++ai)
#pragma unroll
            for (int m = 0; m < 4; ++m) {
                const int row = u.e * SL + u.pm * 256 + (ai + u.mh) * 128 + wr * 64 + m * 16 + fr;
                if (ai == 1 && (u.half & 2)) continue;
                const float g = gq[ai][m];
#pragma unroll
                for (int bj = 0; bj < 2; ++bj) {
                    const int col = u.pn * 256 + (bj + u.nh) * 128 + wc * 32 + 8 * fq;
                    if (bj == 1 && (u.half & 1)) continue;
                    const uint2 t0 = pk4(acc[ai][bj][m][0] * g), t1 = pk4(acc[ai][bj][m][1] * g);
                    *(uint4*)(YE + (size_t)row * 1024 + col) = make_uint4(t0.x, t0.y, t1.x, t1.y);
                }
            }
    }
};
__device__ __forceinline__ void phase_moe2(const Params& p, int layer, char* lds) {
    const int SL = layer == 0 ? 2304 : 2048;
    SchedMoe2 S{p.ws + M_HID, p.ws + M_W + 32ull * 1024 * 1024 * 2, SL, SL / 256};
    EpiMoe2 E{(bf16_t*)(p.ws + M_YE), (const float*)(p.ws + M_GATE), SL};
    g8::gemm_phase<false>((LAS unsigned char*)lds, 1024, S, E);
}

__device__ __forceinline__ void phase_combine(const Params& p, int layer, char* lds) {
    const int lane = threadIdx.x & 63, wg = blockIdx.x * 8 + (threadIdx.x >> 6), nw = gridDim.x * 8;
    const int* SEL = (const int*)(p.ws + M_SEL);
    const bf16_t* YE = (const bf16_t*)(p.ws + M_YE);
    bf16_t* H = (bf16_t*)(p.ws + OFF_H);
    const int SL = layer == 0 ? 2304 : 2048;
    const int nrow = layer == 0 ? NTOK : NB * SEQ;
    auto rowof = [&](int q) { return layer == 0 ? q : (q / SEQ) * TT + LC + (q % SEQ); };
    f32x4 xa[4], xb[4]; int sela = -1, selb = -1;
#pragma unroll
    for (int i = 0; i < 4; ++i) { xa[i] = (f32x4){0.f, 0.f, 0.f, 0.f}; xb[i] = xa[i]; }
    auto body = [&](const f32x4 (&xin)[4], const int selv, f32x4 (&xnext)[4], int& selnext, int q) {
        const int R = rowof(q);
        bf16_t* xr = xs_row(p, R);
        f32x4 x[4], sum[4];
#pragma unroll
        for (int i = 0; i < 4; ++i) { x[i] = xin[i]; sum[i] = (f32x4){0.f, 0.f, 0.f, 0.f}; }
        const int mr = mod_row(R);
        const float* g5 = mod_ptr(p, layer, mr, 5);
        f32x4 g5v[4], fin[4]; ModP mp;
#pragma unroll
        for (int i = 0; i < 4; ++i) g5v[i] = *(const f32x4*)(g5 + rcol(lane, i));
        if (layer == 0) load_modp(p.in[6] + 1024, mod_ptr(p, 1, mr, 0), mod_ptr(p, 1, mr, 1), lane, mp);
        else {
#pragma unroll
            for (int i = 0; i < 4; ++i) fin[i] = *(const f32x4*)(p.in[32] + rcol(lane, i));
        }
        unsigned mask = (unsigned)(__ballot(selv >= 0) & 0xFFFFull);
        bool first = true;
        do {
            const bf16_t* yr[4]; float wgt[4];
#pragma unroll
            for (int j = 0; j < 4; ++j) {
                const bool on = mask != 0u;
                const int e = on ? __builtin_ctz(mask) : 0;
                const int sl = __builtin_amdgcn_readlane(selv, e);
                mask = on ? (mask & (mask - 1u)) : 0u;
                yr[j] = YE + ((size_t)(on ? e : 0) * SL + (on ? sl : 0)) * 1024;
                wgt[j] = on ? 1.f : 0.f;
            }
            uint4 raw[4][2];
#pragma unroll
            for (int j = 0; j < 4; ++j)
#pragma unroll
                for (int k = 0; k < 2; ++k) raw[j][k] = *(const uint4*)(yr[j] + 8 * lane + 512 * k);
            if (first) {
                first = false;
                const int qn = q + nw, Rn = rowof(qn < nrow ? qn : q);
                load_row16(xs_row(p, Rn), lane, xnext); selnext = SEL[(size_t)Rn * 16 + (lane & 15)];
            }
#pragma unroll
            for (int j = 0; j < 4; ++j)
#pragma unroll
                for (int k = 0; k < 2; ++k) { sum[2 * k] += bfq_lo(raw[j][k]) * wgt[j]; sum[2 * k + 1] += bfq_hi(raw[j][k]) * wgt[j]; }
        } while (mask);
#pragma unroll
        for (int i = 0; i < 4; ++i) x[i] += g5v[i] * sum[i];
        if (layer == 0) {
#pragma unroll
            for (int k = 0; k < 2; ++k) {
                const uint2 t0 = pk4(x[2 * k]), t1 = pk4(x[2 * k + 1]);
                *(uint4*)(xr + 8 * lane + 512 * k) = make_uint4(t0.x, t0.y, t1.x, t1.y);
            }
            f32x4 h[4];
            apply_modp(x, mp, h);
            store_h(H + (size_t)R * DM, lane, h);
        } else {
            const float rs = row_rs(x);
            float* orow = p.out + (size_t)(q) * DM;
#pragma unroll
            for (int i = 0; i < 4; ++i) *(f32x4*)(orow + rcol(lane, i)) = x[i] * rs * fin[i];
        }
    };
    if (wg < nrow) { const int R0 = rowof(wg); load_row16(xs_row(p, R0), lane, xa); sela = SEL[(size_t)R0 * 16 + (lane & 15)]; }
    for (int q = wg; q < nrow; q += 2 * nw) {
        body(xa, sela, xb, selb, q);
        if (q + nw >= nrow) break;
        body(xb, selb, xa, sela, q + nw);
    }
}

struct SchedIn1 {
    const char* H; const char* W;
    __device__ __forceinline__ bool next(int i, g8::Unit& u) const {
        const long L = (long)i * gridDim.x + blockIdx.x; if (L >= 400) return false;
        int pm, pn;
        if (L < 384) { const int pl = (int)L / 6; pn = (int)L % 6; pm = (pl >> 3) * 9 + 1 + (pl & 7); }
        else { const int v = (int)L - 384; pm = (v >> 1) * 9; pn = 4 + (v & 1); }
        u.pm = pm; u.pn = pn; u.e = 0; u.half = 0; u.mh = 0; u.nh = 0;
        u.a0 = H + (size_t)pm * 256 * DM * 2; u.a1 = u.a0 + (size_t)128 * DM * 2;
        u.b0 = W + (size_t)pn * 256 * DM * 2; u.b1 = u.b0 + (size_t)128 * DM * 2;
        return true;
    }
    __device__ __forceinline__ unsigned aoff(const g8::Unit&, int, int, int) const { return 0u; }
    __device__ __forceinline__ int araw(const g8::Unit&, int, int) const { return 0; }
    __device__ __forceinline__ unsigned afrom(int, int) const { return 0u; }
};
struct EpiIn1 {
    static constexpr bool PERM = false;
    bf16_t* QB; bf16_t* KB; bf16_t* VT; const float* rope;
    __device__ __forceinline__ void operator()(const f32x4 (&acc)[2][2][4][2], const g8::Unit& u, int wr, int wc, int fr, int fq) const {
        const int bidx = u.pm / 9;
        const bool islat = (u.pm % 9) != 0;
        const bool dorope = islat && u.pn < 5;
        const float qs = u.pn < 4 ? 0.125f * 1.4426950408889634f : 1.f;
#pragma unroll
        for (int ai = 0; ai < 2; ++ai)
#pragma unroll
            for (int m = 0; m < 4; ++m) {
                const int row = u.pm * 256 + ai * 128 + wr * 64 + m * 16 + fr;
                const int sidx = row - bidx * TT, tl = sidx - LC;
                const int pos = (wc & 1) == 0 ? (tl >> 6) : (tl & 63);
                f32x4 cs = (f32x4){1.f, 1.f, 1.f, 1.f}, sn = (f32x4){0.f, 0.f, 0.f, 0.f};
                if (dorope) { cs = *(const f32x4*)(rope + pos * 16 + 4 * fq); sn = *(const f32x4*)(rope + 1024 + pos * 16 + 4 * fq); }
#pragma unroll
                for (int bj = 0; bj < 2; ++bj) {
                    const f32x4 p1 = acc[ai][bj][m][0], p2 = acc[ai][bj][m][1];
                    const f32x4 o1 = (p1 * cs - p2 * sn) * qs, o2 = (p2 * cs + p1 * sn) * qs;
                    const int col = u.pn * 256 + bj * 128 + wc * 32 + 4 * fq;
                    if (u.pn < 4) {
                        st_bf4(QB + (size_t)row * 1024 + col, o1); st_bf4(QB + (size_t)row * 1024 + col + 16, o2);
                    } else if (u.pn == 4) {
                        st_bf4(KB + (size_t)row * 256 + (col - 1024), o1); st_bf4(KB + (size_t)row * 256 + (col - 1024) + 16, o2);
                    } else {
                        const int hd = col - 1280;
                        bf16_t* vp = VT + ((size_t)(bidx * 256 + hd)) * TT + sidx;
                        vp[0] = f2bf(o1[0]); vp[TT] = f2bf(o1[1]); vp[2 * TT] = f2bf(o1[2]); vp[3 * TT] = f2bf(o1[3]);
                        vp[16 * TT] = f2bf(o2[0]); vp[17 * TT] = f2bf(o2[1]); vp[18 * TT] = f2bf(o2[2]); vp[19 * TT] = f2bf(o2[3]);
                    }
                }
            }
    }
};
__device__ __forceinline__ void phase_inproj1(const Params& p, char* lds) {
    SchedIn1 S{p.ws + OFF_H, p.ws + OFF_WIN1};
    EpiIn1 E{(bf16_t*)(p.ws + L_QB), (bf16_t*)(p.ws + L_KB), (bf16_t*)(p.ws + L_VT), (const float*)(p.ws + OFF_ROPE)};
    g8::gemm_phase<false>((LAS unsigned char*)lds, DM, S, E);
    convert_moe<1, 0, 3072>(p, 1, lds);
}

typedef unsigned u32x2_t __attribute__((ext_vector_type(2)));
__device__ __forceinline__ float max_x16_x32(float v) {
    u32x2_t r = __builtin_amdgcn_permlane16_swap(__float_as_uint(v), __float_as_uint(v), false, false);
    v = fmaxf(__uint_as_float(r[0]), __uint_as_float(r[1]));
    r = __builtin_amdgcn_permlane32_swap(__float_as_uint(v), __float_as_uint(v), false, false);
    return fmaxf(__uint_as_float(r[0]), __uint_as_float(r[1]));
}
__device__ __forceinline__ float sum_x16_x32(float v) {
    u32x2_t r = __builtin_amdgcn_permlane16_swap(__float_as_uint(v), __float_as_uint(v), false, false);
    v = __uint_as_float(r[0]) + __uint_as_float(r[1]);
    r = __builtin_amdgcn_permlane32_swap(__float_as_uint(v), __float_as_uint(v), false, false);
    return __uint_as_float(r[0]) + __uint_as_float(r[1]);
}
__device__ __forceinline__ void phase_attn(const Params& p, char* lds) {
    const bf16_t* QB = (const bf16_t*)(p.ws + L_QB); const bf16_t* KB = (const bf16_t*)(p.ws + L_KB); const bf16_t* VT = (const bf16_t*)(p.ws + L_VT);
    bf16_t* AO = (bf16_t*)(p.ws + L_AO);
    constexpr int VROW = 136, STG = 8192 + 64 * VROW;
    const int t = threadIdx.x, lane = t & 63, w = t >> 6, fr = lane & 15, fq = lane >> 4;
    const int g = w & 3, qh = w >> 2;
    const int srow = t >> 3, sc16 = t & 7;
    for (int u = blockIdx.x; u < 512; u += gridDim.x) {
        const int qt = u & 15, hkv = (u >> 4) & 3, b = u >> 6;
        const int hq = hkv * 4 + g;
        const int q0 = qt * 128, qa = q0 + qh * 64;
        char* Qs = lds + 2 * STG + w * 8192;
        {
            const bf16_t* qsrc = QB + (size_t)(b * TT + LC + qa) * 1024 + hq * 64;
#pragma unroll
            for (int it = 0; it < 8; ++it) {
                const int row = it * 8 + (lane >> 3), ch = lane & 7;
                *(uint4*)(Qs + swz(row, ch)) = *(const uint4*)(qsrc + (size_t)row * 1024 + ch * 8);
            }
        }
        f32x4 O[4][4];
        float mrow[4], lrow[4];
#pragma unroll
        for (int mi = 0; mi < 4; ++mi) {
            mrow[mi] = -1e30f; lrow[mi] = 0.f;
#pragma unroll
            for (int dt = 0; dt < 4; ++dt) O[mi][dt] = (f32x4){0.f, 0.f, 0.f, 0.f};
        }
        const int c_lo = (q0 == 0) ? 2 : 0, c_hi = (q0 + 256 > SEQ) ? 4 : 6;
        const int nch = (c_hi - c_lo) + 4;
        const int nloc = c_hi - c_lo;
        const bf16_t* kbase = KB + (size_t)(b * TT) * 256 + hkv * 64 + sc16 * 8;
        const bf16_t* vbase = VT + ((size_t)((b * 4 + hkv) * 64 + srow)) * TT + sc16 * 8;
        uint4 kreg, vreg;
        {
            const int s0 = (0 < nloc) ? LC + q0 - 128 + 64 * c_lo : 0;
            kreg = *(const uint4*)(kbase + (size_t)(s0 + srow) * 256);
            vreg = *(const uint4*)(vbase + s0);
            char* Ks = lds; char* Vs = lds + 8192;
            *(uint4*)(Ks + swz(srow, sc16)) = kreg;
            *(uint2*)(Vs + srow * VROW + sc16 * 16) = make_uint2(vreg.x, vreg.y);
            *(uint2*)(Vs + srow * VROW + sc16 * 16 + 8) = make_uint2(vreg.z, vreg.w);
        }
        __syncthreads();
        for (int i = 0; i < nch; ++i) {
            const bool more = (i + 1 < nch);
            if (more) {
                const int i1 = i + 1;
                const int s1 = (i1 < nloc) ? LC + q0 - 128 + 64 * (c_lo + i1) : 64 * (i1 - nloc);
                kreg = *(const uint4*)(kbase + (size_t)(s1 + srow) * 256);
                vreg = *(const uint4*)(vbase + s1);
            }
            const bool isloc = i < nloc;
            const int kc = q0 - 128 + 64 * (c_lo + i);
            const bool relevant = !isloc || (kc + 63 >= qa - 128 && kc <= qa + 63 + 128);
            const bool needmask = isloc && !(kc >= qa + 63 - 128 && kc + 63 <= qa + 128);
            if (relevant) {
                const char* Ks = lds + (i & 1) * STG;
                const char* Vs = Ks + 8192;
#pragma unroll
                for (int mh = 0; mh < 2; ++mh) {
                    bf16x8 qf[2][2];
                    int qrow = mh * 32 + fr;
                    asm volatile("" : "+v"(qrow));
#pragma unroll
                    for (int m2 = 0; m2 < 2; ++m2)
#pragma unroll
                        for (int kk = 0; kk < 2; ++kk) qf[m2][kk] = *(const bf16x8*)(Qs + swz(qrow + 16 * m2, kk * 4 + fq));
                    f32x4 S[2][4];
#pragma unroll
                    for (int m2 = 0; m2 < 2; ++m2)
#pragma unroll
                        for (int ni = 0; ni < 4; ++ni) S[m2][ni] = (f32x4){0.f, 0.f, 0.f, 0.f};
#pragma unroll
                    for (int kk = 0; kk < 2; ++kk) {
                        bf16x8 kf[4];
#pragma unroll
                        for (int ni = 0; ni < 4; ++ni) kf[ni] = *(const bf16x8*)(Ks + swz(16 * ni + fr, kk * 4 + fq));
#pragma unroll
                        for (int m2 = 0; m2 < 2; ++m2)
#pragma unroll
                            for (int ni = 0; ni < 4; ++ni) S[m2][ni] = __builtin_amdgcn_mfma_f32_16x16x32_bf16(kf[ni], qf[m2][kk], S[m2][ni], 0, 0, 0);
                    }
                    bf16x8 pf[2][2];
#pragma unroll
                    for (int m2 = 0; m2 < 2; ++m2) {
                        const int mi = mh * 2 + m2;
                        if (needmask) {
                            const int qpos = qa + 16 * mi + fr;
#pragma unroll
                            for (int ni = 0; ni < 4; ++ni)
#pragma unroll
                                for (int r = 0; r < 4; ++r) {
                                    const int dist = qpos - (kc + 16 * ni + 4 * fq + r);
                                    S[m2][ni][r] = (dist <= 128 && dist >= -128) ? S[m2][ni][r] : -1e30f;
                                }
                        }
                        float mx = -1e30f;
#pragma unroll
                        for (int ni = 0; ni < 4; ++ni) mx = fmaxf(fmaxf(mx, fmaxf(S[m2][ni][0], S[m2][ni][1])), fmaxf(S[m2][ni][2], S[m2][ni][3]));
                        mx = max_x16_x32(mx);
                        const float mn = fmaxf(mrow[mi], mx);
                        const float scale = __builtin_amdgcn_exp2f(mrow[mi] - mn);
                        mrow[mi] = mn;
                        float ls = 0.f;
                        if (needmask) {
#pragma unroll
                            for (int ni = 0; ni < 4; ++ni)
#pragma unroll
                                for (int r = 0; r < 4; ++r) {
                                    const float pv = S[m2][ni][r] > -1e29f ? __builtin_amdgcn_exp2f(S[m2][ni][r] - mn) : 0.f;
                                    S[m2][ni][r] = pv; ls += pv;
                                }
                        } else {
#pragma unroll
                            for (int ni = 0; ni < 4; ++ni)
#pragma unroll
                                for (int r = 0; r < 4; ++r) {
                                    const float pv = __builtin_amdgcn_exp2f(S[m2][ni][r] - mn);
                                    S[m2][ni][r] = pv; ls += pv;
                                }
                        }
                        lrow[mi] = lrow[mi] * scale + ls;
#pragma unroll
                        for (int dt = 0; dt < 4; ++dt) O[mi][dt] *= scale;
#pragma unroll
                        for (int kk = 0; kk < 2; ++kk) {
                            union { bf16x8 v; unsigned u[4]; } pk;
                            pk.u[0] = pack2(S[m2][2 * kk][0], S[m2][2 * kk][1]); pk.u[1] = pack2(S[m2][2 * kk][2], S[m2][2 * kk][3]);
                            pk.u[2] = pack2(S[m2][2 * kk + 1][0], S[m2][2 * kk + 1][1]); pk.u[3] = pack2(S[m2][2 * kk + 1][2], S[m2][2 * kk + 1][3]);
                            pf[m2][kk] = pk.v;
                        }
                    }
#pragma unroll
                    for (int dt = 0; dt < 4; ++dt)
#pragma unroll
                        for (int kk = 0; kk < 2; ++kk) {
                            union { bf16x8 v; uint2 h[2]; } vf;
                            const char* vp = Vs + (16 * dt + fr) * VROW + (32 * kk + 4 * fq) * 2;
                            vf.h[0] = *(const uint2*)vp;
                            vf.h[1] = *(const uint2*)(vp + 32);
#pragma unroll
                            for (int m2 = 0; m2 < 2; ++m2) O[mh * 2 + m2][dt] = __builtin_amdgcn_mfma_f32_16x16x32_bf16(vf.v, pf[m2][kk], O[mh * 2 + m2][dt], 0, 0, 0);
                        }
                }
            }
            if (more) {
                char* Ks = lds + ((i + 1) & 1) * STG; char* Vs = Ks + 8192;
                *(uint4*)(Ks + swz(srow, sc16)) = kreg;
                *(uint2*)(Vs + srow * VROW + sc16 * 16) = make_uint2(vreg.x, vreg.y);
                *(uint2*)(Vs + srow * VROW + sc16 * 16 + 8) = make_uint2(vreg.z, vreg.w);
            }
            __syncthreads();
        }
        const float sk = p.in[27][hq] * 1.4426950408889634f;
#pragma unroll
        for (int mi = 0; mi < 4; ++mi) {
            const float mf = fmaxf(mrow[mi], sk);
            const float scale = __builtin_amdgcn_exp2f(mrow[mi] - mf);
            const float l = sum_x16_x32(lrow[mi]) * scale + __builtin_amdgcn_exp2f(sk - mf);
            const float inv = scale / l;
            bf16_t* op = AO + (size_t)(b * SEQ + qa + 16 * mi + fr) * DM + hq * 64 + 4 * fq;
#pragma unroll
            for (int dt = 0; dt < 4; ++dt) {
                uint2 o;
                o.x = pack2(O[mi][dt][0] * inv, O[mi][dt][1] * inv);
                o.y = pack2(O[mi][dt][2] * inv, O[mi][dt][3] * inv);
                *(uint2*)(op + 16 * dt) = o;
            }
        }
    }
}

constexpr int NPHASE = 20;
__global__ void __launch_bounds__(NTHR) mega(Params p) {
    extern __shared__ __attribute__((aligned(16))) char lds[];
    cg::grid_group grid = cg::this_grid();
    volatile LAS unsigned* xbst = (volatile LAS unsigned*)(lds + LDS_MAIN);
    if (threadIdx.x == 0) { xbst[0] = 0u; xbst[1] = 0u; xbst[2] = 0u; xbst[3] = 0u; }
    __syncthreads();
    const XcdBarrier xb = xcd_barrier_post((unsigned*)(p.ws + OFF_BAR), xbst);
    if (p.ph_lo < 0) grid.sync();
#ifndef PH_MASK
#define PH_MASK 0xFFFFF
#endif
#ifndef REP_MASK
#define REP_MASK 0
#endif
#define RUN(n, call) if (((PH_MASK >> n) & 1) && p.ph_lo <= n && n < p.ph_hi) { call; if ((REP_MASK >> n) & 1) { xcd_barrier(xb); call; } if (n + 1 < p.ph_hi) xcd_barrier(xb); }
    RUN(0, phase0(p, lds))
    RUN(1, phase1(p))
    RUN(2, phase2(p, lds))
    RUN(3, phase3(p, lds, xb))
    RUN(4, phase4(p, lds, xb))
    RUN(5, phase5(p, lds))
    RUN(6, phase_outproj(p, 0, lds))
    RUN(7, phase_ffn_norm(p, 0, lds))
    RUN(8, phase_topk(p, 0, lds))
    RUN(9, phase_moe1(p, 0, lds))
    RUN(10, phase_moe2(p, 0, lds))
    RUN(11, phase_combine(p, 0, lds))
    RUN(12, phase_inproj1(p, lds))
    RUN(13, phase_attn(p, lds))
    RUN(14, phase_outproj(p, 1, lds))
    RUN(15, phase_ffn_norm(p, 1, lds))
    RUN(16, phase_topk(p, 1, lds))
    RUN(17, phase_moe1(p, 1, lds))
    RUN(18, phase_moe2(p, 1, lds))
    RUN(19, phase_combine(p, 1, lds))
#undef RUN
}

extern "C" void kernel_launch(void* const* d_in, const int* in_sizes, int n_in, void* d_out, int out_size, void* d_ws, size_t ws_size, hipStream_t stream) {
    static int grid_blocks = 0;
    if (grid_blocks == 0) {
        if (n_in != 33 || ws_size < WS_NEED) { fprintf(stderr, "kernel_launch: unexpected n_in %d or ws_size %zu (need %zu)\n", n_in, ws_size, (size_t)WS_NEED); grid_blocks = -1; return; }
        int dev = 0, cus = 0, per_cu = 0;
        (void)hipGetDevice(&dev);
        (void)hipDeviceGetAttribute(&cus, hipDeviceAttributeMultiprocessorCount, dev);
        (void)hipFuncSetAttribute((const void*)mega, hipFuncAttributeMaxDynamicSharedMemorySize, LDS_BYTES);
        (void)hipOccupancyMaxActiveBlocksPerMultiprocessor(&per_cu, (const void*)mega, NTHR, LDS_BYTES);
        if (per_cu < 1) { fprintf(stderr, "kernel_launch: occupancy query says %d blocks per CU\n", per_cu); per_cu = 1; }
        if (per_cu > 1) per_cu = 1;
        grid_blocks = cus * per_cu;
        (void)hipGetLastError();
    }
    if (grid_blocks < 0) return;
    if (hipMemsetAsync((char*)d_ws + OFF_BAR, 0, SZ_BAR, stream) != hipSuccess) { fprintf(stderr, "kernel_launch: memset failed\n"); return; }
    Params p{};
    for (int i = 0; i < 33; ++i) p.in[i] = (const float*)d_in[i];
    p.out = (float*)d_out;
    p.ws = (char*)d_ws;
    p.ph_lo = 0; p.ph_hi = NPHASE;
    void* args[] = {&p};
    hipError_t e = hipLaunchCooperativeKernel((const void*)mega, dim3(grid_blocks), dim3(NTHR), args, LDS_BYTES, stream);
    if (e != hipSuccess) fprintf(stderr, "cooperative launch failed: %s (grid %d)\n", hipGetErrorString(e), grid_blocks);
}
```
